# Optimizing an MI355X kernel written in HIP

```python
import math
import jax, jax.numpy as jnp
from jax import lax
import numpy as np

D_MODEL = 1024
BATCH = 4
SEQ = 4096
DEPTH = 1

CHUNK = 64
MIX_WIDTH = D_MODEL
POOL_WIDTH = MIX_WIDTH // 2
POOL_WINDOWS = (2, 4, 8, 16)
POOL_GROUP = POOL_WIDTH // len(POOL_WINDOWS)
ATTN_HEADS = 8
HEAD_DIM = (MIX_WIDTH - POOL_WIDTH) // ATTN_HEADS
ATTN_WIDTH = ATTN_HEADS * HEAD_DIM
IDX_HEADS = 8
IDX_DIM = 64
TOPK_MAX = 256
Q_BLOCK = 128
ROPE_THETA = 10000.0
MEM_TOKENS = 256
MEM_HEADS = 4
MEM_HEAD_DIM = 128
MEM_WIDTH = MEM_HEADS * MEM_HEAD_DIM
N_GROUPS = 4
EXPERTS_PER_GROUP = 8
EXPERT_FF = 256
TOP_K_EXPERTS = 2
EPS = 1e-6
OFF_POOL = 0
OFF_Q = OFF_POOL + POOL_WIDTH
OFF_K = OFF_Q + ATTN_WIDTH
OFF_V = OFF_K + ATTN_WIDTH
OFF_QI = OFF_V + ATTN_WIDTH
OFF_KI = OFF_QI + IDX_HEADS * IDX_DIM
OFF_WI = OFF_KI + IDX_DIM
IN_COLS = OFF_WI + IDX_HEADS

kernel_name = "hybrid_pool_dsa_hmoe_block"


def rmsnorm(x, g):
    xf = x.astype(jnp.float32)
    y = xf * lax.rsqrt(jnp.mean(xf * xf, axis=-1, keepdims=True) + EPS)
    return (y * g.astype(jnp.float32)).astype(x.dtype)


def rope_tables(seq_len, dim):
    inv = ROPE_THETA ** (-jnp.arange(0, dim, 2, dtype=jnp.float32) / dim)
    ang = jnp.arange(seq_len, dtype=jnp.float32)[:, None] * inv[None, :]
    ang = jnp.concatenate([ang, ang], axis=-1)
    return jnp.cos(ang), jnp.sin(ang)


def apply_rope(x, cos, sin):
    xf = x.astype(jnp.float32)
    half = xf.shape[-1] // 2
    rot = jnp.concatenate([-xf[..., half:], xf[..., :half]], axis=-1)
    return (xf * cos[None, :, None, :] + rot * sin[None, :, None, :]).astype(x.dtype)


def pool_mixer(u, pool_w, pool_scale):
    B, S, _ = u.shape
    uf = u.astype(jnp.float32)
    pos1 = jnp.arange(1, S + 1)
    outs = []
    for g, w in enumerate(POOL_WINDOWS):
        ug = uf[..., g * POOL_GROUP:(g + 1) * POOL_GROUP]
        cs = jnp.cumsum(ug, axis=1)
        lag = jnp.pad(cs, ((0, 0), (w, 0), (0, 0)))[:, :S]
        cnt = jnp.minimum(pos1, w).astype(jnp.float32)[None, :, None]
        mixed = ((cs - lag) / cnt - ug).astype(u.dtype)
        outs.append(jnp.einsum('bsc,cd->bsd', mixed, pool_w[g]))
    return jnp.concatenate(outs, axis=-1) * pool_scale


def dsa_attention(q, k, v, qi, ki, wi):
    B, S, H, Dh = q.shape
    topk = min(TOPK_MAX, S // 4)
    n_blocks = S // Q_BLOCK
    key_chunk = jnp.arange(S) // CHUNK
    idx_scale = (IDX_DIM ** -0.5) * (IDX_HEADS ** -0.5)
    gather = jax.vmap(lambda a, ix: a[ix])

    def block(i):
        start = i * Q_BLOCK
        qb = lax.dynamic_slice_in_dim(q, start, Q_BLOCK, axis=1)
        qib = lax.dynamic_slice_in_dim(qi, start, Q_BLOCK, axis=1)
        wib = lax.dynamic_slice_in_dim(wi, start, Q_BLOCK, axis=1)
        q_chunk = (start + jnp.arange(Q_BLOCK)) // CHUNK
        adm = key_chunk[None, :] <= q_chunk[:, None]
        rel = jax.nn.relu(jnp.einsum('bthd,bsd->bths', qib, ki).astype(jnp.float32))
        score = jnp.einsum('bths,bth->bts', rel, wib.astype(jnp.float32)) * idx_scale
        score = jnp.where(adm[None], score, -jnp.inf)
        _, sel = lax.top_k(score, topk)
        valid = key_chunk[sel] <= q_chunk[None, :, None]
        ks = gather(k, sel)
        vs = gather(v, sel)
        s = jnp.einsum('bthd,btkhd->bthk', qb, ks).astype(jnp.float32) * (Dh ** -0.5)
        s = jnp.where(valid[:, :, None, :], s, -jnp.inf)
        p = jax.nn.softmax(s, axis=-1).astype(v.dtype)
        return jnp.einsum('bthk,btkhd->bthd', p, vs)

    out = lax.map(block, jnp.arange(n_blocks))
    return out.transpose(1, 0, 2, 3, 4).reshape(B, S, H * Dh)


def memory_cross_attention(h, mem, g_mem, w_q, w_kv, q_norm, k_norm, w_o):
    B, S, _ = h.shape
    M = mem.shape[1]
    m = rmsnorm(mem, g_mem)
    q = (h @ w_q).reshape(B, S, MEM_HEADS, MEM_HEAD_DIM)
    kv = (m @ w_kv).reshape(B, M, 2, MEM_HEADS, MEM_HEAD_DIM)
    q = rmsnorm(q, q_norm)
    k = rmsnorm(kv[:, :, 0], k_norm)
    v = kv[:, :, 1]
    s = jnp.einsum('bshd,bmhd->bhsm', q, k).astype(jnp.float32) * (MEM_HEAD_DIM ** -0.5)
    p = jax.nn.softmax(s, axis=-1).astype(v.dtype)
    o = jnp.einsum('bhsm,bmhd->bshd', p, v).reshape(B, S, MEM_WIDTH)
    return o @ w_o


def hierarchical_moe(h, wg_router, bg_router, we_router, be_router, w_gate, w_up, w_down):
    B, S, D = h.shape
    hf = h.reshape(B * S, D)
    g_logits = (hf @ wg_router + bg_router).astype(jnp.float32)
    g_prob = jax.nn.softmax(g_logits, axis=-1)
    g_sel = jnp.argmax(g_logits, axis=-1)
    g_w = jnp.take_along_axis(g_prob, g_sel[:, None], axis=1)
    e_logits = (hf @ we_router + be_router).astype(jnp.float32)
    e_logits = e_logits.reshape(-1, N_GROUPS, EXPERTS_PER_GROUP)
    e_in = jnp.take_along_axis(e_logits, g_sel[:, None, None], axis=1)[:, 0]
    top_v, top_i = lax.top_k(e_in, TOP_K_EXPERTS)
    top_w = jax.nn.softmax(top_v, axis=-1) * g_w
    exp_w = jnp.sum(jax.nn.one_hot(top_i, EXPERTS_PER_GROUP, dtype=jnp.float32)
                    * top_w[..., None], axis=1)
    gates = jax.nn.one_hot(g_sel, N_GROUPS, dtype=jnp.float32)[:, :, None] * exp_w[:, None, :]
    out = jnp.zeros_like(hf)
    for g in range(N_GROUPS):
        a = jnp.einsum('nd,edf->nef', hf, w_gate[g])
        b = jnp.einsum('nd,edf->nef', hf, w_up[g])
        hid = jax.nn.silu(a) * b * gates[:, g, :, None].astype(hf.dtype)
        out = out + jnp.einsum('nef,efd->nd', hid, w_down[g])
    return out.reshape(B, S, D)


def setup_inputs(seed: int = 0) -> dict:
    key = jax.random.key(seed)
    ks = jax.random.split(key, 32)
    f32 = jnp.float32
    L = DEPTH

    def nrm(k, shape, scale):
        return jax.random.normal(k, shape, f32) * scale

    def gain(k, shape):
        return 1.0 + 0.02 * jax.random.normal(k, shape, f32)

    return {
        "x": nrm(ks[0], (BATCH, SEQ, D_MODEL), 1.0),
        "mem": nrm(ks[1], (BATCH, MEM_TOKENS, D_MODEL), 1.0),
        "mix_norm": gain(ks[2], (L, D_MODEL)),
        "w_in": nrm(ks[3], (L, D_MODEL, IN_COLS), D_MODEL ** -0.5),
        "pool_w": nrm(ks[4], (L, len(POOL_WINDOWS), POOL_GROUP, POOL_GROUP), POOL_GROUP ** -0.5),
        "pool_scale": gain(ks[5], (L, POOL_WIDTH)),
        "q_norm": gain(ks[6], (L, HEAD_DIM)),
        "k_norm": gain(ks[7], (L, HEAD_DIM)),
        "idx_k_norm": gain(ks[8], (L, IDX_DIM)),
        "w_out": nrm(ks[9], (L, MIX_WIDTH, D_MODEL), MIX_WIDTH ** -0.5),
        "xattn_norm": gain(ks[10], (L, D_MODEL)),
        "mem_norm": gain(ks[11], (L, D_MODEL)),
        "xattn_wq": nrm(ks[12], (L, D_MODEL, MEM_WIDTH), D_MODEL ** -0.5),
        "xattn_wkv": nrm(ks[13], (L, D_MODEL, 2 * MEM_WIDTH), D_MODEL ** -0.5),
        "xattn_q_norm": gain(ks[14], (L, MEM_HEAD_DIM)),
        "xattn_k_norm": gain(ks[15], (L, MEM_HEAD_DIM)),
        "xattn_wo": nrm(ks[16], (L, MEM_WIDTH, D_MODEL), MEM_WIDTH ** -0.5),
        "ffn_norm": gain(ks[17], (L, D_MODEL)),
        "router_group_w": nrm(ks[18], (L, D_MODEL, N_GROUPS), D_MODEL ** -0.5),
        "router_group_b": nrm(ks[19], (L, N_GROUPS), 0.01),
        "router_expert_w": nrm(ks[20], (L, D_MODEL, N_GROUPS * EXPERTS_PER_GROUP), D_MODEL ** -0.5),
        "router_expert_b": nrm(ks[21], (L, N_GROUPS * EXPERTS_PER_GROUP), 0.01),
        "expert_w_gate": nrm(ks[22], (L, N_GROUPS, EXPERTS_PER_GROUP, D_MODEL, EXPERT_FF), D_MODEL ** -0.5),
        "expert_w_up": nrm(ks[23], (L, N_GROUPS, EXPERTS_PER_GROUP, D_MODEL, EXPERT_FF), D_MODEL ** -0.5),
        "expert_w_down": nrm(ks[24], (L, N_GROUPS, EXPERTS_PER_GROUP, EXPERT_FF, D_MODEL), EXPERT_FF ** -0.5),
    }


def reference(x, mem, mix_norm, w_in, pool_w, pool_scale, q_norm, k_norm, idx_k_norm, w_out,
              xattn_norm, mem_norm, xattn_wq, xattn_wkv, xattn_q_norm, xattn_k_norm, xattn_wo,
              ffn_norm, router_group_w, router_group_b, router_expert_w, router_expert_b,
              expert_w_gate, expert_w_up, expert_w_down):
    B, S, _ = x.shape
    cos_a, sin_a = rope_tables(S, HEAD_DIM)
    cos_i, sin_i = rope_tables(S, IDX_DIM)
    for l in range(DEPTH):
        h = rmsnorm(x, mix_norm[l])
        z = h @ w_in[l]
        u = z[..., OFF_POOL:OFF_Q]
        q = z[..., OFF_Q:OFF_K].reshape(B, S, ATTN_HEADS, HEAD_DIM)
        k = z[..., OFF_K:OFF_V].reshape(B, S, ATTN_HEADS, HEAD_DIM)
        v = z[..., OFF_V:OFF_QI].reshape(B, S, ATTN_HEADS, HEAD_DIM)
        qi = z[..., OFF_QI:OFF_KI].reshape(B, S, IDX_HEADS, IDX_DIM)
        ki = z[..., OFF_KI:OFF_WI]
        wi = z[..., OFF_WI:IN_COLS]
        q = apply_rope(rmsnorm(q, q_norm[l]), cos_a, sin_a)
        k = apply_rope(rmsnorm(k, k_norm[l]), cos_a, sin_a)
        qi = apply_rope(qi, cos_i, sin_i)
        ki = apply_rope(rmsnorm(ki, idx_k_norm[l])[:, :, None, :], cos_i, sin_i)[:, :, 0]
        y_pool = pool_mixer(u, pool_w[l], pool_scale[l])
        y_attn = dsa_attention(q, k, v, qi, ki, wi)
        x = x + jnp.concatenate([y_pool, y_attn], axis=-1) @ w_out[l]
        h = rmsnorm(x, xattn_norm[l])
        x = x + memory_cross_attention(h, mem, mem_norm[l], xattn_wq[l], xattn_wkv[l],
                                       xattn_q_norm[l], xattn_k_norm[l], xattn_wo[l])
        h = rmsnorm(x, ffn_norm[l])
        x = x + hierarchical_moe(h, router_group_w[l], router_group_b[l], router_expert_w[l],
                                 router_expert_b[l], expert_w_gate[l], expert_w_up[l],
                                 expert_w_down[l])
    return x
```

```cpp
#include <hip/hip_runtime.h>
#include <stdint.h>
#include <math.h>
#include <stdio.h>

namespace {
constexpr int NB = 4, S = 4096, D = 1024, M = NB * S, INC = 2632, MEMT = 256, MR = NB * MEMT;
constexpr float EPS = 1e-6f;
constexpr size_t MiB = 1u << 20;

__device__ __forceinline__ float wave_sum(float v) {
#pragma unroll
  for (int o = 32; o > 0; o >>= 1) v += __shfl_xor(v, o);
  return v;
}
__device__ __forceinline__ float wave_max(float v) {
#pragma unroll
  for (int o = 32; o > 0; o >>= 1) v = fmaxf(v, __shfl_xor(v, o));
  return v;
}

__global__ void k_rowrstd(const float* __restrict__ x, float* __restrict__ rstd, int rows, int cols) {
  int w = (blockIdx.x * blockDim.x + threadIdx.x) >> 6, lane = threadIdx.x & 63;
  if (w >= rows) return;
  const float* p = x + (size_t)w * cols;
  float s = 0.f;
  for (int c = lane; c < cols; c += 64) { float v = p[c]; s += v * v; }
  s = wave_sum(s);
  if (lane == 0) rstd[w] = rsqrtf(s / (float)cols + EPS);
}

struct GemmP {
  const float* A; int lda; const int* arow; const float* rs; const float* ks;
  const float* Bm; int ldb;
  float* C; int ldc; const float* R; int ldr; const float* cs; const int* crow;
  int Mrows, N, K; const int* mcount; int atomic;
};
__global__ void __launch_bounds__(256) k_sgemm(GemmP p) {
  __shared__ float As[16][65];
  __shared__ float Bs[16][65];
  const int Mrows = p.mcount ? *p.mcount : p.Mrows;
  const int m0 = blockIdx.y * 64, n0 = blockIdx.x * 64;
  if (m0 >= Mrows) return;
  const int tid = threadIdx.x, tx = tid & 15, ty = tid >> 4;
  float acc[4][4];
#pragma unroll
  for (int i = 0; i < 4; ++i)
#pragma unroll
    for (int j = 0; j < 4; ++j) acc[i][j] = 0.f;
  const int ar = tid >> 2, ak = (tid & 3) * 4;
  int arow_src = -1; float arscale = 1.f;
  if (m0 + ar < Mrows) { arow_src = p.arow ? p.arow[m0 + ar] : (m0 + ar); if (p.rs) arscale = p.rs[arow_src]; }
  const int bk = tid >> 4, bn = (tid & 15) * 4;
  for (int k0 = 0; k0 < p.K; k0 += 16) {
#pragma unroll
    for (int i = 0; i < 4; ++i) {
      float v = 0.f;
      if (arow_src >= 0) { v = p.A[(size_t)arow_src * p.lda + k0 + ak + i] * arscale; if (p.ks) v *= p.ks[k0 + ak + i]; }
      As[ak + i][ar] = v;
    }
#pragma unroll
    for (int i = 0; i < 4; ++i) {
      int n = n0 + bn + i;
      Bs[bk][bn + i] = (n < p.N) ? p.Bm[(size_t)(k0 + bk) * p.ldb + n] : 0.f;
    }
    __syncthreads();
#pragma unroll
    for (int k = 0; k < 16; ++k) {
      float a[4], b[4];
#pragma unroll
      for (int i = 0; i < 4; ++i) { a[i] = As[k][ty * 4 + i]; b[i] = Bs[k][tx * 4 + i]; }
#pragma unroll
      for (int i = 0; i < 4; ++i)
#pragma unroll
        for (int j = 0; j < 4; ++j) acc[i][j] = fmaf(a[i], b[j], acc[i][j]);
    }
    __syncthreads();
  }
#pragma unroll
  for (int i = 0; i < 4; ++i) {
    int m = m0 + ty * 4 + i;
    if (m >= Mrows) continue;
    int cm = p.crow ? p.crow[m] : m;
#pragma unroll
    for (int j = 0; j < 4; ++j) {
      int n = n0 + tx * 4 + j;
      if (n >= p.N) continue;
      float v = acc[i][j];
      if (p.cs) v *= p.cs[n];
      if (p.atomic) { atomicAdd(&p.C[(size_t)cm * p.ldc + n], v); }
      else { if (p.R) v += p.R[(size_t)cm * p.ldr + n]; p.C[(size_t)cm * p.ldc + n] = v; }
    }
  }
}

template <int HD, bool ROPE>
__global__ void k_headnorm(float* buf, int ld, int nheads, const float* __restrict__ gain, int rows) {
  int w = (blockIdx.x * blockDim.x + threadIdx.x) >> 6, lane = threadIdx.x & 63;
  if (w >= rows * nheads) return;
  int row = w / nheads, h = w % nheads;
  float* p = buf + (size_t)row * ld + h * HD;
  if (HD == 64) {
    float v = p[lane];
    if (gain) { float ss = wave_sum(v * v); v = v * rsqrtf(ss / 64.f + EPS) * gain[lane]; }
    if (ROPE) {
      int pos = row % S, i = lane & 31;
      float inv = powf(10000.f, -(float)(2 * i) / 64.f);
      float ang = (float)pos * inv;
      float c = cosf(ang), s = sinf(ang);
      float other = __shfl_xor(v, 32);
      v = (lane < 32) ? (v * c - other * s) : (v * c + other * s);
    }
    p[lane] = v;
  } else {
    float v0 = p[lane], v1 = p[lane + 64];
    float ss = wave_sum(v0 * v0 + v1 * v1);
    float r = rsqrtf(ss / 128.f + EPS);
    p[lane] = v0 * r * gain[lane]; p[lane + 64] = v1 * r * gain[lane + 64];
  }
}

__global__ void k_poolmix(const float* __restrict__ U, float* __restrict__ MIX) {
  size_t idx = (size_t)blockIdx.x * blockDim.x + threadIdx.x;
  if (idx >= (size_t)M * 512) return;
  int c = idx & 511; int m = (int)(idx >> 9); int t = m % S;
  int w = 2 << (c >> 7);
  int cnt = (t + 1 < w) ? (t + 1) : w;
  float s = 0.f;
  for (int j = 0; j < cnt; ++j) s += U[(size_t)(m - j) * 512 + c];
  MIX[idx] = s / (float)cnt - U[idx];
}

__global__ void __launch_bounds__(256) k_indexer(const float* __restrict__ QI, const float* __restrict__ KI, const float* __restrict__ WI, float* __restrict__ SC, int b) {
  const int kc = blockIdx.x, qc = blockIdx.y;
  if (kc > qc) return;
  __shared__ float Qs[64][65];
  __shared__ float Ks[64][65];
  const int tid = threadIdx.x, tx = tid & 15, ty = tid >> 4;
  const size_t qrow0 = (size_t)b * S + qc * 64, krow0 = (size_t)b * S + kc * 64;
  for (int i = tid; i < 64 * 64; i += 256) { int r = i >> 6, d = i & 63; Ks[r][d] = KI[(krow0 + r) * 64 + d]; }
  float acc[4][4];
#pragma unroll
  for (int i = 0; i < 4; ++i)
#pragma unroll
    for (int j = 0; j < 4; ++j) acc[i][j] = 0.f;
  for (int h = 0; h < 8; ++h) {
    __syncthreads();
    for (int i = tid; i < 64 * 64; i += 256) { int r = i >> 6, d = i & 63; Qs[r][d] = QI[(qrow0 + r) * 512 + h * 64 + d]; }
    __syncthreads();
    float s[4][4];
#pragma unroll
    for (int i = 0; i < 4; ++i)
#pragma unroll
      for (int j = 0; j < 4; ++j) s[i][j] = 0.f;
    for (int d = 0; d < 64; ++d) {
      float a[4], k[4];
#pragma unroll
      for (int i = 0; i < 4; ++i) { a[i] = Qs[ty * 4 + i][d]; k[i] = Ks[tx * 4 + i][d]; }
#pragma unroll
      for (int i = 0; i < 4; ++i)
#pragma unroll
        for (int j = 0; j < 4; ++j) s[i][j] = fmaf(a[i], k[j], s[i][j]);
    }
#pragma unroll
    for (int i = 0; i < 4; ++i) {
      float w = WI[(qrow0 + ty * 4 + i) * 8 + h];
#pragma unroll
      for (int j = 0; j < 4; ++j) acc[i][j] += fmaxf(s[i][j], 0.f) * w;
    }
  }
  const float scale = 0.125f * 0.35355339059327373f;
#pragma unroll
  for (int i = 0; i < 4; ++i)
#pragma unroll
    for (int j = 0; j < 4; ++j) SC[(size_t)(qc * 64 + ty * 4 + i) * S + kc * 64 + tx * 4 + j] = acc[i][j] * scale;
}

__device__ __forceinline__ unsigned long long comp_key(float v, int s) {
  if (v == 0.f) v = 0.f;
  unsigned u = __float_as_uint(v);
  u = (u & 0x80000000u) ? ~u : (u | 0x80000000u);
  return ((unsigned long long)u << 12) | (unsigned long long)(4095 - s);
}
__global__ void __launch_bounds__(256) k_select(const float* __restrict__ SC, unsigned long long* __restrict__ MASK, int b) {
  int t = (blockIdx.x * blockDim.x + threadIdx.x) >> 6, lane = threadIdx.x & 63;
  if (t >= S) return;
  const int c = t >> 6, N = 64 * (c + 1), nj = c + 1;
  unsigned long long* mrow = MASK + ((size_t)b * S + t) * 64;
  const float* row = SC + (size_t)t * S;
  if (N <= 256) {
    for (int j = lane; j < 64; j += 64) mrow[j] = (j < nj) ? ~0ull : 0ull;
    return;
  }
  unsigned long long T = 0;
  for (int bit = 43; bit >= 0; --bit) {
    unsigned long long cand = T | (1ull << bit);
    int cnt = 0;
    for (int j = 0; j < nj; ++j) {
      unsigned long long k = comp_key(row[j * 64 + lane], j * 64 + lane);
      cnt += __popcll(__ballot(k >= cand));
    }
    if (cnt >= 256) T = cand;
  }
  for (int j = 0; j < 64; ++j) {
    unsigned long long mk = 0;
    if (j < nj) { unsigned long long k = comp_key(row[j * 64 + lane], j * 64 + lane); mk = __ballot(k >= T); }
    if (lane == 0) mrow[j] = mk;
  }
}

__global__ void __launch_bounds__(256) k_dsa(const float* __restrict__ Q, const float* __restrict__ K, const float* __restrict__ V,
                                             const unsigned long long* __restrict__ MASK, float* __restrict__ Y) {
  const int m = blockIdx.x, b = m / S, tid = threadIdx.x, lane = tid & 63, wid = tid >> 6;
  __shared__ float qs[512];
  __shared__ int list[256];
  __shared__ int cnts[64];
  __shared__ float sc[8][256];
  __shared__ int ntot;
  qs[tid] = Q[(size_t)m * 512 + tid]; qs[tid + 256] = Q[(size_t)m * 512 + tid + 256];
  unsigned long long word = 0;
  if (tid < 64) { word = MASK[(size_t)m * 64 + tid]; cnts[tid] = __popcll(word); }
  __syncthreads();
  if (tid < 64) {
    int off = 0;
    for (int j = 0; j < tid; ++j) off += cnts[j];
    if (tid == 63) ntot = off + cnts[63];
    while (word) { int bpos = __ffsll((long long)word) - 1; word &= word - 1; if (off < 256) list[off] = tid * 64 + bpos; ++off; }
  }
  __syncthreads();
  const int n = ntot < 256 ? ntot : 256;
  if (tid < n) {
    const float* kr = K + ((size_t)b * S + list[tid]) * 512;
    for (int h = 0; h < 8; ++h) {
      float s = 0.f;
      for (int d = 0; d < 64; ++d) s = fmaf(qs[h * 64 + d], kr[h * 64 + d], s);
      sc[h][tid] = s * 0.125f;
    }
  }
  __syncthreads();
  for (int h = wid * 2; h < wid * 2 + 2; ++h) {
    float mx = -INFINITY;
    for (int k = lane; k < n; k += 64) mx = fmaxf(mx, sc[h][k]);
    mx = wave_max(mx);
    float sm = 0.f;
    for (int k = lane; k < n; k += 64) { float e = expf(sc[h][k] - mx); sc[h][k] = e; sm += e; }
    sm = wave_sum(sm);
    float inv = 1.f / sm;
    for (int k = lane; k < n; k += 64) sc[h][k] *= inv;
  }
  __syncthreads();
  for (int col = tid; col < 512; col += 256) {
    int h = col >> 6; float acc = 0.f;
    for (int k = 0; k < n; ++k) acc = fmaf(sc[h][k], V[((size_t)b * S + list[k]) * 512 + col], acc);
    Y[(size_t)m * 1024 + 512 + col] = acc;
  }
}

__global__ void __launch_bounds__(256) k_xattn(const float* __restrict__ Qm, const float* __restrict__ KV, float* __restrict__ O) {
  const int m = blockIdx.x, b = m / S, tid = threadIdx.x, lane = tid & 63, wid = tid >> 6;
  __shared__ float qs[512];
  __shared__ float sc[4][256];
  qs[tid] = Qm[(size_t)m * 512 + tid]; qs[tid + 256] = Qm[(size_t)m * 512 + tid + 256];
  __syncthreads();
  {
    const float* kr = KV + ((size_t)b * MEMT + tid) * 1024;
    for (int h = 0; h < 4; ++h) {
      float s = 0.f;
      for (int d = 0; d < 128; ++d) s = fmaf(qs[h * 128 + d], kr[h * 128 + d], s);
      sc[h][tid] = s * 0.08838834764831845f;
    }
  }
  __syncthreads();
  {
    int h = wid; float mx = -INFINITY;
    for (int k = lane; k < 256; k += 64) mx = fmaxf(mx, sc[h][k]);
    mx = wave_max(mx);
    float sm = 0.f;
    for (int k = lane; k < 256; k += 64) { float e = expf(sc[h][k] - mx); sc[h][k] = e; sm += e; }
    sm = wave_sum(sm);
    float inv = 1.f / sm;
    for (int k = lane; k < 256; k += 64) sc[h][k] *= inv;
  }
  __syncthreads();
  for (int col = tid; col < 512; col += 256) {
    int h = col >> 7; float acc = 0.f;
    for (int k = 0; k < 256; ++k) acc = fmaf(sc[h][k], KV[((size_t)b * MEMT + k) * 1024 + 512 + col], acc);
    O[(size_t)m * 512 + col] = acc;
  }
}

__global__ void __launch_bounds__(256) k_router(const float* __restrict__ X2, const float* __restrict__ rstd, const float* __restrict__ gn,
                                                const float* __restrict__ Wg, const float* __restrict__ bg, const float* __restrict__ We, const float* __restrict__ be,
                                                int* __restrict__ cnt, int* __restrict__ list, float* __restrict__ wlist) {
  int m = (blockIdx.x * blockDim.x + threadIdx.x) >> 6, lane = threadIdx.x & 63;
  if (m >= M) return;
  float acc[36];
#pragma unroll
  for (int j = 0; j < 36; ++j) acc[j] = 0.f;
  const float r = rstd[m];
  for (int k = lane; k < D; k += 64) {
    float h = X2[(size_t)m * D + k] * r * gn[k];
#pragma unroll
    for (int j = 0; j < 4; ++j) acc[j] = fmaf(h, Wg[k * 4 + j], acc[j]);
#pragma unroll
    for (int j = 0; j < 32; ++j) acc[4 + j] = fmaf(h, We[k * 32 + j], acc[4 + j]);
  }
#pragma unroll
  for (int j = 0; j < 36; ++j) acc[j] = wave_sum(acc[j]);
  if (lane == 0) {
    float gl[4]; int g = 0;
#pragma unroll
    for (int j = 0; j < 4; ++j) { gl[j] = acc[j] + bg[j]; }
#pragma unroll
    for (int j = 1; j < 4; ++j) if (gl[j] > gl[g]) g = j;
    float gs = 0.f;
#pragma unroll
    for (int j = 0; j < 4; ++j) gs += expf(gl[j] - gl[g]);
    float gw = 1.f / gs;
    float el[8];
#pragma unroll
    for (int j = 0; j < 8; ++j) {
      float v = 0.f;
#pragma unroll
      for (int gg = 0; gg < 4; ++gg) if (gg == g) v = acc[4 + gg * 8 + j] + be[gg * 8 + j];
      el[j] = v;
    }
    int i0 = 0;
#pragma unroll
    for (int j = 1; j < 8; ++j) if (el[j] > el[i0]) i0 = j;
    int i1 = (i0 == 0) ? 1 : 0;
#pragma unroll
    for (int j = 0; j < 8; ++j) if (j != i0 && el[j] > el[i1]) i1 = j;
    float e1 = expf(el[i1] - el[i0]);
    float w0 = gw / (1.f + e1), w1 = gw * e1 / (1.f + e1);
    int e0g = g * 8 + i0, e1g = g * 8 + i1;
    int p0 = atomicAdd(&cnt[e0g], 1); list[e0g * M + p0] = m; wlist[e0g * M + p0] = w0;
    int p1 = atomicAdd(&cnt[e1g], 1); list[e1g * M + p1] = m; wlist[e1g * M + p1] = w1;
  }
}
__global__ void k_offsets(const int* cnt, int* offs) {
  if (threadIdx.x == 0) { int o = 0; for (int e = 0; e < 32; ++e) { offs[e] = o; o += cnt[e]; } }
}

__global__ void __launch_bounds__(256) k_moe_gu(const float* __restrict__ X2, const float* __restrict__ rstd, const float* __restrict__ gn,
                                               const float* __restrict__ Wgate, const float* __restrict__ Wup, const int* __restrict__ cnt, const int* __restrict__ offs,
                                               const int* __restrict__ list, const float* __restrict__ wlist, float* __restrict__ HID) {
  const int e = blockIdx.z, Mrows = cnt[e];
  const int m0 = blockIdx.y * 64, n0 = blockIdx.x * 64;
  if (m0 >= Mrows) return;
  __shared__ float As[16][65];
  __shared__ float Bg[16][65];
  __shared__ float Bu[16][65];
  const int tid = threadIdx.x, tx = tid & 15, ty = tid >> 4;
  const float* wg = Wgate + (size_t)e * D * 256; const float* wu = Wup + (size_t)e * D * 256;
  float ag[4][4], au[4][4];
#pragma unroll
  for (int i = 0; i < 4; ++i)
#pragma unroll
    for (int j = 0; j < 4; ++j) { ag[i][j] = 0.f; au[i][j] = 0.f; }
  const int ar = tid >> 2, ak = (tid & 3) * 4;
  int src = -1; float rsv = 1.f;
  if (m0 + ar < Mrows) { src = list[e * M + m0 + ar]; rsv = rstd[src]; }
  const int bk = tid >> 4, bn = (tid & 15) * 4;
  for (int k0 = 0; k0 < D; k0 += 16) {
#pragma unroll
    for (int i = 0; i < 4; ++i) As[ak + i][ar] = (src >= 0) ? X2[(size_t)src * D + k0 + ak + i] * rsv * gn[k0 + ak + i] : 0.f;
#pragma unroll
    for (int i = 0; i < 4; ++i) { Bg[bk][bn + i] = wg[(size_t)(k0 + bk) * 256 + n0 + bn + i]; Bu[bk][bn + i] = wu[(size_t)(k0 + bk) * 256 + n0 + bn + i]; }
    __syncthreads();
#pragma unroll
    for (int k = 0; k < 16; ++k) {
      float a[4], b[4], c[4];
#pragma unroll
      for (int i = 0; i < 4; ++i) { a[i] = As[k][ty * 4 + i]; b[i] = Bg[k][tx * 4 + i]; c[i] = Bu[k][tx * 4 + i]; }
#pragma unroll
      for (int i = 0; i < 4; ++i)
#pragma unroll
        for (int j = 0; j < 4; ++j) { ag[i][j] = fmaf(a[i], b[j], ag[i][j]); au[i][j] = fmaf(a[i], c[j], au[i][j]); }
    }
    __syncthreads();
  }
#pragma unroll
  for (int i = 0; i < 4; ++i) {
    int m = m0 + ty * 4 + i;
    if (m >= Mrows) continue;
    float w = wlist[e * M + m];
#pragma unroll
    for (int j = 0; j < 4; ++j) {
      float g = ag[i][j];
      float sg = g / (1.f + expf(-g));
      HID[(size_t)(offs[e] + m) * 256 + n0 + tx * 4 + j] = sg * au[i][j] * w;
    }
  }
}

__global__ void __launch_bounds__(256) k_moe_down(const float* __restrict__ HID, const float* __restrict__ Wdown, const int* __restrict__ cnt, const int* __restrict__ offs,
                                                 const int* __restrict__ list, float* __restrict__ out) {
  const int e = blockIdx.z, Mrows = cnt[e];
  const int m0 = blockIdx.y * 64, n0 = blockIdx.x * 64;
  if (m0 >= Mrows) return;
  __shared__ float As[16][65];
  __shared__ float Bs[16][65];
  const int tid = threadIdx.x, tx = tid & 15, ty = tid >> 4;
  const float* wd = Wdown + (size_t)e * 256 * D;
  float acc[4][4];
#pragma unroll
  for (int i = 0; i < 4; ++i)
#pragma unroll
    for (int j = 0; j < 4; ++j) acc[i][j] = 0.f;
  const int ar = tid >> 2, ak = (tid & 3) * 4;
  const bool aok = (m0 + ar < Mrows);
  const float* arow = HID + (size_t)(offs[e] + m0 + ar) * 256;
  const int bk = tid >> 4, bn = (tid & 15) * 4;
  for (int k0 = 0; k0 < 256; k0 += 16) {
#pragma unroll
    for (int i = 0; i < 4; ++i) As[ak + i][ar] = aok ? arow[k0 + ak + i] : 0.f;
#pragma unroll
    for (int i = 0; i < 4; ++i) Bs[bk][bn + i] = wd[(size_t)(k0 + bk) * D + n0 + bn + i];
    __syncthreads();
#pragma unroll
    for (int k = 0; k < 16; ++k) {
      float a[4], b[4];
#pragma unroll
      for (int i = 0; i < 4; ++i) { a[i] = As[k][ty * 4 + i]; b[i] = Bs[k][tx * 4 + i]; }
#pragma unroll
      for (int i = 0; i < 4; ++i)
#pragma unroll
        for (int j = 0; j < 4; ++j) acc[i][j] = fmaf(a[i], b[j], acc[i][j]);
    }
    __syncthreads();
  }
#pragma unroll
  for (int i = 0; i < 4; ++i) {
    int m = m0 + ty * 4 + i;
    if (m >= Mrows) continue;
    int tok = list[e * M + m];
#pragma unroll
    for (int j = 0; j < 4; ++j) atomicAdd(&out[(size_t)tok * D + n0 + tx * 4 + j], acc[i][j]);
  }
}
}

static void sgemm(hipStream_t st, const float* A, int lda, const int* arow, const float* rs, const float* ks, const float* Bm, int ldb,
                  float* C, int ldc, const float* R, int ldr, const float* cs, const int* crow, int Mrows, int N, int K, const int* mcount, int atomic) {
  GemmP p{};
  p.A = A; p.lda = lda; p.arow = arow; p.rs = rs; p.ks = ks; p.Bm = Bm; p.ldb = ldb; p.C = C; p.ldc = ldc; p.R = R; p.ldr = ldr; p.cs = cs; p.crow = crow;
  p.Mrows = Mrows; p.N = N; p.K = K; p.mcount = mcount; p.atomic = atomic;
  dim3 grid((N + 63) / 64, (Mrows + 63) / 64);
  hipLaunchKernelGGL(k_sgemm, grid, dim3(256), 0, st, p);
}

extern "C" void kernel_launch(void* const* d_in, const int* in_sizes, int n_in, void* d_out, int out_size, void* d_ws, size_t ws_size, hipStream_t stream) {
  if (n_in != 25 || ws_size < 256 * MiB) { fprintf(stderr, "kernel_launch: unexpected n_in %d / ws %zu\n", n_in, ws_size); return; }
  const float* x = (const float*)d_in[0]; const float* mem = (const float*)d_in[1]; const float* mix_norm = (const float*)d_in[2];
  const float* w_in = (const float*)d_in[3]; const float* pool_w = (const float*)d_in[4]; const float* pool_scale = (const float*)d_in[5];
  const float* q_norm = (const float*)d_in[6]; const float* k_norm = (const float*)d_in[7]; const float* idx_k_norm = (const float*)d_in[8];
  const float* w_out = (const float*)d_in[9]; const float* xattn_norm = (const float*)d_in[10]; const float* mem_norm = (const float*)d_in[11];
  const float* wq = (const float*)d_in[12]; const float* wkv = (const float*)d_in[13]; const float* xq_norm = (const float*)d_in[14];
  const float* xk_norm = (const float*)d_in[15]; const float* wo = (const float*)d_in[16]; const float* ffn_norm = (const float*)d_in[17];
  const float* rgw = (const float*)d_in[18]; const float* rgb = (const float*)d_in[19]; const float* rew = (const float*)d_in[20]; const float* reb = (const float*)d_in[21];
  const float* wgate = (const float*)d_in[22]; const float* wup = (const float*)d_in[23]; const float* wdown = (const float*)d_in[24];
  float* out = (float*)d_out; char* ws = (char*)d_ws;
  float* U = (float*)(ws + 0 * MiB); float* Q = (float*)(ws + 32 * MiB); float* K = (float*)(ws + 64 * MiB); float* V = (float*)(ws + 96 * MiB);
  float* QI = (float*)(ws + 128 * MiB); float* KI = (float*)(ws + 160 * MiB); float* WI = (float*)(ws + 164 * MiB);
  float* rstd0 = (float*)(ws + 165 * MiB); float* rstd1 = rstd0 + M; float* rstd2 = rstd1 + M; float* rstdm = rstd2 + M;
  int* cnt = (int*)(rstdm + MR); int* offs = cnt + 32;
  unsigned long long* MASK = (unsigned long long*)(ws + 166 * MiB);
  float* SC = (float*)(ws + 176 * MiB);
  float* KVm = (float*)(ws + 240 * MiB);
  int* list = (int*)(ws + 244 * MiB);
  float* wlist = (float*)(ws + 246 * MiB);
  float* Y = out;
  float* X1 = (float*)(ws + 0 * MiB);
  float* Qm = (float*)(ws + 64 * MiB);
  float* Ox = (float*)(ws + 96 * MiB);
  float* HID = (float*)(ws + 64 * MiB);

  hipLaunchKernelGGL(k_rowrstd, dim3(M / 4), dim3(256), 0, stream, x, rstd0, M, D);
  sgemm(stream, x, D, nullptr, rstd0, mix_norm, w_in + 0, INC, U, 512, nullptr, 0, nullptr, nullptr, M, 512, D, nullptr, 0);
  sgemm(stream, x, D, nullptr, rstd0, mix_norm, w_in + 512, INC, Q, 512, nullptr, 0, nullptr, nullptr, M, 512, D, nullptr, 0);
  sgemm(stream, x, D, nullptr, rstd0, mix_norm, w_in + 1024, INC, K, 512, nullptr, 0, nullptr, nullptr, M, 512, D, nullptr, 0);
  sgemm(stream, x, D, nullptr, rstd0, mix_norm, w_in + 1536, INC, V, 512, nullptr, 0, nullptr, nullptr, M, 512, D, nullptr, 0);
  sgemm(stream, x, D, nullptr, rstd0, mix_norm, w_in + 2048, INC, QI, 512, nullptr, 0, nullptr, nullptr, M, 512, D, nullptr, 0);
  sgemm(stream, x, D, nullptr, rstd0, mix_norm, w_in + 2560, INC, KI, 64, nullptr, 0, nullptr, nullptr, M, 64, D, nullptr, 0);
  sgemm(stream, x, D, nullptr, rstd0, mix_norm, w_in + 2624, INC, WI, 8, nullptr, 0, nullptr, nullptr, M, 8, D, nullptr, 0);
  hipLaunchKernelGGL((k_headnorm<64, true>), dim3(M * 8 / 4), dim3(256), 0, stream, Q, 512, 8, q_norm, M);
  hipLaunchKernelGGL((k_headnorm<64, true>), dim3(M * 8 / 4), dim3(256), 0, stream, K, 512, 8, k_norm, M);
  hipLaunchKernelGGL((k_headnorm<64, true>), dim3(M * 8 / 4), dim3(256), 0, stream, QI, 512, 8, (const float*)nullptr, M);
  hipLaunchKernelGGL((k_headnorm<64, true>), dim3(M / 4), dim3(256), 0, stream, KI, 64, 1, idx_k_norm, M);
  hipLaunchKernelGGL(k_poolmix, dim3((unsigned)((size_t)M * 512 / 256)), dim3(256), 0, stream, U, SC);
  for (int g = 0; g < 4; ++g)
    sgemm(stream, SC + g * 128, 512, nullptr, nullptr, nullptr, pool_w + (size_t)g * 128 * 128, 128, Y + g * 128, 1024, nullptr, 0, pool_scale + g * 128, nullptr, M, 128, 128, nullptr, 0);
  for (int b = 0; b < NB; ++b) {
    hipLaunchKernelGGL(k_indexer, dim3(64, 64), dim3(256), 0, stream, QI, KI, WI, SC, b);
    hipLaunchKernelGGL(k_select, dim3(S / 4), dim3(256), 0, stream, SC, MASK, b);
  }
  hipLaunchKernelGGL(k_dsa, dim3(M), dim3(256), 0, stream, Q, K, V, MASK, Y);
  sgemm(stream, Y, 1024, nullptr, nullptr, nullptr, w_out, D, X1, D, x, D, nullptr, nullptr, M, D, D, nullptr, 0);
  hipLaunchKernelGGL(k_rowrstd, dim3(M / 4), dim3(256), 0, stream, X1, rstd1, M, D);
  hipLaunchKernelGGL(k_rowrstd, dim3(MR / 4), dim3(256), 0, stream, mem, rstdm, MR, D);
  sgemm(stream, X1, D, nullptr, rstd1, xattn_norm, wq, 512, Qm, 512, nullptr, 0, nullptr, nullptr, M, 512, D, nullptr, 0);
  sgemm(stream, mem, D, nullptr, rstdm, mem_norm, wkv, 1024, KVm, 1024, nullptr, 0, nullptr, nullptr, MR, 1024, D, nullptr, 0);
  hipLaunchKernelGGL((k_headnorm<128, false>), dim3(M * 4 / 4), dim3(256), 0, stream, Qm, 512, 4, xq_norm, M);
  hipLaunchKernelGGL((k_headnorm<128, false>), dim3(MR * 4 / 4), dim3(256), 0, stream, KVm, 1024, 4, xk_norm, MR);
  hipLaunchKernelGGL(k_xattn, dim3(M), dim3(256), 0, stream, Qm, KVm, Ox);
  sgemm(stream, Ox, 512, nullptr, nullptr, nullptr, wo, D, X1, D, X1, D, nullptr, nullptr, M, D, 512, nullptr, 0);
  hipMemcpyAsync(out, X1, (size_t)M * D * 4, hipMemcpyDeviceToDevice, stream);
  hipLaunchKernelGGL(k_rowrstd, dim3(M / 4), dim3(256), 0, stream, X1, rstd2, M, D);
  hipMemsetAsync(cnt, 0, 64 * sizeof(int), stream);
  hipLaunchKernelGGL(k_router, dim3(M / 4), dim3(256), 0, stream, X1, rstd2, ffn_norm, rgw, rgb, rew, reb, cnt, list, wlist);
  hipLaunchKernelGGL(k_offsets, dim3(1), dim3(64), 0, stream, cnt, offs);
  hipLaunchKernelGGL(k_moe_gu, dim3(4, M / 64, 32), dim3(256), 0, stream, X1, rstd2, ffn_norm, wgate, wup, cnt, offs, list, wlist, HID);
  hipLaunchKernelGGL(k_moe_down, dim3(16, M / 64, 32), dim3(256), 0, stream, HID, wdown, cnt, offs, list, out);
}
```

```cpp
#include <hip/hip_runtime.h>
#include <stdint.h>
#include <math.h>
#include <stdio.h>
#ifndef PROBE_DOUBLE
#define PROBE_DOUBLE -1
#endif
#define PH_REP(k) (PROBE_DOUBLE == (k) ? 2 : 1)
#ifndef DBG_ATTN
#define DBG_ATTN 0
#endif
#define DBG_TOL 0.03f
#define DBG_CH_RVR 1
#define DBG_CH_ABS 1
#ifndef ONE_LAUNCH
#define ONE_LAUNCH 1
#endif
#ifndef DBG_T1
#define DBG_T1 0
#endif
#ifndef DBG_T3
#define DBG_T3 0
#endif
#ifndef DBG_T2
#define DBG_T2 0
#endif

constexpr int NB = 4, S = 4096, D = 1024, M = NB * S, INC = 2632, MEMT = 256, MR = NB * MEMT;
constexpr float EPS = 1e-6f;
constexpr float C2Q = 0.125f * 1.4426950408889634f;
constexpr float IDX_SCALE = 0.125f * 0.35355339059327373f;
typedef unsigned short hbits;
typedef _Float16 h2v __attribute__((ext_vector_type(2)));
typedef _Float16 h8v __attribute__((ext_vector_type(8)));
typedef float f32x2 __attribute__((ext_vector_type(2)));
__device__ __forceinline__ unsigned pkh(float a, float b) { f32x2 v = {a, b}; return __builtin_bit_cast(unsigned, __builtin_convertvector(v, h2v)); }
__device__ __forceinline__ float h2f(hbits b) { return (float)__builtin_bit_cast(_Float16, b); }
__device__ __forceinline__ hbits f2h(float f) { return __builtin_bit_cast(hbits, (_Float16)f); }

__device__ __forceinline__ int fx_lane() { int l; asm volatile("v_mbcnt_lo_u32_b32 %0, -1, 0\n\tv_mbcnt_hi_u32_b32 %0, -1, %0" : "=v"(l)); return l; }

constexpr size_t MiB = 1u << 20;
constexpr size_t WS_CTL = 0, CTL_ZERO_BYTES = 256 * 1024;
constexpr size_t WS_ROPE = 1 * MiB;
constexpr size_t WS_SS1 = 2 * MiB, WS_SS2 = 3 * MiB;
constexpr size_t WS_RLIST = 4 * MiB, WS_RW = 6 * MiB;
constexpr size_t WS_KVRAW = 8 * MiB;
constexpr size_t WS_RSL = 8 * MiB;
constexpr size_t WS_KMEM = 12 * MiB, WS_VMEM = 13 * MiB;
constexpr size_t WS_WI = 14 * MiB;
constexpr size_t WS_MISC = 14 * MiB + 512 * 1024;
constexpr size_t WS_PWT = 15 * MiB;
constexpr size_t WS_RWT = 15 * MiB + 256 * 1024;
constexpr size_t WS_RSTD2 = 14 * MiB + 768 * 1024;
constexpr size_t WS_RMS0 = 14 * MiB + 512 * 1024;
constexpr size_t WS_HID = 76 * MiB;
constexpr size_t WS_P = 110 * MiB;
constexpr int CW_CNT = 8192; constexpr int CW_MOE = 12288;
constexpr size_t WS_WIN = 16 * MiB;
constexpr size_t WS_WOUT = 24 * MiB, WS_WQ = 26 * MiB, WS_WO = 27 * MiB;
constexpr size_t WS_WGU = 28 * MiB, WS_WD = 60 * MiB;
constexpr size_t WS_XH = 76 * MiB;
constexpr size_t WS_U = 110 * MiB, WS_QA = 126 * MiB, WS_KA = 142 * MiB, WS_VA = 158 * MiB, WS_QI = 174 * MiB, WS_KI = 190 * MiB;
constexpr size_t WS_MASK = 192 * MiB;
constexpr size_t WS_SC2 = 200 * MiB;
constexpr size_t WS_X1 = 110 * MiB;
constexpr size_t WS_X1H = 76 * MiB;
constexpr size_t WS_QM = 174 * MiB;
constexpr size_t WS_OX = 200 * MiB;
constexpr size_t WS_X2H = 216 * MiB;
constexpr size_t WS_END = 256 * MiB;
constexpr size_t SC_BATCH_ELEMS = (size_t)4096 * 64 * 65 / 2;
__host__ __device__ __forceinline__ unsigned char* sc_batch_ptr(unsigned char* ws, unsigned char* outb, int b) {
    return (b == 0) ? (outb + 32 * MiB) : (b == 1) ? (ws + 234 * MiB) : (ws + WS_SC2 + (size_t)(b - 2) * SC_BATCH_ELEMS * 2); }
static_assert(32 * MiB + SC_BATCH_ELEMS * 2 <= 64 * MiB && 234 * MiB + SC_BATCH_ELEMS * 2 <= WS_END && WS_SC2 + 2 * SC_BATCH_ELEMS * 2 <= 234 * MiB, "SC layout");
namespace pg8 {
#define PG8_LAS __attribute__((address_space(3)))
typedef unsigned short bf16_t;
typedef short bf16x8 __attribute__((ext_vector_type(8)));
typedef float f32x4 __attribute__((ext_vector_type(4)));
typedef unsigned u32x4 __attribute__((ext_vector_type(4)));
constexpr int BM = 256, BK = 64, HALF = 128, HTB = HALF * BK * 2  , STAGE_BYTES = 8 * HTB, NXCD = 8, WGM = 8;

__host__ __device__ __forceinline__ int lds_byte(int r, int c) { const int st = (r >> 4) * 2 + (c >> 5), rr = r & 15, cc = c & 31, ob = rr * 64 + cc * 2; return st * 1024 + (ob ^ (((ob >> 9) & 1) << 5)); }
__host__ __device__ __forceinline__ void stage_rc(int b, int& R, int& C) { const int st = b / 1024, sb = b % 1024, swz = sb ^ (((sb >> 9) & 1) << 5); R = (st >> 1) * 16 + swz / 64; C = (st & 1) * 32 + (swz % 64) / 2; }
__host__ __device__ __forceinline__ int perm32(int rho) { const int n = rho >> 4, i = rho & 15; return 8 * (i >> 2) + 4 * n + (i & 3); }

struct Unit { int pm, pn; };
struct Gemm { const bf16_t* A; const bf16_t* Bt; int M, N, K; const int* glist; int gvalid; };

struct StaticOrder {
    int nM, nN, nwg, G, c;
    __host__ __device__ void init(int M, int N, int G_, int c_) { nM = M / BM; nN = N / BM; nwg = nM * nN; G = G_; c = c_; }
    __host__ __device__ bool next(int i, Unit& u) const {
        const long L = (long)i * G + c; if (L >= nwg) return false;
        int wgid = (int)L; { const int q = nwg / NXCD, r = nwg % NXCD, xcd = wgid % NXCD, off = wgid / NXCD; wgid = (xcd < r ? xcd * (q + 1) : r * (q + 1) + (xcd - r) * q) + off; }
        const int nig = WGM * nN, gid = wgid / nig, fm = gid * WGM, gsz = (nM - fm) < WGM ? (nM - fm) : WGM;
        u.pm = fm + ((wgid % nig) % gsz); u.pn = (wgid % nig) / gsz; return true;
    }
    __device__ __forceinline__ void a_ready(const Unit&) const {}
    __device__ __forceinline__ void done(const Unit&) const {}
};


template <class Epi, class Sched, bool ALIGN_EPI = false, bool SP2 = false, bool GATHER = false, bool ROWLIM = false>
__device__ __forceinline__ void gemm_phase(PG8_LAS unsigned char* lds, const Gemm g, const Sched& S, const Epi& E, int wid_in) {
    const int lane = fx_lane(), wid = wid_in, tid = wid * 64 + lane, wr = wid >> 2, wc = wid & 3, fr = lane & 15, fq = lane >> 4;
    const int K = g.K, nt = K / BK;
    const bool skip_hi_ = ROWLIM && (g.gvalid <= 128 || (g.gvalid <= 192 && wr == 1)), skip_lo_ = ROWLIM && (g.gvalid <= 64 && wr == 1);
    unsigned voffA[2], voffB[2];
#pragma unroll
    for (int i = 0; i < 2; ++i) { int R, C; stage_rc(tid * 16 + i * 8192, R, C); const int Rb = Epi::PERM ? ((R & ~31) + perm32(R & 31)) : R;
        voffA[i] = (unsigned)(R * K + C) * 2u; voffB[i] = (unsigned)(Rb * K + C) * 2u; }
    unsigned voffA0[2], voffA1[2];
#pragma unroll
    for (int i = 0; i < 2; ++i) {
        if constexpr (GATHER) { int R, C; stage_rc(tid * 16 + i * 8192, R, C);
            const bool ok0_ = R < g.gvalid, ok1_ = R + HALF < g.gvalid;
            const int e0_ = g.glist[ok0_ ? R : 0], e1_ = g.glist[ok1_ ? R + HALF : 0];
            const int t0 = ok0_ ? (e0_ >> 1) : 0, t1 = ok1_ ? (e1_ >> 1) : 0;
            voffA0[i] = (unsigned)(t0 * K + C) * 2u; voffA1[i] = (unsigned)(t1 * K + C) * 2u; }
        else { voffA0[i] = voffA[i]; voffA1[i] = voffA[i]; }
    }
    const size_t kstep = (size_t)(BK * 2);
    const size_t hstep = (size_t)HALF * K * 2;
    const size_t tstep = 2 * hstep; const size_t hstepA = GATHER ? (size_t)0 : hstep;
    const unsigned ldsw = (unsigned)wid * 1024u;
    const int aoff = lds_byte(wr * 64 + fr, fq * 8), boff = lds_byte(wc * 32 + fr, fq * 8);
#define PG8_SA(b, h) (((b) * 2 + (h)) * HTB)
#define PG8_SB(b, h) ((4 + (b) * 2 + (h)) * HTB)
#define PG8_STAGE(bufoff, gbase, voff) do { _Pragma("unroll") for (int _i = 0; _i < 2; ++_i) \
        __builtin_amdgcn_global_load_lds((const unsigned*)((const char*)(gbase) + (voff)[_i]), (PG8_LAS unsigned*)(lds + (bufoff) + ldsw + _i * 8192), 16, 0, 0); } while (0)
#define PG8_LDA(dst, b, h) do { _Pragma("unroll") for (int m = 0; m < 4; ++m) _Pragma("unroll") for (int k = 0; k < 2; ++k) dst[m][k] = *(const PG8_LAS bf16x8*)(lds + PG8_SA(b, h) + aoff + m * 2048 + k * 1024); } while (0)
#define PG8_LDB(dst, b, h) do { _Pragma("unroll") for (int n = 0; n < 2; ++n) _Pragma("unroll") for (int k = 0; k < 2; ++k) dst[n][k] = *(const PG8_LAS bf16x8*)(lds + PG8_SB(b, h) + boff + n * 2048 + k * 1024); } while (0)
#define PG8_MMA(ai, bj, At, Bt) do { if (ROWLIM && ((ai) == 1 ? skip_hi_ : skip_lo_)) break; __builtin_amdgcn_s_setprio(1); _Pragma("unroll") for (int m = 0; m < 4; ++m) _Pragma("unroll") for (int n = 0; n < 2; ++n) _Pragma("unroll") for (int k = 0; k < 2; ++k) \
        acc[ai][bj][m][n] = __builtin_amdgcn_mfma_f32_16x16x32_f16(__builtin_bit_cast(h8v, Bt[n][k]), __builtin_bit_cast(h8v, At[m][k]), acc[ai][bj][m][n], 0, 0, 0); __builtin_amdgcn_s_setprio(0); } while (0)
#define PG8_WAIT_V(n) asm volatile("s_waitcnt vmcnt(" #n ")" ::: "memory")
#define PG8_WAIT_L(n) asm volatile("s_waitcnt lgkmcnt(" #n ")" ::: "memory")
#define PG8_BAR __builtin_amdgcn_s_barrier()
#define PG8_SCHED __builtin_amdgcn_sched_barrier(0)
    Unit cur, nxt; int ui = 0;
    if (!S.next(0, cur)) return;
    f32x4 acc[2][2][4][2];
#pragma unroll
    for (int a = 0; a < 2; ++a)
#pragma unroll
        for (int b = 0; b < 2; ++b)
#pragma unroll
            for (int m = 0; m < 4; ++m)
#pragma unroll
                for (int n = 0; n < 2; ++n) acc[a][b][m][n] = (f32x4){0.f, 0.f, 0.f, 0.f};
    bf16x8 At[4][2], B0[2][2], B1[2][2];
    const char* cA = (const char*)g.A + (GATHER ? (size_t)0 : (size_t)cur.pm * tstep); const char* cB = (const char*)g.Bt + (size_t)cur.pn * tstep;
    S.a_ready(cur);
    if constexpr (SP2) {
        PG8_STAGE(PG8_SB(0, 0), cB, voffB); PG8_STAGE(PG8_SB(0, 1), cB + hstep, voffB); PG8_STAGE(PG8_SA(0, 0), cA, voffA0); PG8_STAGE(PG8_SA(0, 1), cA + hstepA, voffA1);
        if (wr == 1) PG8_BAR;
        PG8_WAIT_V(2); PG8_BAR;
        PG8_STAGE(PG8_SB(1, 0), cB + kstep, voffB); PG8_STAGE(PG8_SA(1, 0), cA + kstep, voffA0); PG8_STAGE(PG8_SB(1, 1), cB + hstep + kstep, voffB);
        PG8_WAIT_V(6); PG8_BAR;
    } else {
        PG8_STAGE(PG8_SB(0, 0), cB, voffB); PG8_STAGE(PG8_SA(0, 0), cA, voffA0); PG8_STAGE(PG8_SB(0, 1), cB + hstep, voffB); PG8_STAGE(PG8_SA(0, 1), cA + hstepA, voffA1);
        if (wr == 1) PG8_BAR;
        PG8_WAIT_V(4); PG8_BAR;
        PG8_STAGE(PG8_SB(1, 0), cB + kstep, voffB); PG8_STAGE(PG8_SA(1, 0), cA + kstep, voffA0); PG8_STAGE(PG8_SB(1, 1), cB + hstep + kstep, voffB);
        PG8_WAIT_V(6); PG8_BAR;
    }
    for (;;) {
        const bool has_next = S.next(ui + 1, nxt);
        const char* nA = (has_next && !GATHER) ? (const char*)g.A + (size_t)nxt.pm * tstep : cA; const char* nB = has_next ? (const char*)g.Bt + (size_t)nxt.pn * tstep : cB;
        for (int t = 0; t < nt; t += 2) {
            const bool last = (t == nt - 2);
            const char* a1 = cA + (size_t)(t + 1) * kstep;
            const char* a2 = last ? nA : cA + (size_t)(t + 2) * kstep; const char* b2 = last ? nB : cB + (size_t)(t + 2) * kstep;
            const char* a3 = a2 + kstep; const char* b3 = b2 + kstep;
            if (last && has_next) S.a_ready(nxt);
            if constexpr (SP2) {
            PG8_LDB(B0, 0, 0); PG8_LDB(B1, 0, 1); PG8_SCHED; PG8_LDA(At, 0, 0); PG8_STAGE(PG8_SA(1, 1), a1 + hstepA, voffA1);
            PG8_WAIT_V(8); PG8_WAIT_L(0); PG8_BAR; PG8_MMA(0, 0, At, B0); PG8_MMA(0, 1, At, B1); PG8_BAR; PG8_SCHED;
            PG8_LDA(At, 0, 1); PG8_STAGE(PG8_SB(0, 0), b2, voffB); PG8_STAGE(PG8_SB(0, 1), b2 + hstep, voffB); PG8_STAGE(PG8_SA(0, 0), a2, voffA0);
            PG8_WAIT_V(8); PG8_WAIT_L(0); PG8_BAR; PG8_MMA(1, 0, At, B0); PG8_MMA(1, 1, At, B1); PG8_BAR; PG8_SCHED;
            PG8_LDB(B0, 1, 0); PG8_LDB(B1, 1, 1); PG8_SCHED; PG8_LDA(At, 1, 0); PG8_STAGE(PG8_SA(0, 1), a2 + hstepA, voffA1);
            PG8_WAIT_V(8); PG8_WAIT_L(0); PG8_BAR; PG8_MMA(0, 0, At, B0); PG8_MMA(0, 1, At, B1); PG8_BAR; PG8_SCHED;
            PG8_LDA(At, 1, 1); PG8_STAGE(PG8_SB(1, 0), b3, voffB); PG8_STAGE(PG8_SB(1, 1), b3 + hstep, voffB); PG8_STAGE(PG8_SA(1, 0), a3, voffA0);
            PG8_WAIT_V(8); PG8_WAIT_L(0); PG8_BAR; PG8_MMA(1, 0, At, B0); PG8_MMA(1, 1, At, B1); PG8_BAR; PG8_SCHED;
            } else {
            PG8_LDB(B0, 0, 0); PG8_SCHED; PG8_LDA(At, 0, 0); PG8_STAGE(PG8_SA(1, 1), a1 + hstepA, voffA1);
            PG8_WAIT_L(8); PG8_BAR; PG8_WAIT_L(0); PG8_MMA(0, 0, At, B0); PG8_BAR; PG8_SCHED;
            PG8_LDB(B1, 0, 1); PG8_STAGE(PG8_SB(0, 0), b2, voffB);
            PG8_BAR; PG8_WAIT_L(0); PG8_MMA(0, 1, At, B1); PG8_BAR;
            PG8_LDA(At, 0, 1); PG8_STAGE(PG8_SA(0, 0), a2, voffA0);
            PG8_BAR; PG8_WAIT_L(0); PG8_MMA(1, 0, At, B0); PG8_BAR; PG8_SCHED;
            PG8_STAGE(PG8_SB(0, 1), b2 + hstep, voffB);
            PG8_WAIT_V(6); PG8_BAR; PG8_MMA(1, 1, At, B1); PG8_BAR;
            PG8_LDB(B0, 1, 0); PG8_SCHED; PG8_LDA(At, 1, 0); PG8_STAGE(PG8_SA(0, 1), a2 + hstepA, voffA1);
            PG8_WAIT_L(8); PG8_BAR; PG8_WAIT_L(0); PG8_MMA(0, 0, At, B0); PG8_BAR; PG8_SCHED;
            PG8_LDB(B1, 1, 1); PG8_STAGE(PG8_SB(1, 0), b3, voffB);
            PG8_BAR; PG8_WAIT_L(0); PG8_MMA(0, 1, At, B1); PG8_BAR;
            PG8_LDA(At, 1, 1); PG8_STAGE(PG8_SA(1, 0), a3, voffA0);
            PG8_BAR; PG8_WAIT_L(0); PG8_MMA(1, 0, At, B0); PG8_BAR; PG8_SCHED;
            PG8_STAGE(PG8_SB(1, 1), b3 + hstep, voffB);
            PG8_WAIT_V(6); PG8_BAR; PG8_MMA(1, 1, At, B1); PG8_BAR;
            }
        }
        if constexpr (ALIGN_EPI) { if (wr == 0) PG8_BAR; }
        if constexpr (!Epi::AFTER_DRAIN) { int l2_ = lane; asm volatile("" : "+v"(l2_)); E(acc, cur, wr, wc, l2_ & 15, l2_ >> 4); S.done(cur); }
        if (!has_next) break;
#pragma unroll
        for (int a = 0; a < 2; ++a)
#pragma unroll
            for (int b = 0; b < 2; ++b)
#pragma unroll
                for (int m = 0; m < 4; ++m)
#pragma unroll
                    for (int n = 0; n < 2; ++n) acc[a][b][m][n] = (f32x4){0.f, 0.f, 0.f, 0.f};
        cur = nxt; cA = nA; cB = nB; ++ui;
        if constexpr (ALIGN_EPI) { if (wr == 1) PG8_BAR; }
    }
    PG8_WAIT_V(0);
    if constexpr (!ALIGN_EPI) { if (wr == 0) PG8_BAR; }
    PG8_BAR;
    if constexpr (Epi::AFTER_DRAIN) { E.fused(acc, cur, wr, wc, fr, fq, lds, wid, lane); S.done(cur); }
#undef PG8_SA
#undef PG8_SB
#undef PG8_STAGE
#undef PG8_LDA
#undef PG8_LDB
#undef PG8_MMA
#undef PG8_WAIT_V
#undef PG8_WAIT_L
#undef PG8_BAR
#undef PG8_SCHED
}
}

#ifndef PG8_SP2
#define PG8_SP2 true
#endif
#ifndef PG8_ALIGN
#define PG8_ALIGN true
#endif
namespace pg8 {
template <bool NORM>
__device__ __forceinline__ void head_store(const f32x4 (&acc)[2][2][4][2], int row0, hbits* dst, int ldd, int col0, const float* gain, float scale, int fq,
                                           const float* __restrict__ cosT, const float* __restrict__ sinT) {
    f32x4 g[2][2];
    if (NORM) {
#pragma unroll
        for (int bj = 0; bj < 2; ++bj)
#pragma unroll
            for (int n = 0; n < 2; ++n) g[bj][n] = *(const f32x4*)(gain + 32 * bj + 8 * fq + 4 * n);
    }
#pragma unroll
    for (int ai = 0; ai < 2; ++ai)
#pragma unroll
        for (int mp = 0; mp < 2; ++mp) {
            f32x4 cc[2][2], sn[2][2];
#pragma unroll
            for (int mi = 0; mi < 2; ++mi) { const int pos = (row0 + ai * HALF + (2 * mp + mi) * 16) & (S - 1);
#pragma unroll
                for (int n = 0; n < 2; ++n) { cc[mi][n] = *(const f32x4*)(cosT + pos * 32 + 8 * fq + 4 * n); sn[mi][n] = *(const f32x4*)(sinT + pos * 32 + 8 * fq + 4 * n); } }
#pragma unroll
            for (int mi = 0; mi < 2; ++mi) {
            const int m = 2 * mp + mi;
            const int row = row0 + ai * HALF + m * 16;
            f32x4 v[2][2];
#pragma unroll
            for (int bj = 0; bj < 2; ++bj)
#pragma unroll
                for (int n = 0; n < 2; ++n) v[bj][n] = acc[ai][bj][m][n];
            if (NORM) {
                float ss = 0.f;
#pragma unroll
                for (int bj = 0; bj < 2; ++bj)
#pragma unroll
                    for (int n = 0; n < 2; ++n) ss += (v[bj][n][0] * v[bj][n][0] + v[bj][n][1] * v[bj][n][1]) + (v[bj][n][2] * v[bj][n][2] + v[bj][n][3] * v[bj][n][3]);
                ss += __shfl_xor(ss, 16); ss += __shfl_xor(ss, 32);
                const float r = rsqrtf(ss * (1.0f / 64.0f) + EPS);
#pragma unroll
                for (int bj = 0; bj < 2; ++bj)
#pragma unroll
                    for (int n = 0; n < 2; ++n) v[bj][n] = v[bj][n] * r * g[bj][n];
            }
            f32x4 olo[2], ohi[2];
#pragma unroll
            for (int n = 0; n < 2; ++n) {
                const f32x4 c = cc[mi][n], s = sn[mi][n];
                olo[n] = (v[0][n] * c - v[1][n] * s) * scale; ohi[n] = (v[1][n] * c + v[0][n] * s) * scale;
            }
            u32x4 w0, w1;
            w0.x = pkh(olo[0][0], olo[0][1]); w0.y = pkh(olo[0][2], olo[0][3]); w0.z = pkh(olo[1][0], olo[1][1]); w0.w = pkh(olo[1][2], olo[1][3]);
            w1.x = pkh(ohi[0][0], ohi[0][1]); w1.y = pkh(ohi[0][2], ohi[0][3]); w1.z = pkh(ohi[1][0], ohi[1][1]); w1.w = pkh(ohi[1][2], ohi[1][3]);
            hbits* p = dst + (size_t)row * ldd + col0;
            *(u32x4*)p = w0; *(u32x4*)(p + 32) = w1;
            }
        }
}
__device__ __forceinline__ void plain_store_h(const f32x4 (&acc)[2][2][4][2], int row0, hbits* dst, int ldd, int col0) {
#pragma unroll
    for (int ai = 0; ai < 2; ++ai)
#pragma unroll
        for (int m = 0; m < 4; ++m) {
            hbits* p = dst + (size_t)(row0 + ai * HALF + m * 16) * ldd + col0;
#pragma unroll
            for (int bj = 0; bj < 2; ++bj) {
                const f32x4 v0 = acc[ai][bj][m][0], v1 = acc[ai][bj][m][1];
                u32x4 w; w.x = pkh(v0[0], v0[1]); w.y = pkh(v0[2], v0[3]); w.z = pkh(v1[0], v1[1]); w.w = pkh(v1[2], v1[3]);
                *(u32x4*)(p + bj * HALF) = w;
            }
        }
}
struct EpiIn {
    static constexpr bool PERM = true, AFTER_DRAIN = false;
    hbits *U, *Qa, *Ka, *Va, *Qi, *Ki; float *WI, *KVraw;
    const float *cosT, *sinT, *qg, *kg, *kig;
    __device__ __forceinline__ void operator()(const f32x4 (&acc)[2][2][4][2], const Unit& u, int wr, int wc, int fr, int fq) const {
        const int pn = u.pn;
        if (u.pm >= 64) {
            const int row0 = (u.pm - 64) * BM + wr * 64 + fr, col0 = (pn - 11) * BM + wc * 32 + 8 * fq;
#pragma unroll
            for (int ai = 0; ai < 2; ++ai)
#pragma unroll
                for (int m = 0; m < 4; ++m) { float* p = KVraw + (size_t)(row0 + ai * HALF + m * 16) * 1024 + col0;
#pragma unroll
                    for (int bj = 0; bj < 2; ++bj) { *(f32x4*)(p + bj * HALF) = acc[ai][bj][m][0]; *(f32x4*)(p + bj * HALF + 4) = acc[ai][bj][m][1]; } }
            return;
        }
        const int row0 = u.pm * BM + wr * 64 + fr;
        if (pn < 2) { plain_store_h(acc, row0, U, 512, pn * BM + wc * 32 + 8 * fq); }
        else if (pn == 6 || pn == 7) { plain_store_h(acc, row0, Va, 512, (pn - 6) * BM + wc * 32 + 8 * fq); }
        else if (pn == 2 || pn == 3) { head_store<true>(acc, row0, Qa, 512, (4 * (pn & 1) + wc) * 64 + 8 * fq, qg, C2Q, fq, cosT, sinT); }
        else if (pn == 4 || pn == 5) { head_store<true>(acc, row0, Ka, 512, (4 * (pn & 1) + wc) * 64 + 8 * fq, kg, 1.0f, fq, cosT, sinT); }
        else if (pn == 8 || pn == 9) { head_store<false>(acc, row0, Qi, 512, (4 * (pn & 1) + wc) * 64 + 8 * fq, nullptr, 1.0f, fq, cosT, sinT); }
        else {
            if (wc == 0) head_store<true>(acc, row0, Ki, 64, 8 * fq, kig, 1.0f, fq, cosT, sinT);
            else if (wc == 1 && fq == 0) {
#pragma unroll
                for (int ai = 0; ai < 2; ++ai)
#pragma unroll
                    for (int m = 0; m < 4; ++m) { float* p = WI + (size_t)(row0 + ai * HALF + m * 16) * 8;
                        *(f32x4*)p = acc[ai][0][m][0] * IDX_SCALE; *(f32x4*)(p + 4) = acc[ai][0][m][1] * IDX_SCALE; }
            }
        }
    }
};
struct SchedIn {
    StaticOrder so; int G, c;
    __device__ void init(int G_, int c_) { so.init(M, 2816, G_, c_); G = G_; c = c_; }
    __device__ bool next(int i, Unit& u) const {
        if (so.next(i, u)) return true;
        const long L = (long)i * G + c - 704; if (L >= 16) return false;
        u.pm = 64 + (int)(L >> 2); u.pn = 11 + (int)(L & 3); return true;
    }
    __device__ __forceinline__ void a_ready(const Unit&) const {}
    __device__ __forceinline__ void done(const Unit&) const {}
};
template <bool RH, bool RS = false>
struct EpiRes {
    static constexpr bool PERM = true, AFTER_DRAIN = false;
    const void* resid; hbits* outh; float* ss; const float* rs;
    __device__ __forceinline__ void operator()(const f32x4 (&acc)[2][2][4][2], const Unit& u, int wr, int wc, int fr, int fq) const {
        const int row0 = u.pm * BM + wr * 64 + fr, col0 = u.pn * BM + wc * 32 + 8 * fq;
#pragma unroll
        for (int ai = 0; ai < 2; ++ai)
#pragma unroll
            for (int mp = 0; mp < 2; ++mp) {
                float rsv[2] = {1.f, 1.f};
                if (RS) { rsv[0] = rs[row0 + ai * HALF + (2 * mp) * 16]; rsv[1] = rs[row0 + ai * HALF + (2 * mp + 1) * 16]; }
                f32x4 r0[2][2], r1[2][2];
#pragma unroll
                for (int mi = 0; mi < 2; ++mi) { const int m = 2 * mp + mi; const size_t off = (size_t)(row0 + ai * HALF + m * 16) * D + col0;
#pragma unroll
                    for (int bj = 0; bj < 2; ++bj) {
                        if (RH) { const u32x4 rv = *(const u32x4*)((const hbits*)resid + off + bj * HALF); const unsigned a = rv.x, b = rv.y, c = rv.z, d = rv.w;
                            const h2v h0 = __builtin_bit_cast(h2v, a), h1 = __builtin_bit_cast(h2v, b), h2 = __builtin_bit_cast(h2v, c), h3 = __builtin_bit_cast(h2v, d);
                            r0[mi][bj] = (f32x4){(float)h0[0], (float)h0[1], (float)h1[0], (float)h1[1]}; r1[mi][bj] = (f32x4){(float)h2[0], (float)h2[1], (float)h3[0], (float)h3[1]}; }
                        else { r0[mi][bj] = *(const f32x4*)((const float*)resid + off + bj * HALF); r1[mi][bj] = *(const f32x4*)((const float*)resid + off + bj * HALF + 4); } } }
#pragma unroll
                for (int mi = 0; mi < 2; ++mi) { const int m = 2 * mp + mi; const int row = row0 + ai * HALF + m * 16; const size_t off = (size_t)row * D + col0; float q = 0.f;
#pragma unroll
                    for (int bj = 0; bj < 2; ++bj) {
                        const f32x4 v0 = (RS ? r0[mi][bj] * rsv[mi] : r0[mi][bj]) + acc[ai][bj][m][0], v1 = (RS ? r1[mi][bj] * rsv[mi] : r1[mi][bj]) + acc[ai][bj][m][1];
                        u32x4 w; w.x = pkh(v0[0], v0[1]); w.y = pkh(v0[2], v0[3]); w.z = pkh(v1[0], v1[1]); w.w = pkh(v1[2], v1[3]);
                        *(u32x4*)(outh + off + bj * HALF) = w;
                        q += (v0[0] * v0[0] + v0[1] * v0[1]) + (v0[2] * v0[2] + v0[3] * v0[3]) + (v1[0] * v1[0] + v1[1] * v1[1]) + (v1[2] * v1[2] + v1[3] * v1[3]);
                    }
                    q += __shfl_xor(q, 16); q += __shfl_xor(q, 32);
                    if (fq == 0) ss[(size_t)row * 16 + u.pn * 4 + wc] = q; }
            }
    }
};
struct EpiWq {
    static constexpr bool PERM = true, AFTER_DRAIN = false;
    const float* ss; hbits* out;
    __device__ __forceinline__ void operator()(const f32x4 (&acc)[2][2][4][2], const Unit& u, int wr, int wc, int fr, int fq) const {
        const int row0 = u.pm * BM + wr * 64 + fr, col0 = u.pn * BM + wc * 32 + 8 * fq;
        f32x4 pv[2][4];
#pragma unroll
        for (int ai = 0; ai < 2; ++ai)
#pragma unroll
            for (int m = 0; m < 4; ++m) pv[ai][m] = *(const f32x4*)(ss + (size_t)(row0 + ai * HALF + m * 16) * 16 + 4 * fq);
#pragma unroll
        for (int ai = 0; ai < 2; ++ai)
#pragma unroll
            for (int m = 0; m < 4; ++m) {
                const int row = row0 + ai * HALF + m * 16;
                float t = (pv[ai][m][0] + pv[ai][m][1]) + (pv[ai][m][2] + pv[ai][m][3]);
                t += __shfl_xor(t, 16); t += __shfl_xor(t, 32);
                const float r = rsqrtf(t * (1.0f / 1024.0f) + EPS);
                hbits* p = out + (size_t)row * 512 + col0;
#pragma unroll
                for (int bj = 0; bj < 2; ++bj) { const f32x4 v0 = acc[ai][bj][m][0] * r, v1 = acc[ai][bj][m][1] * r;
                    u32x4 w; w.x = pkh(v0[0], v0[1]); w.y = pkh(v0[2], v0[3]); w.z = pkh(v1[0], v1[1]); w.w = pkh(v1[2], v1[3]);
                    *(u32x4*)(p + bj * HALF) = w; }
            }
    }
};

struct SchedTwo {
    Unit ua, ub; int n;
    __device__ bool next(int i, Unit& u) const { if (i >= n) return false; u = i ? ub : ua; return true; }
    __device__ __forceinline__ void a_ready(const Unit&) const {}
    __device__ __forceinline__ void done(const Unit&) const {}
};
struct SchedOne {
    Unit un;
    __device__ bool next(int i, Unit& u) const { if (i != 0) return false; u = un; return true; }
    __device__ __forceinline__ void a_ready(const Unit&) const {}
    __device__ __forceinline__ void done(const Unit&) const {}
};
struct EpiGU {
    static constexpr bool PERM = true, AFTER_DRAIN = false;
    hbits* HID; const float* gw; const float* grs; int nvalid, hidrow0;
    __device__ __forceinline__ void operator()(const f32x4 (&acc)[2][2][4][2], const Unit& u, int wr, int wc, int fr, int fq) const {
#pragma unroll
        for (int ai = 0; ai < 2; ++ai) {
            float rr_[4], ww_[4];
#pragma unroll
            for (int i = 0; i < 4; ++i) { const int rl = wr * 64 + fr + ai * HALF + i * 16; const int rc = (rl < nvalid) ? rl : 0; ww_[i] = gw[rc]; rr_[i] = grs[rc]; }
#pragma unroll
            for (int i = 0; i < 4; ++i) { const int rl = wr * 64 + fr + ai * HALF + i * 16; const bool ok = rl < nvalid; ww_[i] = ok ? ww_[i] : 0.f; rr_[i] = ok ? rr_[i] : 0.f; }
#pragma unroll
            for (int m = 0; m < 4; ++m) {
                const int rl = wr * 64 + fr + ai * HALF + m * 16;
                const float r = rr_[m], w = ww_[m];
                f32x4 h[2];
#pragma unroll
                for (int n = 0; n < 2; ++n) {
                    const f32x4 g = acc[ai][0][m][n] * r, uu = acc[ai][1][m][n] * r;
#pragma unroll
                    for (int j = 0; j < 4; ++j) { const float sg = g[j] * __builtin_amdgcn_rcpf(1.0f + __builtin_amdgcn_exp2f(-1.4426950408889634f * g[j])); h[n][j] = sg * uu[j] * w; }
                }
                u32x4 o; o.x = pkh(h[0][0], h[0][1]); o.y = pkh(h[0][2], h[0][3]); o.z = pkh(h[1][0], h[1][1]); o.w = pkh(h[1][2], h[1][3]);
                { hbits* hp_ = HID + (size_t)(hidrow0 + rl) * 256 + 128 * (u.pn & 1) + 32 * wc + 8 * fq;
                  asm volatile("global_store_dwordx4 %0, %1, off sc0 sc1\n\ts_nop 1" :: "v"(hp_), "v"(o) : "memory"); }
            }
        }
    }
};
struct MoeTab { const PG8_LAS int* TB; const PG8_LAS int* TC; int TT;
    __device__ __forceinline__ int expert_of(int tile) const { int e = 0;
#pragma unroll 1
        for (int i = 1; i < 32; ++i) if (TB[i] <= tile) e = i; return e; } };
struct SchedList {
    const PG8_LAS int* UL; int n;
    __device__ bool next(int i, Unit& u) const { if (i >= n) return false; u.pm = __builtin_amdgcn_readfirstlane(UL[2 * i]); u.pn = __builtin_amdgcn_readfirstlane(UL[2 * i + 1]); return true; }
    __device__ __forceinline__ void a_ready(const Unit&) const {}
    __device__ __forceinline__ void done(const Unit&) const {}
};
struct EpiDown {
    static constexpr bool PERM = true, AFTER_DRAIN = false;
    MoeTab tab; const int* rlist; hbits* P;
    __device__ __forceinline__ void operator()(const f32x4 (&acc)[2][2][4][2], const Unit& u, int wr, int wc, int fr, int fq) const {
        const int e = u.pn >> 2, cn = u.pn & 3, rt = u.pm - __builtin_amdgcn_readfirstlane(tab.TB[e]), nvalid = __builtin_amdgcn_readfirstlane(tab.TC[e]) - rt * 256;
        const int* gl = rlist + (size_t)e * M + rt * 256;
#pragma unroll
        for (int ai = 0; ai < 2; ++ai) {
            int ent_[4];
#pragma unroll
            for (int i = 0; i < 4; ++i) { const int rl = wr * 64 + fr + ai * HALF + i * 16; ent_[i] = gl[(rl < nvalid) ? rl : 0]; }
#pragma unroll
            for (int i = 0; i < 4; ++i) { const int rl = wr * 64 + fr + ai * HALF + i * 16; ent_[i] = (rl < nvalid) ? ent_[i] : -1; }
#pragma unroll
            for (int m = 0; m < 4; ++m) {
                const int ent = ent_[m];
                if (ent >= 0) {
                    hbits* p = P + ((size_t)(ent & 1) * M + (ent >> 1)) * D + cn * BM + 32 * wc + 8 * fq;
#pragma unroll
                    for (int bj = 0; bj < 2; ++bj) { const f32x4 v0 = acc[ai][bj][m][0], v1 = acc[ai][bj][m][1];
                        u32x4 w; w.x = pkh(v0[0], v0[1]); w.y = pkh(v0[2], v0[3]); w.z = pkh(v1[0], v1[1]); w.w = pkh(v1[2], v1[3]);
                        __builtin_nontemporal_store(w, (u32x4*)(p + bj * HALF)); }
                }
            }
        }
    }
};
}
namespace attn_body {
using bf16=unsigned short;
using bf16x8=__attribute__((ext_vector_type(8)))short;
using s16x4=__attribute__((ext_vector_type(4)))short;
using f32x16=__attribute__((ext_vector_type(16)))float;
using u32x4=__attribute__((ext_vector_type(4)))unsigned;
constexpr int BATCH=4,NHEAD=8,SEQ=4096,D=64,DM=NHEAD*D,OPITCH=1024,OCOL0=512;
constexpr int NW=8,QBLK=32,QB=QBLK*NW,KVBLK=64,NQB=SEQ/QB;
constexpr int ATTN_PITCH=DM, ATTN_UNIT_ROWS=QB;
__device__ __forceinline__ int crow(int r,int hi){return (r&3)+8*(r>>2)+4*hi;}
#define SBAR() __builtin_amdgcn_sched_barrier(0)
#define MFMA16H(a,b,c,x,y,z) __builtin_amdgcn_mfma_f32_32x32x16_f16(__builtin_bit_cast(h8v,(a)),__builtin_bit_cast(h8v,(b)),(c),0,0,0)
constexpr int NSLOT=3, SLOTB=8192;
constexpr int LDS_K=0, LDS_V=NSLOT*SLOTB, LDS_WS=2*NSLOT*SLOTB, LDS_OST=LDS_WS+NW*64*4, LDS_BYTES=LDS_OST+NW*4096;
constexpr float C2=0.125f*1.4426950408889634f;
__device__ __forceinline__ void glds16(const void*gsrc,unsigned lds_dst){unsigned keep;
  asm volatile("s_mov_b32 %0, m0\n\ts_mov_b32 m0, %2\n\ts_nop 0\n\tglobal_load_lds_dwordx4 %1, off\n\ts_mov_b32 m0, %0":"=&s"(keep):"v"(gsrc),"s"(lds_dst):"memory");}
__device__ __forceinline__ float max3f(float a,float b,float c){float r;asm("v_max3_f32 %0, %1, %2, %3":"=v"(r):"v"(a),"v"(b),"v"(c));return r;}
__device__ __forceinline__ float max2f(float a,float b){float r;asm("v_max_f32_e32 %0, %1, %2":"=v"(r):"v"(a),"v"(b));return r;}
__device__ __forceinline__ float fadd_s(float a,float b){float r;asm("v_add_f32_e32 %0, %1, %2":"=v"(r):"v"(a),"v"(b));return r;}
__device__ __forceinline__ float fsub_s(float a,float b){float r;asm("v_sub_f32_e32 %0, %1, %2":"=v"(r):"v"(a),"v"(b));return r;}
__device__ __forceinline__ unsigned cvtpk_s(float lo,float hi){return pkh(lo,hi);}
#define WAIT_BAR(N) asm volatile("s_waitcnt vmcnt(" #N ") lgkmcnt(0)\n\ts_barrier":::"memory")
#define WAIT_BARM(N,MK) asm volatile("s_waitcnt vmcnt(" #N ") lgkmcnt(0)\n\ts_barrier":"+v"(MK)::"memory")

__device__ __forceinline__ void qkt(f32x16&p0,f32x16&p1,const char*Kslot,const bf16x8*qr,const f32x16&negm,int r32,int hi){
  const char*kb=Kslot+hi*1024+r32*16;
  #pragma unroll
  for(int d0=0;d0<4;++d0){
    const bf16x8 b0=*reinterpret_cast<const bf16x8*>(kb+d0*2048);
    const bf16x8 b1=*reinterpret_cast<const bf16x8*>(kb+d0*2048+512);
    if(d0==0){p0=MFMA16H(b0,qr[0],negm,0,0,0);p1=MFMA16H(b1,qr[0],negm,0,0,0);}
    else{p0=MFMA16H(b0,qr[d0],p0,0,0,0);p1=MFMA16H(b1,qr[d0],p1,0,0,0);}}
}
typedef __attribute__((address_space(3))) const char* lds_cptr;
typedef short v4i16_t __attribute__((ext_vector_type(4)));
__device__ __forceinline__ void kload8(bf16x8*kf,lds_cptr kp){
  kf[0]=*(const __attribute__((address_space(3))) bf16x8*)(kp);      kf[1]=*(const __attribute__((address_space(3))) bf16x8*)(kp+512);
  kf[2]=*(const __attribute__((address_space(3))) bf16x8*)(kp+2048); kf[3]=*(const __attribute__((address_space(3))) bf16x8*)(kp+2560);
  kf[4]=*(const __attribute__((address_space(3))) bf16x8*)(kp+4096); kf[5]=*(const __attribute__((address_space(3))) bf16x8*)(kp+4608);
  kf[6]=*(const __attribute__((address_space(3))) bf16x8*)(kp+6144); kf[7]=*(const __attribute__((address_space(3))) bf16x8*)(kp+6656);
}
__device__ __forceinline__ void kload2(bf16x8*kf,lds_cptr kp,int j){ kf[2*j]=*(const __attribute__((address_space(3))) bf16x8*)(kp+j*2048); kf[2*j+1]=*(const __attribute__((address_space(3))) bf16x8*)(kp+j*2048+512); }
__device__ __forceinline__ s16x4 vtr(lds_cptr p){ return __builtin_bit_cast(s16x4,__builtin_amdgcn_ds_read_tr16_b64_v4i16((__attribute__((address_space(3))) v4i16_t*)p)); }
__device__ __forceinline__ float rowmax(const f32x16&p0,const f32x16&p1){
  float a=max3f(p0[0],p0[1],p1[0]),b=max3f(p0[2],p0[3],p1[1]);a=max3f(a,p1[2],p1[3]);
  #pragma unroll
  for(int r=4;r<16;r+=4){a=max3f(a,p0[r],p0[r+1]);b=max3f(b,p0[r+2],p0[r+3]);a=max3f(a,p1[r],p1[r+1]);b=max3f(b,p1[r+2],p1[r+3]);}
  const float m=max2f(a,b);
  auto rr=__builtin_amdgcn_permlane32_swap(__float_as_uint(m),__float_as_uint(m),false,false);
  return max2f(__uint_as_float(rr[0]),__uint_as_float(rr[1]));
}
__device__ __forceinline__ void pv(f32x16*o,int vb,bf16x8 pa0,bf16x8 pa1,bf16x8 pa2,bf16x8 pa3){
  #pragma unroll
  for(int d0=0;d0<2;++d0){s16x4 lo[4],hi[4];
    #pragma unroll
    for(int ks=0;ks<4;++ks){
      asm volatile("ds_read_b64_tr_b16 %0,%1 offset:%c2":"=&v"(lo[ks]):"v"(vb),"i"(d0*4096+ks*1024):"memory");
      asm volatile("ds_read_b64_tr_b16 %0,%1 offset:%c2":"=&v"(hi[ks]):"v"(vb),"i"(d0*4096+ks*1024+512):"memory");}
    asm volatile("s_waitcnt lgkmcnt(0)":::"memory");SBAR();
    #define PK(k) (bf16x8){lo[k][0],lo[k][1],lo[k][2],lo[k][3],hi[k][0],hi[k][1],hi[k][2],hi[k][3]}
    o[d0]=MFMA16H(pa0,PK(0),o[d0],0,0,0);
    o[d0]=MFMA16H(pa1,PK(1),o[d0],0,0,0);
    o[d0]=MFMA16H(pa2,PK(2),o[d0],0,0,0);
    o[d0]=MFMA16H(pa3,PK(3),o[d0],0,0,0);
    #undef PK
  }
}

__device__ __forceinline__ float msel(float x,int t){ const int xi=__builtin_bit_cast(int,x); return __builtin_bit_cast(float,__builtin_amdgcn_bitop3_b32(xi,(int)0xc76a6000,t,0xE4)); }
#ifndef ATTN_STORE16
#define ATTN_STORE16(p,v) __builtin_nontemporal_store((v),(u32x4*)(p))
#endif
__device__ __forceinline__ void attn_unit(int b,int h,int qb,const bf16*Q,const bf16*__restrict__ K,const bf16*__restrict__ V,bf16*O,const unsigned long long*__restrict__ MASK,float mref,char*shm,int wid){
  const int lane=fx_lane(),tid=wid*64+lane,r32=lane&31,hi=lane>>5; (void)tid;
  const long rowbase=(long)b*SEQ; const int q0=qb*QB;
  const bf16*Qw=Q+(rowbase+q0+wid*QBLK)*DM+h*D;
  const bf16*Kh=K+rowbase*DM+h*D,*Vh=V+rowbase*DM+h*D;
  const unsigned lds0=(unsigned)(uintptr_t)shm;
  float*wsf=(float*)(shm+LDS_WS)+wid*64;
  const bf16*ksrc=Kh+(long)lane*DM+wid*8;
  const bf16*vsrc=Vh+(long)(16*(wid&3)+(lane>>2))*DM+(wid>>2)*32+(lane&3)*8;
  const unsigned kdst=lds0+LDS_K+wid*1024, vdst=lds0+LDS_V+wid*1024;
  #define DMA_K(t,slot) glds16(ksrc+(long)(t)*KVBLK*DM,(unsigned)__builtin_amdgcn_readfirstlane(kdst+(slot)))
  #define DMA_V(t,slot) glds16(vsrc+(long)(t)*KVBLK*DM,(unsigned)__builtin_amdgcn_readfirstlane(vdst+(slot)))
  const int vb0=(int)(lds0+LDS_V)+((lane>>4)&1)*32+(lane&3)*8+(4*hi+((lane&15)>>2))*64;
  const char*Kbase=shm+LDS_K; bf16x8 kf[8];
  const lds_cptr shm3=(lds_cptr)shm; const lds_cptr kp0=shm3+LDS_K+hi*1024+r32*16; const lds_cptr vp0=shm3+LDS_V+((lane>>4)&1)*32+(lane&3)*8+(4*hi+((lane&15)>>2))*64;
  const int NT=(q0+QB)/KVBLK;
  const unsigned long long*mbase=MASK+((size_t)(rowbase+q0+wid*QBLK))*64; const unsigned mvoff=(unsigned)r32*512u; unsigned long long mkA,mkB;
  #define MLOAD(dst,t) dst=*(const unsigned long long*)((const char*)(mbase+(t))+mvoff)
  #define MPIN(x) asm volatile("":"+v"(x))
  const int sh4=4*hi; const int NEGI=(int)0xc76a6000;
  #define MAPPLY(C0,C1,MK) do{ const unsigned lo_=((unsigned)(MK))>>sh4, hi_=((unsigned)((MK)>>32))>>sh4; \
    _Pragma("unroll") for(int r=0;r<16;++r){ const int kb_=(r&3)+8*(r>>2); \
      const int t0_=__builtin_amdgcn_sbfe((int)lo_,kb_,1), t1_=__builtin_amdgcn_sbfe((int)hi_,kb_,1); \
      C0[r]=msel(C0[r],t0_); C1[r]=msel(C1[r],t1_); } }while(0)
  MLOAD(mkA,0);MLOAD(mkB,1);
  DMA_K(0,0);DMA_V(0,0);DMA_K(1,SLOTB);
  bf16x8 qr[4];
  #pragma unroll
  for(int d0=0;d0<4;++d0)qr[d0]=*reinterpret_cast<const bf16x8*>(&Qw[(long)r32*DM+d0*16+hi*8]);
  float l_reg=0.f;f32x16 o[2];o[0]=f32x16{};o[1]=f32x16{};const f32x16 negm=f32x16{};
  const int qrel=wid*QBLK+r32;
  f32x16 pA0,pA1,pB0,pB1;
  int sl_prev=0,sl_cur=0,sl_next=SLOTB;
  #define ROT() do{sl_prev=sl_cur;sl_cur=sl_next;sl_next=(sl_next==(NSLOT-1)*SLOTB)?0:sl_next+SLOTB;}while(0)
  DMA_K(2,2*SLOTB);
  WAIT_BAR(3);
  qkt(pA0,pA1,Kbase,qr,negm,r32,hi);asm volatile("s_nop 15\n\ts_nop 7":"+v"(pA0),"+v"(pA1));MAPPLY(pA0,pA1,mkA);
  _Pragma("unroll") for(int r=0;r<16;++r)pA0[r]=__builtin_amdgcn_exp2f(pA0[r]);
  _Pragma("unroll") for(int r=0;r<16;++r)pA1[r]=__builtin_amdgcn_exp2f(pA1[r]);
  WAIT_BAR(0);
  DMA_K(3,0);DMA_V(1,SLOTB);
  ROT();
  kload8(kf,kp0+sl_cur);
  WAIT_BAR(2);
  s16x4 vlo[8],vhi[8]; u32x4 pw0,pw1,pw2,pw3;
  #define PKW(P,B) cvtpk_s(P[B],P[B+1])
  #define PAF(k) __builtin_bit_cast(bf16x8,pw##k)
  #define VFR(i) (bf16x8){vlo[i][0],vlo[i][1],vlo[i][2],vlo[i][3],vhi[i][0],vhi[i][1],vhi[i][2],vhi[i][3]}
  #define PIN(x) asm volatile("":"+v"(x))
  #define MX3(a,b,c) __builtin_fmaxf(__builtin_fmaxf((a),(b)),(c))
  #define GAPA(MF,A0,A1,A2,A3,W0,W1,PW) do{ MF; sacc+=A0; sacc+=A1; sacc+=A2; sacc+=A3; PIN(sacc); W0; W1; PIN(PW); SBAR(); }while(0)
  #define EX(v) __builtin_amdgcn_exp2f(v)
  #define GAPB(MF,X,B) do{ MF; X[B]=EX(X[B]); X[B+1]=EX(X[B+1]); X[B+2]=EX(X[B+2]); X[B+3]=EX(X[B+3]); PIN(X); SBAR(); }while(0)
  #define VRD(i) do{ vlo[i]=vtr(vp_+(((i)>>2)*4096+((i)&3)*1024)); vhi[i]=vtr(vp_+(((i)>>2)*4096+((i)&3)*1024+512)); }while(0)
  #define KRD(G,j) do{ if(G){ kload2(kf,kp0+sl_next,j); SBAR(); } }while(0)
  #define STEP(C0,C1,P0,P1,t,GK,GV,GL,MKU,MKL) do{ SBAR(); \
    const lds_cptr vp_=vp0+sl_prev; \
    VRD(0); SBAR(); float sacc=(P0[0]+P0[1]); \
    GAPA(C0=MFMA16H(kf[0],qr[0],negm,0,0,0), P0[2],P0[3],P0[4],P0[5],     pw0[0]=PKW(P0,0), pw0[1]=PKW(P0,2), pw0); \
    VRD(4); SBAR(); GAPA(C1=MFMA16H(kf[1],qr[0],negm,0,0,0), P0[6],P0[7],P0[8],P0[9],     pw0[2]=PKW(P0,4), pw0[3]=PKW(P0,6), pw0); \
    VRD(1); SBAR(); GAPA(C0=MFMA16H(kf[2],qr[1],C0,0,0,0),   P0[10],P0[11],P0[12],P0[13], pw1[0]=PKW(P0,8), pw1[1]=PKW(P0,10), pw1); \
    VRD(5); SBAR(); GAPA(C1=MFMA16H(kf[3],qr[1],C1,0,0,0),   P0[14],P0[15],P1[0],P1[1],   pw1[2]=PKW(P0,12),pw1[3]=PKW(P0,14), pw1); \
    VRD(2); SBAR(); GAPA(C0=MFMA16H(kf[4],qr[2],C0,0,0,0),   P1[2],P1[3],P1[4],P1[5],     pw2[0]=PKW(P1,0), pw2[1]=PKW(P1,2), pw2); \
    VRD(6); SBAR(); GAPA(C1=MFMA16H(kf[5],qr[2],C1,0,0,0),   P1[6],P1[7],P1[8],P1[9],     pw2[2]=PKW(P1,4), pw2[3]=PKW(P1,6), pw2); \
    VRD(3); SBAR(); GAPA(C0=MFMA16H(kf[6],qr[3],C0,0,0,0),   P1[10],P1[11],P1[12],P1[13], pw3[0]=PKW(P1,8), pw3[1]=PKW(P1,10), pw3); \
    VRD(7); SBAR(); GAPA(C1=MFMA16H(kf[7],qr[3],C1,0,0,0),   P1[14],P1[15],0.f,0.f,       pw3[2]=PKW(P1,12),pw3[3]=PKW(P1,14), pw3); \
    l_reg+=sacc; MPIN(MKU); SBAR(); \
    if(GK){DMA_K((t)+3,sl_cur);} if(GV){DMA_V((t)+1,sl_next);} \
    MAPPLY(C0,C1,MKU); if(GL){MLOAD(MKL,(t)+1);} \
    SBAR(); \
    GAPB(o[0]=MFMA16H(PAF(0),VFR(0),o[0],0,0,0), C0,0); \
    GAPB(o[1]=MFMA16H(PAF(0),VFR(4),o[1],0,0,0), C0,4); \
    KRD(GL,0); GAPB(o[0]=MFMA16H(PAF(1),VFR(1),o[0],0,0,0), C0,8); \
    KRD(GL,1); GAPB(o[1]=MFMA16H(PAF(1),VFR(5),o[1],0,0,0), C0,12); \
    KRD(GL,2); GAPB(o[0]=MFMA16H(PAF(2),VFR(2),o[0],0,0,0), C1,0); \
    KRD(GL,3); GAPB(o[1]=MFMA16H(PAF(2),VFR(6),o[1],0,0,0), C1,4); \
    GAPB(o[0]=MFMA16H(PAF(3),VFR(3),o[0],0,0,0), C1,8); \
    GAPB(o[1]=MFMA16H(PAF(3),VFR(7),o[1],0,0,0), C1,12); \
    }while(0)
  int t=1;
  for(;t+5<NT;t+=2){
    STEP(pB0,pB1,pA0,pA1,t,true,true,true,mkB,mkA);     WAIT_BAR(2); ROT();
    STEP(pA0,pA1,pB0,pB1,t+1,true,true,true,mkA,mkB);   WAIT_BAR(2); ROT();
  }
  #define ENDW(tt,MK) do{ if((tt)+3<NT){WAIT_BAR(2);} else if((tt)+2<NT){WAIT_BAR(1);} else {WAIT_BAR(0);} }while(0)
  for(;t+1<NT;t+=2){
    STEP(pB0,pB1,pA0,pA1,t,(t+3<NT),(t+1<NT),(t+1<NT),mkB,mkA);       ENDW(t,mkA);   ROT();
    STEP(pA0,pA1,pB0,pB1,t+1,(t+4<NT),(t+2<NT),(t+2<NT),mkA,mkB);     ENDW(t+1,mkB); ROT();
  }
  STEP(pB0,pB1,pA0,pA1,NT-1,false,false,false,mkB,mkA);
  { float sacc=pB0[0]+pB0[1]; _Pragma("unroll") for(int r=2;r<16;++r)sacc+=pB0[r]; _Pragma("unroll") for(int r=0;r<16;++r)sacc+=pB1[r]; l_reg+=sacc;
    pw0=(u32x4){PKW(pB0,0),PKW(pB0,2),PKW(pB0,4),PKW(pB0,6)};pw1=(u32x4){PKW(pB0,8),PKW(pB0,10),PKW(pB0,12),PKW(pB0,14)};pw2=(u32x4){PKW(pB1,0),PKW(pB1,2),PKW(pB1,4),PKW(pB1,6)};pw3=(u32x4){PKW(pB1,8),PKW(pB1,10),PKW(pB1,12),PKW(pB1,14)};
    SBAR(); pv(o,vb0+sl_cur,PAF(0),PAF(1),PAF(2),PAF(3)); }
  #undef PKW
  #undef PAF
  #undef VFR
  #undef PIN
  #undef MX3
  #undef GAPA
  #undef GAPB
  #undef EX
  #undef VRD
  #undef KRD
  #undef STEP
  #undef ENDW
  int le_=lane; asm volatile("":"+v"(le_)); const int r32e=le_&31,hie=le_>>5;
  {auto rr=__builtin_amdgcn_permlane32_swap(__float_as_uint(l_reg),__float_as_uint(l_reg),false,false);l_reg=__uint_as_float(rr[0])+__uint_as_float(rr[1]);}
  if(hie==0)wsf[32+r32e]=l_reg;asm volatile("s_waitcnt lgkmcnt(0)":::"memory");
  float rli[16];
  #pragma unroll
  for(int r=0;r<16;++r)rli[r]=__builtin_amdgcn_rcpf(wsf[32+crow(r,hie)]);
  bf16*Ow=O+(rowbase+q0+wid*QBLK)*OPITCH+OCOL0+h*D;
  { bf16*stg=(bf16*)(shm+LDS_OST)+wid*2048;
    #pragma unroll
    for(int r=0;r<16;++r){const int orow=crow(r,hie);
      #pragma unroll
      for(int d0=0;d0<2;++d0)stg[orow*64+d0*32+r32e]=f2h(o[d0][r]*rli[r]);}
    asm volatile("s_waitcnt lgkmcnt(0)":::"memory");
    #pragma unroll
    for(int i=0;i<4;++i){const int row=i*8+(le_>>3),ch=le_&7; const u32x4 v=*(const u32x4*)(stg+row*64+ch*8); ATTN_STORE16(Ow+(long)row*OPITCH+ch*8,v);} }
  asm volatile("s_waitcnt lgkmcnt(0)\n\ts_barrier":::"memory");
  #undef DMA_K
  #undef DMA_V
  #undef MLOAD
  #undef MAPPLY
  #undef MPIN
  #undef ROT
}
constexpr int ATTN_LDS_BYTES=LDS_BYTES;
struct AttnTensors { const bf16* Q; const bf16* K; const bf16* V; bf16* O; const unsigned long long* MASK; float mref; };
struct AttnUnit { int bh; int qb; };
struct StaticOrder {
  int vcu;
  __device__ __forceinline__ explicit StaticOrder(int grid,int block):vcu((block%8)*(grid/8)+block/8){}
  __device__ __forceinline__ bool next(int i,AttnUnit&u)const{ if(i>=2)return false; const int s=vcu&7; u.bh=vcu>>3; u.qb=(i==0)?s:15-s; return true; }
  __device__ __forceinline__ void a_ready(const AttnUnit&)const{}
  __device__ __forceinline__ void done(const AttnUnit&)const{}
};
template<class Sched> __device__ __forceinline__ void attn_phase(char*lds,const AttnTensors&T,const Sched&S,int wid){
  AttnUnit u;
  for(int i=0;S.next(i,u);++i){ S.a_ready(u); attn_unit(u.bh/NHEAD,u.bh%NHEAD,u.qb,T.Q,T.K,T.V,T.O,T.MASK,T.mref,lds,wid); S.done(u); }
}
#undef SBAR
#undef WAIT_BAR
}
#define GAS __attribute__((address_space(1)))
#define LAS __attribute__((address_space(3)))
typedef unsigned short bf16;
typedef unsigned v4u __attribute__((ext_vector_type(4)));
typedef float f32x4 __attribute__((ext_vector_type(4)));
typedef short bf16x8 __attribute__((ext_vector_type(8)));
typedef GAS unsigned gu32;
typedef GAS unsigned long long gu64;
#define RLX_AGENT __ATOMIC_RELAXED, __HIP_MEMORY_SCOPE_AGENT
#define LDS_WAIT() asm volatile("s_waitcnt lgkmcnt(0)" ::: "memory")
#define VM_WAIT() asm volatile("s_waitcnt vmcnt(0)" ::: "memory")
__device__ __forceinline__ unsigned long long rt() { return __builtin_amdgcn_s_memrealtime(); }
__device__ __forceinline__ unsigned f2bf(float f) { unsigned u = __builtin_bit_cast(unsigned, f); return (u + 0x7fffu + ((u >> 16) & 1u)) >> 16; }
__device__ __forceinline__ unsigned pk2(float lo, float hi) { return f2bf(lo) | (f2bf(hi) << 16); }

#define XB_TMO      128
#define XB_XCNT(j)  (256  + 64 * (j))
#define XB_XSUB(j)  (1280 + 64 * (j))
#define XB_XGEN(j)  (2304 + 64 * (j))
#define XB_TOP      3328
#define XB_TOPGEN   3392
#define XCD_BAR_WORDS 3456
#define XB_SPIN_CAP (1u << 18)

__device__ __forceinline__ unsigned xb_ld(unsigned* p)              { return __hip_atomic_load(p, __ATOMIC_RELAXED, __HIP_MEMORY_SCOPE_AGENT); }
__device__ __forceinline__ unsigned xb_add(unsigned* p, unsigned v) { return __hip_atomic_fetch_add(p, v, __ATOMIC_RELAXED, __HIP_MEMORY_SCOPE_AGENT); }
__device__ __forceinline__ unsigned xb_xcc_id() { return (unsigned)__builtin_amdgcn_s_getreg((3 << 11) | 20) & 0xFu; }
#define XB_SPIN(cond, bar) do { unsigned _sp = 0; while (cond) { __builtin_amdgcn_s_sleep(1); \
    if ((++_sp & 255u) == 0u) { if (xb_ld(&(bar)[XB_TMO])) break; if (_sp > XB_SPIN_CAP) { atomicAdd(&(bar)[XB_TMO], 1u); break; } } } } while (0)

struct XcdBarrier {
    unsigned* bar; unsigned x;
    volatile LAS unsigned* st;
};

__device__ __forceinline__ XcdBarrier xcd_barrier_post(unsigned* bar, volatile LAS unsigned* st, bool t0) {
    XcdBarrier b; b.bar = bar; b.x = xb_xcc_id(); b.st = st;
    if (t0) (void)xb_add(&bar[XB_XCNT(b.x)], 1u);
    return b;
}
__device__ __forceinline__ void xcd_barrier_complete(unsigned* bar, unsigned x, volatile LAS unsigned* st) {
    const unsigned G = gridDim.x * gridDim.y * gridDim.z;
    const int l = fx_lane();
    unsigned c, sum, sp = 0u;
    for (;;) {
        c = (l < 16) ? xb_ld(&bar[XB_XCNT(l & 15)]) : 0u;
        sum = c;
#pragma unroll
        for (int o = 1; o < 16; o <<= 1) sum += (unsigned)__shfl_xor((int)sum, o);
        sum = (unsigned)__builtin_amdgcn_readfirstlane((int)sum);
        if (sum == G) break;
        __builtin_amdgcn_s_sleep(1);
        if ((++sp & 255u) == 0u) { if (xb_ld(&bar[XB_TMO])) break; if (sp > XB_SPIN_CAP) { if (l == 0) atomicAdd(&bar[XB_TMO], 1u); break; } }
    }
    const unsigned msk = (unsigned)(__ballot(c > 0u) & 0xffffull) | (1u << x);
    const unsigned mine = (unsigned)__builtin_amdgcn_readlane((int)c, (int)x);
    if (l == 0) { st[0] = mine > 0u ? mine : 1u; st[1] = msk; }
}

__device__ __forceinline__ void xcd_barrier(const XcdBarrier& b, bool t0, bool w0) {
    asm volatile("s_waitcnt vmcnt(0)" ::: "memory");
    __syncthreads();
    if (w0) {
        unsigned* bar = b.bar;
        __builtin_amdgcn_s_waitcnt(0);
        if (b.st[0] == 0u) { xcd_barrier_complete(bar, b.x, b.st); LDS_WAIT(); }
        const unsigned nloc = b.st[0], xmask = b.st[1];
        const int l = fx_lane();
        unsigned old = 0u;
        if (l == 0) old = xb_add(&bar[XB_XSUB(b.x)], 1u);
        old = (unsigned)__builtin_amdgcn_readfirstlane((int)old);
        const unsigned gen = old / nloc;
        if (old + 1u == (gen + 1u) * nloc) {
            __builtin_amdgcn_fence(__ATOMIC_RELEASE, "agent");
            asm volatile("s_waitcnt vmcnt(0)" ::: "memory");
            if (l == 0) xb_add(&bar[XB_XGEN(b.x)], 1u);
        }
        { unsigned sp = 0u; const bool need = (l < 16) && (((xmask >> (l & 15)) & 1u) != 0u);
          for (;;) {
              const unsigned v = need ? xb_ld(&bar[XB_XGEN(l & 15)]) : 0xffffffffu;
              if (__ballot(need && !(v > gen)) == 0ull) break;
              __builtin_amdgcn_s_sleep(1);
              if ((++sp & 255u) == 0u) { if (xb_ld(&bar[XB_TMO])) break; if (sp > XB_SPIN_CAP) { if (l == 0) atomicAdd(&bar[XB_TMO], 1u); break; } }
          } }
        __builtin_amdgcn_fence(__ATOMIC_ACQUIRE, "agent");
        asm volatile("s_waitcnt vmcnt(0)" ::: "memory");
    }
    __syncthreads();
}
namespace sl {
__device__ __forceinline__ float wsum(float v) {
#pragma unroll
  for (int o = 32; o > 0; o >>= 1) v += __shfl_xor(v, o);
  return v;
}
__device__ __forceinline__ float wmax(float v) {
#pragma unroll
  for (int o = 32; o > 0; o >>= 1) v = fmaxf(v, __shfl_xor(v, o));
  return v;
}
__device__ __forceinline__ void pool_phase(LAS unsigned char* L, int bx, int G, int tid, const hbits* __restrict__ U, const float* __restrict__ pool_w, const float* __restrict__ pool_scale, hbits* __restrict__ Y) {
  const int sb = tid >> 8, t = tid & 255, tx = t & 15, ty = t >> 4;
  LAS float* As = (LAS float*)(L + sb * 16384);
  LAS float* Bs = As + 16 * 65;
  for (int kk_ = 0; kk_ < (256 * 4 * 2 + 2 * G - 1) / (2 * G); ++kk_) {
    const int it = bx * 2 + sb + kk_ * 2 * G; const bool live = it < 256 * 4 * 2;
    const int mb = (it >> 3), g = (it >> 1) & 3, nb = it & 1, m0 = mb * 64, n0 = nb * 64, w = 2 << g;
    float acc[4][4] = {};
    const int ar = t >> 2, ak = (t & 3) * 4, bk = t >> 4, bn = (t & 15) * 4;
    for (int k0 = 0; k0 < 128; k0 += 16) {
      if (live) {
#pragma unroll
        for (int i = 0; i < 4; ++i) { const int m = m0 + ar, c = g * 128 + k0 + ak + i, tt = m & (S - 1); const int cnt = (tt + 1 < w) ? (tt + 1) : w; float s = 0.f;
          for (int j = 0; j < cnt; ++j) s += h2f(U[(size_t)(m - j) * 512 + c]);
          As[(ak + i) * 65 + ar] = s / (float)cnt - h2f(U[(size_t)m * 512 + c]); }
#pragma unroll
        for (int i = 0; i < 4; ++i) Bs[bk * 65 + bn + i] = pool_w[((size_t)g * 128 + k0 + bk) * 128 + n0 + bn + i];
      }
      __syncthreads();
      if (live) {
#pragma unroll
        for (int k = 0; k < 16; ++k) { float a[4], b[4];
#pragma unroll
          for (int i = 0; i < 4; ++i) { a[i] = As[k * 65 + ty * 4 + i]; b[i] = Bs[k * 65 + tx * 4 + i]; }
#pragma unroll
          for (int i = 0; i < 4; ++i)
#pragma unroll
            for (int j = 0; j < 4; ++j) acc[i][j] = fmaf(a[i], b[j], acc[i][j]); }
      }
      __syncthreads();
    }
    if (live) {
#pragma unroll
      for (int i = 0; i < 4; ++i)
#pragma unroll
        for (int j = 0; j < 4; ++j) { const int d = n0 + tx * 4 + j; Y[(size_t)(m0 + ty * 4 + i) * 1024 + g * 128 + d] = f2h(acc[i][j] * pool_scale[g * 128 + d]); }
    }
  }
}
__device__ __forceinline__ void kmem_phase(int gw, int NGW, int lane, const float* __restrict__ KVraw, const float* __restrict__ kgain, hbits* __restrict__ Kmem, hbits* __restrict__ Vmem) {
  for (int w = gw; w < MR * 4; w += NGW) {
    const int row = w >> 2, h = w & 3, b = row >> 8, key = row & 255;
    const float* p = KVraw + (size_t)row * 1024 + h * 128;
    const float v0 = p[lane], v1 = p[lane + 64];
    const float r = rsqrtf(wsum(v0 * v0 + v1 * v1) / 128.f + EPS);
    hbits* ko = Kmem + (((size_t)b * 4 + h) * 256 + key) * 128; hbits* vo = Vmem + (((size_t)b * 4 + h) * 256 + key) * 128;
    ko[lane] = f2h(v0 * r * kgain[lane]); ko[lane + 64] = f2h(v1 * r * kgain[lane + 64]);
    vo[lane] = f2h(p[512 + lane]); vo[lane + 64] = f2h(p[512 + lane + 64]);
  }
}
__device__ __forceinline__ void indexer_phase(LAS unsigned char* L, int bx, int G, int tid, const hbits* __restrict__ QI, const hbits* __restrict__ KI, const float* __restrict__ WI, unsigned char* ws) {
  const int sb = tid >> 8, t = tid & 255, tx = t & 15, ty = t >> 4;
  LAS float* Qs = (LAS float*)(L + sb * 40960);
  LAS float* Ks = Qs + 64 * 65;
  constexpr int NT = 4 * 2080;
  for (int kk_ = 0; kk_ < (NT + 2 * G - 1) / (2 * G); ++kk_) {
    const int it = bx * 2 + sb + kk_ * 2 * G; const bool live = it < NT;
    int b = 0, qc = 0, kc = 0;
    if (live) { b = it / 2080; int r = it % 2080; qc = (int)((sqrtf(8.f * (float)r + 1.f) - 1.f) * 0.5f); while ((qc + 1) * (qc + 2) / 2 <= r) ++qc; while (qc * (qc + 1) / 2 > r) --qc; kc = r - qc * (qc + 1) / 2; }
    const size_t qrow0 = (size_t)b * S + qc * 64, krow0 = (size_t)b * S + kc * 64;
    __syncthreads();
    if (live) for (int i = t; i < 64 * 64; i += 256) { const int r = i >> 6, d = i & 63; Ks[r * 65 + d] = h2f(KI[(krow0 + r) * 64 + d]); }
    float acc[4][4] = {};
    for (int h = 0; h < 8; ++h) {
      __syncthreads();
      if (live) for (int i = t; i < 64 * 64; i += 256) { const int r = i >> 6, d = i & 63; Qs[r * 65 + d] = h2f(QI[(qrow0 + r) * 512 + h * 64 + d]); }
      __syncthreads();
      if (live) {
        float s[4][4] = {};
        for (int d = 0; d < 64; ++d) { float a[4], k[4];
#pragma unroll
          for (int i = 0; i < 4; ++i) { a[i] = Qs[(ty * 4 + i) * 65 + d]; k[i] = Ks[(tx * 4 + i) * 65 + d]; }
#pragma unroll
          for (int i = 0; i < 4; ++i)
#pragma unroll
            for (int j = 0; j < 4; ++j) s[i][j] = fmaf(a[i], k[j], s[i][j]); }
#pragma unroll
        for (int i = 0; i < 4; ++i) { const float w = WI[(qrow0 + ty * 4 + i) * 8 + h];
#pragma unroll
          for (int j = 0; j < 4; ++j) acc[i][j] += fmaxf(s[i][j], 0.f) * w; }
      }
    }
    if (live) {
      hbits* SC = (hbits*)sc_batch_ptr((unsigned char*)ws, (unsigned char*)ws, b) + (size_t)4096 * qc * (qc + 1) / 2;
#pragma unroll
      for (int i = 0; i < 4; ++i)
#pragma unroll
        for (int j = 0; j < 4; ++j) SC[(size_t)(ty * 4 + i) * 64 * (qc + 1) + kc * 64 + tx * 4 + j] = f2h(acc[i][j]);
    }
  }
}
__device__ __forceinline__ unsigned comp_key(hbits hb, int s) {
  unsigned u = hb; u = (u & 0x8000u) ? (~u & 0xffffu) : (u | 0x8000u);
  return (u << 12) | (unsigned)(4095 - s);
}
__device__ __forceinline__ void select_phase(int gw, int NGW, int lane, const unsigned char* __restrict__ ws, unsigned long long* __restrict__ MASK) {
  for (int rw = gw; rw < M; rw += NGW) {
    const int b = rw >> 12, t = rw & 4095, c = t >> 6, N = 64 * (c + 1), nj = c + 1;
    unsigned long long* mrow = MASK + (size_t)rw * 64;
    const hbits* row = (const hbits*)sc_batch_ptr((unsigned char*)ws, (unsigned char*)ws, b) + (size_t)4096 * c * (c + 1) / 2 + (size_t)(t & 63) * N;
    if (N <= 256) { mrow[lane] = (lane < nj) ? ~0ull : 0ull; continue; }
    unsigned T = 0;
    for (int bit = 27; bit >= 0; --bit) { const unsigned cand = T | (1u << bit); int cnt = 0;
      for (int j = 0; j < nj; ++j) { const unsigned k = comp_key(row[j * 64 + lane], j * 64 + lane); cnt += __popcll(__ballot(k >= cand)); }
      if (cnt >= 256) T = cand; }
    for (int j = 0; j < 64; ++j) { unsigned long long mk = 0;
      if (j < nj) { const unsigned k = comp_key(row[j * 64 + lane], j * 64 + lane); mk = __ballot(k >= T); }
      if (lane == 0) mrow[j] = mk; }
  }
}
__device__ __forceinline__ void dsa_phase(LAS unsigned char* L, int bx, int G, int tid, const hbits* __restrict__ Q, const hbits* __restrict__ K, const hbits* __restrict__ V,
                                          const unsigned long long* __restrict__ MASK, hbits* __restrict__ Y) {
  const int sb = tid >> 8, t = tid & 255, lane = t & 63, wid = t >> 6;
  LAS float* qs = (LAS float*)(L + sb * 16384);
  LAS int* list = (LAS int*)(qs + 512);
  LAS int* cnts = list + 256;
  LAS int* ntot = cnts + 64;
  LAS float* sc = (LAS float*)(ntot + 16);
  for (int kk_ = 0; kk_ < (M + 2 * G - 1) / (2 * G); ++kk_) { const int m = bx * 2 + sb + kk_ * 2 * G; if (m >= M) break;
    const int b = m / S;
    __syncthreads();
    qs[t] = h2f(Q[(size_t)m * 512 + t]); qs[t + 256] = h2f(Q[(size_t)m * 512 + t + 256]);
    unsigned long long word = 0;
    if (t < 64) { word = MASK[(size_t)m * 64 + t]; cnts[t] = __popcll(word); }
    __syncthreads();
    if (t < 64) { int off = 0; for (int j = 0; j < t; ++j) off += cnts[j];
      if (t == 63) ntot[0] = off + cnts[63];
      while (word) { const int bpos = __ffsll((long long)word) - 1; word &= word - 1; if (off < 256) list[off] = t * 64 + bpos; ++off; } }
    __syncthreads();
    const int n = ntot[0] < 256 ? ntot[0] : 256;
    if (t < n) { const hbits* kr = K + ((size_t)b * S + list[t]) * 512;
      for (int h = 0; h < 8; ++h) { float s = 0.f; for (int d = 0; d < 64; ++d) s = fmaf(qs[h * 64 + d], h2f(kr[h * 64 + d]), s); sc[h * 256 + t] = s; } }
    __syncthreads();
    for (int h = wid * 2; h < wid * 2 + 2; ++h) { float mx = -INFINITY;
      for (int k = lane; k < n; k += 64) mx = fmaxf(mx, sc[h * 256 + k]);
      mx = wmax(mx); float sm = 0.f;
      for (int k = lane; k < n; k += 64) { const float e = exp2f(sc[h * 256 + k] - mx); sc[h * 256 + k] = e; sm += e; }
      sm = wsum(sm); const float inv = 1.f / sm;
      for (int k = lane; k < n; k += 64) sc[h * 256 + k] *= inv; }
    __syncthreads();
    for (int col = t; col < 512; col += 256) { const int h = col >> 6; float acc = 0.f;
      for (int k = 0; k < n; ++k) acc = fmaf(sc[h * 256 + k], h2f(V[((size_t)b * S + list[k]) * 512 + col]), acc);
      Y[(size_t)m * 1024 + 512 + col] = f2h(acc); }
  }
}
__device__ __forceinline__ void xattn_phase(LAS unsigned char* L, int bx, int G, int tid, const hbits* __restrict__ Qm, const float* __restrict__ qgain, const hbits* __restrict__ Kmem, const hbits* __restrict__ Vmem, hbits* __restrict__ O) {
  const int sb = tid >> 8, t = tid & 255, lane = t & 63, wid = t >> 6;
  LAS float* qs = (LAS float*)(L + sb * 8192);
  LAS float* sc = qs + 512;
  for (int kk_ = 0; kk_ < (M + 2 * G - 1) / (2 * G); ++kk_) { const int m = bx * 2 + sb + kk_ * 2 * G; if (m >= M) break;
    const int b = m / S;
    __syncthreads();
    { const float v0 = h2f(Qm[(size_t)m * 512 + wid * 128 + lane]), v1 = h2f(Qm[(size_t)m * 512 + wid * 128 + 64 + lane]);
      const float r = rsqrtf(wsum(v0 * v0 + v1 * v1) / 128.f + EPS);
      qs[wid * 128 + lane] = v0 * r * qgain[lane]; qs[wid * 128 + 64 + lane] = v1 * r * qgain[lane + 64]; }
    __syncthreads();
    for (int h = 0; h < 4; ++h) { const hbits* kr = Kmem + (((size_t)b * 4 + h) * 256 + t) * 128; float s = 0.f;
      for (int d = 0; d < 128; ++d) s = fmaf(qs[h * 128 + d], h2f(kr[d]), s);
      sc[h * 256 + t] = s * 0.08838834764831845f; }
    __syncthreads();
    { const int h = wid; float mx = -INFINITY;
      for (int k = lane; k < 256; k += 64) mx = fmaxf(mx, sc[h * 256 + k]);
      mx = wmax(mx); float sm = 0.f;
      for (int k = lane; k < 256; k += 64) { const float e = expf(sc[h * 256 + k] - mx); sc[h * 256 + k] = e; sm += e; }
      sm = wsum(sm); const float inv = 1.f / sm;
      for (int k = lane; k < 256; k += 64) sc[h * 256 + k] *= inv; }
    __syncthreads();
    for (int col = t; col < 512; col += 256) { const int h = col >> 7, d = col & 127; float acc = 0.f;
      for (int k = 0; k < 256; ++k) acc = fmaf(sc[h * 256 + k], h2f(Vmem[(((size_t)b * 4 + h) * 256 + k) * 128 + d]), acc);
      O[(size_t)m * 512 + col] = f2h(acc); }
  }
}
}
namespace fx {
typedef float f32x16 __attribute__((ext_vector_type(16)));
typedef short s16x8 __attribute__((ext_vector_type(8)));
typedef unsigned u32x4v __attribute__((ext_vector_type(4)));
typedef unsigned u32x2v __attribute__((ext_vector_type(2)));
#define FX_MFMA(a, b, c) __builtin_amdgcn_mfma_f32_32x32x16_f16(__builtin_bit_cast(h8v, (a)), __builtin_bit_cast(h8v, (b)), (c), 0, 0, 0)
constexpr int IDX_Q_LDS = 65536, IDX_STG = 4608;
__device__ __forceinline__ void indexer_item(int b, int c, int t_lo, int t_hi, int tid, int lane, int wave, const hbits* __restrict__ Qi, const hbits* __restrict__ Ki, const float* __restrict__ WI,
                                             unsigned char* ws, unsigned char* outb, LAS unsigned char* L) {
    asm volatile("" : "+v"(tid), "+v"(lane));
    const int r32 = lane & 31, hi = lane >> 5, grp = wave >> 2, wq = wave & 3;
    __syncthreads();
#pragma unroll
    for (int i = 0; i < 8; ++i) { const int pc = i * 512 + tid, q64 = pc >> 6, within = pc & 63, h = within >> 3, d0 = (within >> 1) & 3, h8 = within & 1;
        const u32x4v v = *(const u32x4v*)(Qi + ((size_t)b * S + 64 * c + q64) * 512 + within * 8);
        *(LAS u32x4v*)(L + (q64 >> 5) * 32768 + ((h * 4 + d0) * 2 + h8) * 512 + (q64 & 31) * 16) = v; }
    const size_t qrow = (size_t)b * S + 64 * c + 32 * grp + r32;
    float w[8];
    { const f32x4 wa = *(const f32x4*)(WI + qrow * 8), wb = *(const f32x4*)(WI + qrow * 8 + 4);
      w[0] = wa[0]; w[1] = wa[1]; w[2] = wa[2]; w[3] = wa[3]; w[4] = wb[0]; w[5] = wb[1]; w[6] = wb[2]; w[7] = wb[3]; }
    __syncthreads();
    const LAS unsigned char* qb = L + grp * 32768 + hi * 512 + r32 * 16;
    LAS unsigned char* stg = L + IDX_Q_LDS + wave * IDX_STG;
    hbits* scg = (hbits*)sc_batch_ptr(ws, outb, b) + (size_t)4096 * c * (c + 1) / 2 + (size_t)(32 * grp) * 64 * (c + 1);
#pragma unroll 1
    for (int kt = t_lo + wq; kt < t_hi; kt += 4) {
        const hbits* kbase = Ki + ((size_t)b * S + 64 * kt + r32) * 64 + hi * 8;
        s16x8 k0[4], k1[4];
#pragma unroll
        for (int d0 = 0; d0 < 4; ++d0) { k0[d0] = *(const s16x8*)(kbase + d0 * 16); k1[d0] = *(const s16x8*)(kbase + 32 * 64 + d0 * 16); }
#pragma unroll
        for (int half = 0; half < 2; ++half) {
            f32x16 sc = f32x16{}, aA = f32x16{}, aB = f32x16{};
#pragma unroll
            for (int d0 = 0; d0 < 4; ++d0) { const s16x8 qv = *(const LAS s16x8*)(qb + d0 * 1024); aA = FX_MFMA(half ? k1[d0] : k0[d0], qv, aA); }
#pragma unroll
            for (int h = 0; h < 8; ++h) {
                if (h < 7) {
                    if (h & 1) { aA = f32x16{};
#pragma unroll
                        for (int d0 = 0; d0 < 4; ++d0) { const s16x8 qv = *(const LAS s16x8*)(qb + ((h + 1) * 4 + d0) * 1024); aA = FX_MFMA(half ? k1[d0] : k0[d0], qv, aA); } }
                    else { aB = f32x16{};
#pragma unroll
                        for (int d0 = 0; d0 < 4; ++d0) { const s16x8 qv = *(const LAS s16x8*)(qb + ((h + 1) * 4 + d0) * 1024); aB = FX_MFMA(half ? k1[d0] : k0[d0], qv, aB); } }
                }
                if (h & 1) {
#pragma unroll
                    for (int rr = 0; rr < 16; ++rr) sc[rr] = fmaf(__builtin_amdgcn_fmed3f(aB[rr], 0.f, 3.0e38f), w[h], sc[rr]);
                } else {
#pragma unroll
                    for (int rr = 0; rr < 16; ++rr) sc[rr] = fmaf(__builtin_amdgcn_fmed3f(aA[rr], 0.f, 3.0e38f), w[h], sc[rr]);
                }
                asm volatile("" : "+v"(sc));
                __builtin_amdgcn_sched_barrier(0);
            }
#pragma unroll
            for (int g4 = 0; g4 < 4; ++g4) { u32x2v o; o.x = pkh(sc[4 * g4], sc[4 * g4 + 1]); o.y = pkh(sc[4 * g4 + 2], sc[4 * g4 + 3]);
                *(LAS u32x2v*)(stg + r32 * 144 + (32 * half + 8 * g4 + 4 * hi) * 2) = o; }
        }
        LDS_WAIT(); asm volatile("" ::: "memory");
        int l2 = lane; asm volatile("" : "+v"(l2));
#pragma unroll
        for (int i = 0; i < 4; ++i) { const int row = i * 8 + (l2 >> 3), ch = l2 & 7;
            const u32x4v v = *(const LAS u32x4v*)(stg + row * 144 + ch * 16);
            __builtin_nontemporal_store(v, (u32x4v*)(scg + (size_t)row * 64 * (c + 1) + 64 * kt + ch * 8)); }
        LDS_WAIT(); asm volatile("" ::: "memory");
    }
}
__device__ __forceinline__ void indexer_phase(int bx, int G, int tid, int lane, int wave, const hbits* __restrict__ Qi, const hbits* __restrict__ Ki, const float* __restrict__ WI, unsigned char* ws, unsigned char* outb, LAS unsigned char* L) {
    for (int it = bx; it < 256; it += G) {
        const int b = it >> 6, j = it & 63;
#pragma unroll 1
        for (int part = 0; part < 2; ++part) {
            const int c = part ? 63 - j : j, t_lo = part ? (65 - j) >> 1 : 0, t_hi = part ? 64 - j : (j + 2) >> 1;
            indexer_item(b, c, t_lo, t_hi, tid, lane, wave, Qi, Ki, WI, ws, outb, L);
        }
    }
}

typedef short s16x2 __attribute__((ext_vector_type(2)));
typedef unsigned short u16x2 __attribute__((ext_vector_type(2)));
__device__ __forceinline__ int wave_isum(int v) {
    v += __builtin_amdgcn_update_dpp(0, v, 0xB1, 0xf, 0xf, false);
    v += __builtin_amdgcn_update_dpp(0, v, 0x4E, 0xf, 0xf, false);
    v += __builtin_amdgcn_update_dpp(0, v, 0x141, 0xf, 0xf, false);
    v += __builtin_amdgcn_update_dpp(0, v, 0x140, 0xf, 0xf, false);
    v += __builtin_amdgcn_update_dpp(0, v, 0x142, 0xa, 0xf, false);
    v += __builtin_amdgcn_update_dpp(0, v, 0x143, 0xc, 0xf, false);
    return __builtin_amdgcn_readlane(v, 63);
}
__device__ __forceinline__ unsigned cnt_lt(const unsigned (&kv)[8][4], int nj8, int T) {
    const s16x2 tp = {(short)T, (short)T}; u16x2 c = {0, 0};
#pragma unroll
    for (int j = 0; j < 8; ++j) if (j < nj8) {
#pragma unroll
        for (int v = 0; v < 4; ++v) { const unsigned kk = kv[j][v]; const s16x2 d = __builtin_elementwise_sub_sat(__builtin_bit_cast(s16x2, kk), tp);
            c += __builtin_bit_cast(u16x2, d) >> (unsigned short)15; } }
    const unsigned cc = __builtin_bit_cast(unsigned, c);
    return ((cc & 0xffffu) + (cc >> 16)) << 15;
}
__device__ __forceinline__ int wave_iscan(int x) {
    x += __builtin_amdgcn_update_dpp(0, x, 0x111, 0xf, 0xf, false);
    x += __builtin_amdgcn_update_dpp(0, x, 0x112, 0xf, 0xf, false);
    x += __builtin_amdgcn_update_dpp(0, x, 0x114, 0xf, 0xf, false);
    x += __builtin_amdgcn_update_dpp(0, x, 0x118, 0xf, 0xf, false);
    x += __builtin_amdgcn_update_dpp(0, x, 0x142, 0xa, 0xf, false);
    x += __builtin_amdgcn_update_dpp(0, x, 0x143, 0xc, 0xf, false);
    return x;
}
__device__ __forceinline__ void find_bucket(const LAS unsigned* H, int lane, int tgt, int& B, int& above, int& cnt) {
    const int base = 252 - 4 * lane;
    const u32x4v c = *(const LAS u32x4v*)(H + base);
    const int c0 = (int)c.x, c1 = (int)c.y, c2 = (int)c.z, c3 = (int)c.w, s4 = (c0 + c1) + (c2 + c3);
    const int P = wave_iscan(s4), A = P - s4;
    const bool hit = (A < tgt) && (tgt <= P);
    int b = base, ab = A + c3 + c2 + c1, ct = c0;
    if (A + c3 >= tgt) { b = base + 3; ab = A; ct = c3; }
    else if (A + c3 + c2 >= tgt) { b = base + 2; ab = A + c3; ct = c2; }
    else if (A + c3 + c2 + c1 >= tgt) { b = base + 1; ab = A + c3 + c2; ct = c1; }
    const unsigned long long hm = __ballot(hit);
    const int sl = hm ? (__ffsll((long long)hm) - 1) : 0;
    B = __builtin_amdgcn_readlane(b, sl); above = __builtin_amdgcn_readlane(ab, sl); cnt = __builtin_amdgcn_readlane(ct, sl);
}
__device__ __forceinline__ void find_bucket4(const LAS unsigned* H, int lane, int tgt, int& B, int& above, int& cnt) {
    const int base = 252 - 4 * lane;
    const u32x4v q0 = *(const LAS u32x4v*)(H + 4 * base), q1 = *(const LAS u32x4v*)(H + 4 * base + 4), q2 = *(const LAS u32x4v*)(H + 4 * base + 8), q3 = *(const LAS u32x4v*)(H + 4 * base + 12);
    const int c0 = (int)((q0.x + q0.y) + (q0.z + q0.w)), c1 = (int)((q1.x + q1.y) + (q1.z + q1.w)), c2 = (int)((q2.x + q2.y) + (q2.z + q2.w)), c3 = (int)((q3.x + q3.y) + (q3.z + q3.w)), s4 = (c0 + c1) + (c2 + c3);
    const int P = wave_iscan(s4), A = P - s4;
    const bool hit = (A < tgt) && (tgt <= P);
    int b = base, ab = A + c3 + c2 + c1, ct = c0;
    if (A + c3 >= tgt) { b = base + 3; ab = A; ct = c3; }
    else if (A + c3 + c2 >= tgt) { b = base + 2; ab = A + c3; ct = c2; }
    else if (A + c3 + c2 + c1 >= tgt) { b = base + 1; ab = A + c3 + c2; ct = c1; }
    const unsigned long long hm = __ballot(hit);
    const int sl = hm ? (__ffsll((long long)hm) - 1) : 0;
    B = __builtin_amdgcn_readlane(b, sl); above = __builtin_amdgcn_readlane(ab, sl); cnt = __builtin_amdgcn_readlane(ct, sl);
}
__device__ __forceinline__ void select_load(int b, int t, int lane, const unsigned char* __restrict__ ws, const unsigned char* __restrict__ outb, u32x4v (&raw)[8]) {
    const int c = t >> 6, N = 64 * (c + 1);
    const hbits* row = (const hbits*)sc_batch_ptr((unsigned char*)ws, (unsigned char*)outb, b) + (size_t)4096 * c * (c + 1) / 2 + (size_t)(t & 63) * N;
#pragma unroll
    for (int j = 0; j < 8; ++j) { const int off = j * 512 + lane * 8; raw[j] = __builtin_nontemporal_load((const u32x4v*)(row + (off < N ? off : 0))); }
}
__device__ __forceinline__ void select_rows2(int b0, int t, int lane, u32x4v (&raw)[2][8], unsigned char* __restrict__ MASKB, LAS unsigned* H) {
    const int c = t >> 6, N = 64 * (c + 1), nj8 = (N + 511) >> 9;
    unsigned char* mrow[2] = {MASKB + ((size_t)b0 * S + t) * 512, MASKB + ((size_t)(b0 + 1) * S + t) * 512};
    if (N <= 256) { const unsigned char v = (8 * lane < N) ? 0xff : 0x00; mrow[0][lane] = v; mrow[1][lane] = v; return; }
#define kv_(r, j, v) raw[r][j][v]
#pragma unroll
    for (int j = 0; j < 8; ++j) {
        const bool ok = (j * 512 + lane * 8 < N);
#pragma unroll
        for (int r = 0; r < 2; ++r) {
            const unsigned ux = raw[r][j].x, uy = raw[r][j].y, uz = raw[r][j].z, uw = raw[r][j].w;
            const s16x2 sx = __builtin_bit_cast(s16x2, ux), sy = __builtin_bit_cast(s16x2, uy), sz = __builtin_bit_cast(s16x2, uz), sw = __builtin_bit_cast(s16x2, uw);
            const s16x2 kx = sx ^ ((sx >> (short)15) & (short)0x7fff), ky = sy ^ ((sy >> (short)15) & (short)0x7fff), kz = sz ^ ((sz >> (short)15) & (short)0x7fff), kw = sw ^ ((sw >> (short)15) & (short)0x7fff);
            u32x4v kq; kq.x = ok ? __builtin_bit_cast(unsigned, kx) : 0x80008000u; kq.y = ok ? __builtin_bit_cast(unsigned, ky) : 0x80008000u;
            kq.z = ok ? __builtin_bit_cast(unsigned, kz) : 0x80008000u; kq.w = ok ? __builtin_bit_cast(unsigned, kw) : 0x80008000u; raw[r][j] = kq;
        }
    }
    { const u32x4v z = {0u, 0u, 0u, 0u};
#pragma unroll
      for (int q = 0; q < 10; ++q) *(LAS u32x4v*)(H + 256 * q + 4 * lane) = z; }
    LDS_WAIT(); asm volatile("" ::: "memory");
#pragma unroll
    for (int j = 0; j < 8; ++j) if (j < nj8) {
#pragma unroll
        for (int v = 0; v < 4; ++v)
#pragma unroll
            for (int r = 0; r < 2; ++r) { const unsigned ku = kv_(r, j, v) ^ 0x80008000u; LAS unsigned* H1 = H + 1280 * r + (lane & 3);
                __hip_atomic_fetch_add(H1 + ((ku >> 6) & 0x3fcu), 1u, __ATOMIC_RELAXED, __HIP_MEMORY_SCOPE_WORKGROUP);
                __hip_atomic_fetch_add(H1 + ((ku >> 22) & 0x3fcu), 1u, __ATOMIC_RELAXED, __HIP_MEMORY_SCOPE_WORKGROUP); } }
    LDS_WAIT(); asm volatile("" ::: "memory");
    int B1[2], above1[2], cnt1[2];
#pragma unroll
    for (int r = 0; r < 2; ++r) find_bucket4(H + 1280 * r, lane, 256, B1[r], above1[r], cnt1[r]);
#pragma unroll
    for (int j = 0; j < 8; ++j) if (j < nj8) {
#pragma unroll
        for (int v = 0; v < 4; ++v)
#pragma unroll
            for (int r = 0; r < 2; ++r) { const unsigned ku = kv_(r, j, v) ^ 0x80008000u; LAS unsigned* H2 = H + 1280 * r + 1024;
                if (((ku >> 8) & 0xffu) == (unsigned)B1[r]) __hip_atomic_fetch_add(H2 + (ku & 0xffu), 1u, __ATOMIC_RELAXED, __HIP_MEMORY_SCOPE_WORKGROUP);
                if ((ku >> 24) == (unsigned)B1[r]) __hip_atomic_fetch_add(H2 + ((ku >> 16) & 0xffu), 1u, __ATOMIC_RELAXED, __HIP_MEMORY_SCOPE_WORKGROUP); } }
    LDS_WAIT(); asm volatile("" ::: "memory");
    int T[2], cgt[2], cge[2], need[2];
#pragma unroll
    for (int r = 0; r < 2; ++r) { int B2, above2, cnt2; find_bucket(H + 1280 * r + 1024, lane, 256 - above1[r], B2, above2, cnt2);
        T[r] = ((B1[r] << 8) | B2) - 32768;
        cgt[r] = above1[r] + above2; cge[r] = cgt[r] + cnt2; need[r] = 256 - cgt[r]; }
    if (cge[0] - cgt[0] == need[0] && cge[1] - cgt[1] == need[1]) {
#pragma unroll
        for (int j = 0; j < 8; ++j) if (j < nj8) {
#pragma unroll
            for (int r = 0; r < 2; ++r) { const s16x2 tp = {(short)T[r], (short)T[r]}; unsigned sel8 = 0u;
#pragma unroll
                for (int v = 0; v < 4; ++v) { const unsigned kk = kv_(r, j, v); const unsigned dl = ~__builtin_bit_cast(unsigned, __builtin_elementwise_sub_sat(__builtin_bit_cast(s16x2, kk), tp));
                    sel8 |= (((dl >> 15) & 1u) | ((dl >> 30) & 2u)) << (2 * v); }
                mrow[r][j * 64 + lane] = (unsigned char)sel8; } }
        return;
    }
#pragma unroll 1
    for (int r = 0; r < 2; ++r) {
        const s16x2 tp = {(short)T[r], (short)T[r]};
        int base = 0;
#pragma unroll
        for (int j = 0; j < 8; ++j) if (j < nj8) {
            unsigned gtb = 0u, eqb = 0u;
#pragma unroll
            for (int v = 0; v < 4; ++v) { const unsigned kk = (r ? kv_(1, j, v) : kv_(0, j, v)); const s16x2 ks = __builtin_bit_cast(s16x2, kk);
                const unsigned dg = __builtin_bit_cast(unsigned, __builtin_elementwise_sub_sat(tp, ks));
                const unsigned dl = __builtin_bit_cast(unsigned, __builtin_elementwise_sub_sat(ks, tp));
                const unsigned g2 = ((dg >> 15) & 1u) | ((dg >> 30) & 2u), l2 = ((dl >> 15) & 1u) | ((dl >> 30) & 2u);
                gtb |= g2 << (2 * v); eqb |= ((~(g2 | l2)) & 3u) << (2 * v); }
            const int ce = __popc(eqb);
            const int inc = wave_iscan(ce);
            const int tot = __builtin_amdgcn_readlane(inc, 63);
            int allow = (r ? need[1] : need[0]) - base - (inc - ce); allow = allow < 0 ? 0 : allow;
            unsigned sel = 0u;
            if (allow >= ce) sel = eqb;
            else {
#pragma unroll
                for (int e = 0; e < 8; ++e) { if ((eqb >> e) & 1u) { if (allow > 0) { sel |= 1u << e; --allow; } } }
            }
            (r ? mrow[1] : mrow[0])[j * 64 + lane] = (unsigned char)(gtb | sel);
            base += tot;
        }
    }
}
#undef kv_
__device__ __forceinline__ void select_load2(int b0, int t, int lane, const unsigned char* __restrict__ ws, const unsigned char* __restrict__ outb, u32x4v (&raw)[2][8]) {
    select_load(b0, t, lane, ws, outb, raw[0]); select_load(b0 + 1, t, lane, ws, outb, raw[1]);
}
__device__ __forceinline__ void select_phase(int gw, int NGW, int lane, const unsigned char* __restrict__ ws, const unsigned char* __restrict__ outb, unsigned char* __restrict__ MASKB, LAS unsigned* H) {
    for (int i = gw; i < 2048; i += NGW) {
#pragma unroll 1
        for (int q = 0; q < 4; ++q) { const int bp = (q >> 1) * 2, t = (q & 1) ? 4095 - i : i;
            u32x4v raw[2][8];
            select_load2(bp, t, lane, ws, outb, raw);
            select_rows2(bp, t, lane, raw, MASKB, H);
        }
    }
}

typedef short s16x4v __attribute__((ext_vector_type(4)));
typedef short v4i16_t __attribute__((ext_vector_type(4)));
__device__ __forceinline__ s16x4v xvtr(const LAS unsigned char* p) { return __builtin_bit_cast(s16x4v, __builtin_amdgcn_ds_read_tr16_b64_v4i16((LAS v4i16_t*)p)); }
__device__ __forceinline__ void xattn_unit(int b, int h, int qb, int tid, int lane, int wave, const hbits* __restrict__ Qm, const float* __restrict__ qgain, const hbits* __restrict__ Kmem, const hbits* __restrict__ Vmem,
                                           hbits* __restrict__ O, float mref, LAS unsigned char* L) {
    asm volatile("" : "+v"(tid), "+v"(lane));
    const int r32 = lane & 31, hi = lane >> 5;
    LAS unsigned char* LK = L; LAS unsigned char* LV = L + 65536;
    __syncthreads();
    { const hbits* kg = Kmem + ((size_t)b * 4 + h) * 256 * 128; const hbits* vg = Vmem + ((size_t)b * 4 + h) * 256 * 128;
#pragma unroll
      for (int i = 0; i < 8; ++i) { const int pc = i * 512 + tid, key = pc >> 4, dc = pc & 15;
          const u32x4v kvv = *(const u32x4v*)(kg + (size_t)key * 128 + dc * 8); *(LAS u32x4v*)(LK + dc * 4096 + key * 16) = kvv;
          const u32x4v vvv = *(const u32x4v*)(vg + (size_t)key * 128 + dc * 8); *(LAS u32x4v*)(LV + (dc >> 2) * 16384 + key * 64 + (dc & 3) * 16) = vvv; } }
    const size_t qrow = (size_t)b * S + 256 * qb + 32 * wave + r32;
    s16x8 qf[8];
    { float qv[8][8]; float ss = 0.f;
#pragma unroll
      for (int d0 = 0; d0 < 8; ++d0) { const u32x4v u = *(const u32x4v*)(Qm + qrow * 512 + h * 128 + d0 * 16 + hi * 8);
          const unsigned ux = u.x, uy = u.y, uz = u.z, uw = u.w;
          const h2v a0 = __builtin_bit_cast(h2v, ux), a1 = __builtin_bit_cast(h2v, uy), a2 = __builtin_bit_cast(h2v, uz), a3 = __builtin_bit_cast(h2v, uw);
          qv[d0][0] = (float)a0[0]; qv[d0][1] = (float)a0[1]; qv[d0][2] = (float)a1[0]; qv[d0][3] = (float)a1[1]; qv[d0][4] = (float)a2[0]; qv[d0][5] = (float)a2[1]; qv[d0][6] = (float)a3[0]; qv[d0][7] = (float)a3[1];
#pragma unroll
          for (int j = 0; j < 8; ++j) ss += qv[d0][j] * qv[d0][j]; }
      ss += __shfl_xor(ss, 32);
      const float r = rsqrtf(ss * (1.0f / 128.0f) + EPS) * (0.08838834764831845f * 1.4426950408889634f);
#pragma unroll
      for (int d0 = 0; d0 < 8; ++d0) { const f32x4 g0 = *(const f32x4*)(qgain + d0 * 16 + hi * 8), g1 = *(const f32x4*)(qgain + d0 * 16 + hi * 8 + 4);
          u32x4v o; o.x = pkh(qv[d0][0] * r * g0[0], qv[d0][1] * r * g0[1]); o.y = pkh(qv[d0][2] * r * g0[2], qv[d0][3] * r * g0[3]);
          o.z = pkh(qv[d0][4] * r * g1[0], qv[d0][5] * r * g1[1]); o.w = pkh(qv[d0][6] * r * g1[2], qv[d0][7] * r * g1[3]);
          qf[d0] = __builtin_bit_cast(s16x8, o); } }
    f32x16 o4[4]; o4[0] = f32x16{}; o4[1] = f32x16{}; o4[2] = f32x16{}; o4[3] = f32x16{};
    float l_reg = 0.f;
    __syncthreads();
    const LAS unsigned char* kp = LK + hi * 4096 + r32 * 16;
    const LAS unsigned char* vp = LV + ((lane >> 4) & 1) * 32 + (lane & 3) * 8 + (4 * hi + ((lane & 15) >> 2)) * 64;
#pragma unroll 1
    for (int half = 0; half < 2; ++half) {
        f32x16 sv[4];
#pragma unroll
        for (int kb = 0; kb < 4; ++kb) {
            f32x16 a = f32x16{};
#pragma unroll
            for (int d0 = 0; d0 < 8; ++d0) { const s16x8 kfr = *(const LAS s16x8*)(kp + d0 * 8192 + (half * 4 + kb) * 512); a = FX_MFMA(kfr, qf[d0], a); }
            sv[kb] = a;
        }
        u32x4v pw[4][2];
#pragma unroll
        for (int kb = 0; kb < 4; ++kb) { float sacc = 0.f; f32x16 pv_ = sv[kb];
#pragma unroll
            for (int rr = 0; rr < 16; ++rr) { pv_[rr] = __builtin_amdgcn_exp2f(pv_[rr] - mref); sacc += pv_[rr]; }
            l_reg += sacc;
            pw[kb][0].x = pkh(pv_[0], pv_[1]); pw[kb][0].y = pkh(pv_[2], pv_[3]); pw[kb][0].z = pkh(pv_[4], pv_[5]); pw[kb][0].w = pkh(pv_[6], pv_[7]);
            pw[kb][1].x = pkh(pv_[8], pv_[9]); pw[kb][1].y = pkh(pv_[10], pv_[11]); pw[kb][1].z = pkh(pv_[12], pv_[13]); pw[kb][1].w = pkh(pv_[14], pv_[15]); }
#pragma unroll
        for (int db = 0; db < 4; ++db)
#pragma unroll
            for (int kb = 0; kb < 4; ++kb)
#pragma unroll
                for (int s2 = 0; s2 < 2; ++s2) { const LAS unsigned char* vq = vp + db * 16384 + ((half * 4 + kb) * 32 + s2 * 16) * 64;
                    const s16x4v lo = xvtr(vq), hi4 = xvtr(vq + 512);
                    const s16x8 vf = {lo[0], lo[1], lo[2], lo[3], hi4[0], hi4[1], hi4[2], hi4[3]};
                    o4[db] = FX_MFMA(pw[kb][s2], vf, o4[db]); }
    }
    l_reg += __shfl_xor(l_reg, 32);
    __syncthreads();
    LAS float* lw = (LAS float*)(LK + wave * 8192 + 7936);
    LAS unsigned char* stg = LV + wave * 8192;
    if (hi == 0) lw[r32] = l_reg;
    LDS_WAIT(); asm volatile("" ::: "memory");
#pragma unroll
    for (int rr = 0; rr < 16; ++rr) { const int qr_ = (rr & 3) + 8 * (rr >> 2) + 4 * hi; const float rl = __builtin_amdgcn_rcpf(lw[qr_]);
#pragma unroll
        for (int db = 0; db < 4; ++db) *(LAS hbits*)(stg + qr_ * 256 + (db * 32 + r32) * 2) = f2h(o4[db][rr] * rl); }
    LDS_WAIT(); asm volatile("" ::: "memory");
    hbits* og = O + ((size_t)b * S + 256 * qb + 32 * wave) * 512 + h * 128;
#pragma unroll
    for (int i = 0; i < 8; ++i) { const int row = i * 4 + (lane >> 4), ch = lane & 15;
        const u32x4v v = *(const LAS u32x4v*)(stg + row * 256 + ch * 16);
        __builtin_nontemporal_store(v, (u32x4v*)(og + (size_t)row * 512 + ch * 8)); }
    LDS_WAIT(); asm volatile("" ::: "memory");
}
__device__ __forceinline__ void xattn_phase(int bx, int G, int tid, int lane, int wave, const hbits* __restrict__ Qm, const float* __restrict__ qgain, const float* __restrict__ kgain,
                                            const hbits* __restrict__ Kmem, const hbits* __restrict__ Vmem, hbits* __restrict__ O, LAS unsigned char* L) {
    float gm = fmaxf(fabsf(qgain[lane]), fabsf(qgain[lane + 64])), km = fmaxf(fabsf(kgain[lane]), fabsf(kgain[lane + 64]));
#pragma unroll
    for (int o = 1; o < 64; o <<= 1) { gm = fmaxf(gm, __shfl_xor(gm, o)); km = fmaxf(km, __shfl_xor(km, o)); }
    const float mref = fmaxf(0.f, 128.f * gm * km * (0.08838834764831845f * 1.4426950408889634f) - 14.f);
#pragma unroll 1
    for (int u = bx; u < 256; u += G) { const int bh = u >> 4, qb = u & 15; xattn_unit(bh >> 2, bh & 3, qb, tid, lane, wave, Qm, qgain, Kmem, Vmem, O, mref, L); }
}

template <int W>
__device__ __forceinline__ void pool_mix(int m0, int g, int tid, const hbits* __restrict__ U, LAS unsigned char* L) {
    const int c2 = tid & 63, seg = tid >> 6, ms = m0 + 32 * seg, pos0 = ms & (S - 1);
    const hbits* up = U + (size_t)ms * 512 + g * 128 + 2 * c2;
    unsigned uv[W - 1 + 32];
#pragma unroll
    for (int j = 0; j < W - 1 + 32; ++j) { const int rel = j - (W - 1); uv[j] = *(const unsigned*)(up + (ptrdiff_t)((pos0 + rel >= 0) ? rel : 0) * 512); }
    __builtin_amdgcn_sched_barrier(0);
#pragma unroll
    for (int j = 0; j < W - 1; ++j) { const int rel = j - (W - 1); uv[j] = (pos0 + rel >= 0) ? uv[j] : 0u; }
    float s0 = 0.f, s1 = 0.f;
#pragma unroll
    for (int j = 0; j < W - 1; ++j) { const unsigned u = uv[j]; const h2v hv = __builtin_bit_cast(h2v, u); s0 += (float)hv[0]; s1 += (float)hv[1]; }
#pragma unroll
    for (int i = 0; i < 32; ++i) { const int pos = pos0 + i;
        const unsigned u = uv[W - 1 + i]; const h2v hv = __builtin_bit_cast(h2v, u); const float u0 = (float)hv[0], u1 = (float)hv[1];
        s0 += u0; s1 += u1;
        const float rc = 1.0f / (float)((pos + 1 < W) ? pos + 1 : W);
        *(LAS unsigned*)(L + (32 * seg + i) * 272 + c2 * 4) = pkh(s0 * rc - u0, s1 * rc - u1);
        const unsigned uo = uv[i]; const h2v ho = __builtin_bit_cast(h2v, uo); s0 -= (float)ho[0]; s1 -= (float)ho[1]; }
}
__device__ __forceinline__ void pool_item(int g, int tb, int tid, int lane, int wave, const hbits* __restrict__ U, const hbits* __restrict__ Pwt, hbits* __restrict__ Y, LAS unsigned char* L) {
    asm volatile("" : "+v"(tid), "+v"(lane));
    const int m0 = tb * 256;
    __syncthreads();
    u32x4v wst_[4];
#pragma unroll
    for (int i = 0; i < 4; ++i) { const int pc = i * 512 + tid; wst_[i] = *(const u32x4v*)(Pwt + (size_t)g * 128 * 128 + (size_t)(pc >> 4) * 128 + (pc & 15) * 8); }
    if (g == 0) pool_mix<2>(m0, g, tid, U, L); else if (g == 1) pool_mix<4>(m0, g, tid, U, L); else if (g == 2) pool_mix<8>(m0, g, tid, U, L); else pool_mix<16>(m0, g, tid, U, L);
#pragma unroll
    for (int i = 0; i < 4; ++i) { const int pc = i * 512 + tid; *(LAS u32x4v*)(L + 69632 + (pc >> 4) * 272 + (pc & 15) * 16) = wst_[i]; }
    __syncthreads();
    const int r32 = lane & 31, hi = lane >> 5;
    const LAS unsigned char* mp = L + (32 * wave + r32) * 272 + hi * 16;
    const LAS unsigned char* wl = L + 69632 + r32 * 272 + hi * 16;
    hbits* yp = Y + (size_t)(m0 + 32 * wave + r32) * 1024 + g * 128 + 4 * hi;
#pragma unroll 1
    for (int db = 0; db < 4; ++db) {
        f32x16 acc = f32x16{};
        s16x8 wf[8];
#pragma unroll
        for (int ks = 0; ks < 8; ++ks) wf[ks] = *(const LAS s16x8*)(wl + (32 * db) * 272 + ks * 32);
        asm volatile("" : "+v"(wf[0]), "+v"(wf[1]), "+v"(wf[2]), "+v"(wf[3]), "+v"(wf[4]), "+v"(wf[5]), "+v"(wf[6]), "+v"(wf[7]));
#pragma unroll
        for (int ks = 0; ks < 8; ++ks) { const s16x8 mf = *(const LAS s16x8*)(mp + ks * 32); acc = FX_MFMA(wf[ks], mf, acc); }
#pragma unroll
        for (int q4 = 0; q4 < 4; ++q4) { u32x2v o; o.x = pkh(acc[4 * q4], acc[4 * q4 + 1]); o.y = pkh(acc[4 * q4 + 2], acc[4 * q4 + 3]); *(u32x2v*)(yp + 32 * db + 8 * q4) = o; }
    }
}
__device__ __forceinline__ void pool_phase(int bx, int G, int tid, int lane, int wave, const hbits* __restrict__ U, const hbits* __restrict__ Pwt, hbits* __restrict__ Y, LAS unsigned char* L) {
#pragma unroll 1
    for (int it = bx; it < 256; it += G) pool_item(it & 3, it >> 2, tid, lane, wave, U, Pwt, Y, L);
}
}
constexpr int NWAVES = 8;
constexpr int RING_OFF = 0, RING_BYTES = 131072, LDSCTL_OFF = RING_BYTES, MISC_OFF = LDSCTL_OFF + 320, LDS_BYTES = 147456;
constexpr int CW_BAR = 4096;

__device__ __forceinline__ float wave_sum_x(float v) {
#define FDPP(ctrl, rm) __builtin_bit_cast(float, __builtin_amdgcn_update_dpp(0, __builtin_bit_cast(int, v), ctrl, rm, 0xf, false))
    v += FDPP(0xB1, 0xf); v += FDPP(0x4E, 0xf); v += FDPP(0x141, 0xf); v += FDPP(0x140, 0xf); v += FDPP(0x142, 0xa); v += FDPP(0x143, 0xc);
#undef FDPP
    return __builtin_bit_cast(float, __builtin_amdgcn_readlane(__builtin_bit_cast(int, v), 63));
}
__device__ __forceinline__ void tr_item(const float* __restrict__ W, int ldw, int src0, int nvalid, const float* __restrict__ kgain, const float* __restrict__ nscale,
                                        hbits* WT, int ldt, int dst_row0, int k0, LAS float* scr, int lane) {
    { const int n = lane & 31, kh = lane >> 5; float vals[32];
#pragma unroll
      for (int i = 0; i < 32; ++i) vals[i] = (n < nvalid) ? __builtin_nontemporal_load(&W[(size_t)(k0 + 2 * i + kh) * ldw + src0 + n]) : 0.f;
      if (kgain) {
#pragma unroll
        for (int i = 0; i < 32; ++i) vals[i] *= kgain[k0 + 2 * i + kh]; }
#pragma unroll
      for (int i = 0; i < 32; ++i) scr[(2 * i + kh) * 33 + n] = vals[i]; }
    LDS_WAIT(); asm volatile("" ::: "memory");
    const int c = lane & 7;
#pragma unroll
    for (int j = 0; j < 4; ++j) { const int n = (lane >> 3) + 8 * j; const LAS float* s = scr + (8 * c) * 33 + n; const float sc = nscale ? nscale[n] : 1.0f;
        v4u o; o.x = pkh(s[0 * 33] * sc, s[1 * 33] * sc); o.y = pkh(s[2 * 33] * sc, s[3 * 33] * sc); o.z = pkh(s[4 * 33] * sc, s[5 * 33] * sc); o.w = pkh(s[6 * 33] * sc, s[7 * 33] * sc);
        *(GAS v4u*)(WT + (size_t)(dst_row0 + n) * ldt + k0 + 8 * c) = o; }
    LDS_WAIT(); asm volatile("" ::: "memory");
}
__device__ __forceinline__ void rms_row_to_h(const float* xrow, hbits* orow, int lane) {
    const GAS f32x4* xr = (const GAS f32x4*)xrow + lane;
    f32x4 v[4]; float s = 0.f;
#pragma unroll
    for (int j = 0; j < 4; ++j) { v[j] = xr[64 * j]; s += (v[j].x * v[j].x + v[j].y * v[j].y) + (v[j].z * v[j].z + v[j].w * v[j].w); }
    const float rstd = rsqrtf(wave_sum_x(s) * (1.f / D) + EPS);
    GAS unsigned long long* o8 = (GAS unsigned long long*)orow + lane;
#pragma unroll
    for (int j = 0; j < 4; ++j) o8[64 * j] = (unsigned long long)pkh(v[j].x * rstd, v[j].y * rstd) | ((unsigned long long)pkh(v[j].z * rstd, v[j].w * rstd) << 32);
}

__device__ __forceinline__ void rms_rows2_to_h(const float* xa, hbits* oa, const float* xb, hbits* ob, float* rmsa, float* rmsb, int lane) {
    const GAS f32x4* pa = (const GAS f32x4*)xa + lane; const GAS f32x4* pb = (const GAS f32x4*)xb + lane;
    f32x4 va[4], vb[4]; float sa = 0.f, sb = 0.f;
#pragma unroll
    for (int j = 0; j < 4; ++j) { va[j] = __builtin_nontemporal_load(pa + 64 * j); vb[j] = __builtin_nontemporal_load(pb + 64 * j); }
#pragma unroll
    for (int j = 0; j < 4; ++j) { sa += (va[j].x * va[j].x + va[j].y * va[j].y) + (va[j].z * va[j].z + va[j].w * va[j].w); sb += (vb[j].x * vb[j].x + vb[j].y * vb[j].y) + (vb[j].z * vb[j].z + vb[j].w * vb[j].w); }
    const float ra = rsqrtf(wave_sum_x(sa) * (1.f / D) + EPS), rb = rsqrtf(wave_sum_x(sb) * (1.f / D) + EPS);
    if (lane == 0) { if (rmsa) *rmsa = __builtin_amdgcn_rcpf(ra); if (rmsb) *rmsb = __builtin_amdgcn_rcpf(rb); }
    GAS unsigned long long* qa = (GAS unsigned long long*)oa + lane; GAS unsigned long long* qb = (GAS unsigned long long*)ob + lane;
#pragma unroll
    for (int j = 0; j < 4; ++j) { qa[64 * j] = (unsigned long long)pkh(va[j].x * ra, va[j].y * ra) | ((unsigned long long)pkh(va[j].z * ra, va[j].w * ra) << 32);
        qb[64 * j] = (unsigned long long)pkh(vb[j].x * rb, vb[j].y * rb) | ((unsigned long long)pkh(vb[j].z * rb, vb[j].w * rb) << 32); }
}

struct Args { const float* in[25]; float* out; unsigned char* ws; int ph_lo, ph_hi, li, pad; int rep[16]; };

__global__ void __launch_bounds__(NWAVES * 64, 2) mk(Args args) {
    extern __shared__ __attribute__((aligned(16))) unsigned char lds[];
    LAS unsigned char* L = (LAS unsigned char*)lds;
    volatile LAS unsigned* MISC = (volatile LAS unsigned*)(L + MISC_OFF);
    const int wave = __builtin_amdgcn_readfirstlane((int)threadIdx.x >> 6);
#define lane (fx_lane())
#define tid (wave * 64 + fx_lane())
#define T0 (wave == 0 && fx_lane() == 0)
    const int G = gridDim.x; const int bx = blockIdx.x;
    unsigned char* ws = args.ws;
    for (int u = tid; u < (LDS_BYTES - LDSCTL_OFF) / 4; u += NWAVES * 64) ((LAS unsigned*)(L + LDSCTL_OFF))[u] = 0u;
    __syncthreads();
    XcdBarrier bar = xcd_barrier_post((unsigned*)(ws + WS_CTL) + CW_BAR, MISC + 8, T0);
    const int lo = args.ph_lo, hi = args.ph_hi;
#define IN(k) (lo <= (k) && (k) < hi)
#define BOTH(k) (IN(k) && IN((k) + 1))
    const float* x = args.in[0]; const float* mem = args.in[1]; const float* mix_norm = args.in[2]; const float* w_in = args.in[3];
    const float* pool_w = args.in[4]; const float* pool_scale = args.in[5]; const float* q_norm = args.in[6]; const float* k_norm = args.in[7]; const float* idx_k_norm = args.in[8];
    const float* w_out = args.in[9]; const float* xattn_norm = args.in[10]; const float* mem_norm = args.in[11]; const float* wq = args.in[12]; const float* wkv = args.in[13];
    const float* wo = args.in[16]; const float* ffn_norm = args.in[17]; const float* wgate = args.in[22]; const float* wup = args.in[23]; const float* wdown = args.in[24];
#define Win_t ((hbits*)(ws + WS_WIN))
#define Wkv_t (Win_t + (size_t)2816 * 1024)
#define Wout_t ((hbits*)(ws + WS_WOUT))
#define Wq_t ((hbits*)(ws + WS_WQ))
#define Wo_t ((hbits*)(ws + WS_WO))
#define Wgu_t ((hbits*)(ws + WS_WGU))
#define Wd_t ((hbits*)(ws + WS_WD))
#define Pw_t ((hbits*)(ws + WS_PWT))
#define XH ((hbits*)(ws + WS_XH))
#define cosT ((float*)(ws + WS_ROPE))
#define sinT (cosT + 4096 * 32)

    for (int rep_ = 0; rep_ < (IN(0) ? args.rep[0] : 0); ++rep_) {
        LAS float* scr = (LAS float*)(L + RING_OFF + wave * 16384);
        const int gw = bx * NWAVES + wave, NGW = G * NWAVES;
        constexpr int I0 = 16 * 88, I1 = 512, I2 = 512, I3 = 256, I4 = 256, I5 = 32, I6 = 8192, I7 = 4096, NITEMS = I0 + I1 + I2 + I3 + I4 + I5;
        for (int it = gw; it < NITEMS; it += NGW) {
            int r = it;
            if (r < I0) { const int kb = r / 88, bb = r % 88, T = bb >> 3, cb = bb & 7, wc = cb & 3, bj = cb >> 2; int src0, nv = 32;
                if (T < 2) src0 = 256 * T + 32 * cb;
                else if (T == 6 || T == 7) src0 = 1536 + 256 * (T - 6) + 32 * cb;
                else if (T == 10) { if (cb == 0) src0 = 2560; else if (cb == 4) src0 = 2592; else if (cb == 1) { src0 = 2624; nv = 8; } else { src0 = 0; nv = 0; } }
                else { const int base = (T < 4) ? 512 : (T < 6) ? 1024 : 2048; src0 = base + 64 * (4 * (T & 1) + wc) + 32 * bj; }
                tr_item(w_in, INC, src0, nv, mix_norm, nullptr, Win_t, 1024, 32 * bb, 64 * kb, scr, lane); continue; }
            r -= I0;
            if (r < I1) { const int kb = r / 32, nb = r % 32; tr_item(wkv, 1024, 32 * nb, 32, mem_norm, nullptr, Wkv_t, 1024, 32 * nb, 64 * kb, scr, lane); continue; }
            r -= I1;
            if (r < I2) { const int kb = r / 32, nb = r % 32; tr_item(w_out, 1024, 32 * nb, 32, nullptr, nullptr, Wout_t, 1024, 32 * nb, 64 * kb, scr, lane); continue; }
            r -= I2;
            if (r < I3) { const int kb = r / 16, nb = r % 16; tr_item(wq, 512, 32 * nb, 32, xattn_norm, nullptr, Wq_t, 1024, 32 * nb, 64 * kb, scr, lane); continue; }
            r -= I3;
            if (r < I4) { const int kb = r / 32, nb = r % 32; tr_item(wo, 1024, 32 * nb, 32, nullptr, nullptr, Wo_t, 512, 32 * nb, 64 * kb, scr, lane); continue; }
            r -= I4;
            if (r < I5) { const int g = r >> 3, kb = (r >> 2) & 1, nb = r & 3;
                tr_item(pool_w + (size_t)g * 128 * 128, 128, 32 * nb, 32, nullptr, pool_scale + g * 128 + 32 * nb, Pw_t + (size_t)g * 128 * 128, 128, 32 * nb, 64 * kb, scr, lane); continue; }
        }
        for (int m = gw; m < M + MR; m += 2 * NGW) {
            const int m2 = m + NGW; const bool has2 = m2 < M + MR; const int mm2 = has2 ? m2 : m;
            rms_rows2_to_h(m < M ? x + (size_t)m * D : mem + (size_t)(m - M) * D, XH + (size_t)m * D, mm2 < M ? x + (size_t)mm2 * D : mem + (size_t)(mm2 - M) * D, XH + (size_t)mm2 * D, m < M ? (float*)(ws + WS_RMS0) + m : nullptr, mm2 < M ? (float*)(ws + WS_RMS0) + mm2 : nullptr, lane); }
        for (int i = bx * 512 + tid; i < 4096 * 32; i += G * 512) { const int pos = i >> 5, k = i & 31;
            const float inv = powf(10000.f, -(float)(2 * k) / 64.f), ang = (float)pos * inv; cosT[i] = cosf(ang); sinT[i] = sinf(ang); }
        { hbits* RWT = (hbits*)(ws + WS_RWT); const float* rgw = args.in[18]; const float* rew = args.in[20];
          for (int i = bx * 512 + tid; i < 64 * 1024; i += G * 512) { const int j = i >> 10, k = i & 1023; RWT[i] = (j < 36) ? f2h(ffn_norm[k] * (j < 4 ? rgw[k * 4 + j] : rew[k * 32 + (j - 4)])) : (hbits)0; } }
        if (BOTH(0)) xcd_barrier(bar, T0, wave == 0);
    }
    for (int rep_ = 0; rep_ < (IN(1) ? args.rep[1] : 0); ++rep_) {
        pg8::Gemm g{XH, Win_t, M + MR, 3840, D}; pg8::SchedIn Sc; Sc.init(G, bx);
        pg8::EpiIn E{(hbits*)(ws + WS_U), (hbits*)(ws + WS_QA), (hbits*)(ws + WS_KA), (hbits*)(ws + WS_VA), (hbits*)(ws + WS_QI), (hbits*)(ws + WS_KI), (float*)(ws + WS_WI), (float*)(ws + WS_KVRAW),
                     cosT, sinT, q_norm, k_norm, idx_k_norm};
        pg8::gemm_phase<pg8::EpiIn, pg8::SchedIn, true, true>(L + RING_OFF, g, Sc, E, wave);
        if (BOTH(1)) xcd_barrier(bar, T0, wave == 0);
    }

    for (int rep_ = 0; rep_ < (IN(2) ? args.rep[2] : 0); ++rep_) {
        for (int r2 = 0; r2 < args.rep[13]; ++r2) fx::pool_phase(bx, G, tid, lane, wave, (const hbits*)(ws + WS_U), Pw_t, (hbits*)args.out, L + RING_OFF);
        for (int r2 = 0; r2 < args.rep[14]; ++r2) sl::kmem_phase(bx * NWAVES + wave, G * NWAVES, lane, (const float*)(ws + WS_KVRAW), args.in[15], (hbits*)(ws + WS_KMEM), (hbits*)(ws + WS_VMEM));
        __syncthreads();
        for (int r2 = 0; r2 < args.rep[15]; ++r2) fx::indexer_phase(bx, G, tid, lane, wave, (const hbits*)(ws + WS_QI), (const hbits*)(ws + WS_KI), (const float*)(ws + WS_WI), ws, (unsigned char*)args.out, L + RING_OFF);
        if (BOTH(2)) xcd_barrier(bar, T0, wave == 0);
    }
    for (int rep_ = 0; rep_ < (IN(3) ? args.rep[3] : 0); ++rep_) {
        fx::select_phase(bx * NWAVES + wave, G * NWAVES, lane, ws, (const unsigned char*)args.out, (unsigned char*)(ws + WS_MASK), (LAS unsigned*)(L + RING_OFF + wave * 10240));
        if (BOTH(3)) xcd_barrier(bar, T0, wave == 0);
    }
    for (int rep_ = 0; rep_ < (IN(4) ? args.rep[4] : 0); ++rep_) {
        float gm = fabsf(q_norm[lane]), km = fabsf(k_norm[lane]);
#pragma unroll
        for (int o = 1; o < 64; o <<= 1) { gm = fmaxf(gm, __shfl_xor(gm, o)); km = fmaxf(km, __shfl_xor(km, o)); }
        const bool fast_ok = (G == 256) && (64.f * gm * km * C2Q <= 14.f);
#if DBG_ATTN
        sl::dsa_phase(L, bx, G, tid, (const hbits*)(ws + WS_QA), (const hbits*)(ws + WS_KA), (const hbits*)(ws + WS_VA), (const unsigned long long*)(ws + WS_MASK), (hbits*)args.out);
        __syncthreads();
        { const attn_body::AttnTensors AT{(const hbits*)(ws + WS_QA), (const hbits*)(ws + WS_KA), (const hbits*)(ws + WS_VA), (hbits*)(ws + WS_X1H), (const unsigned long long*)(ws + WS_MASK), 0.f};
          const attn_body::StaticOrder SA(G, bx);
          attn_body::attn_phase<attn_body::StaticOrder>((char*)lds + RING_OFF, AT, SA, wave); }
        xcd_barrier(bar, T0, wave == 0);
        { unsigned* dbg = (unsigned*)(ws + WS_CTL) + 16384;
          const hbits* Ya = (const hbits*)args.out; const hbits* Yb = (const hbits*)(ws + WS_X1H);
          float mx = 0.f; unsigned cntb = 0, cnt2 = 0, minrow = 0xffffffffu;
          for (size_t i = (size_t)bx * 512 + tid; i < (size_t)M * 512; i += (size_t)G * 512) { const int m = (int)(i >> 9), cidx = (int)(i & 511);
              const float d = fabsf(h2f(Ya[(size_t)m * 1024 + 512 + cidx]) - h2f(Yb[(size_t)m * 1024 + 512 + cidx]));
              mx = fmaxf(mx, d); if (d > DBG_TOL) { ++cntb; if ((m & 4095) < 256) ++cnt2; if ((unsigned)(m & 4095) < minrow) minrow = (unsigned)(m & 4095); } }
          atomicMax(dbg + 0, __float_as_uint(mx)); atomicAdd(dbg + 1, cntb); if (minrow != 0xffffffffu) atomicMax(dbg + 2, 4096u - minrow); atomicAdd(dbg + 3, cnt2); }
#else
        if (fast_ok) {
            static_assert(attn_body::ATTN_LDS_BYTES <= RING_BYTES, "attention LDS");
            const attn_body::AttnTensors AT{(const hbits*)(ws + WS_QA), (const hbits*)(ws + WS_KA), (const hbits*)(ws + WS_VA), (hbits*)args.out, (const unsigned long long*)(ws + WS_MASK), 0.f};
            const attn_body::StaticOrder SA(G, bx);
            attn_body::attn_phase<attn_body::StaticOrder>((char*)lds + RING_OFF, AT, SA, wave);
        } else
        sl::dsa_phase(L, bx, G, tid, (const hbits*)(ws + WS_QA), (const hbits*)(ws + WS_KA), (const hbits*)(ws + WS_VA), (const unsigned long long*)(ws + WS_MASK), (hbits*)args.out);
#endif
        if (BOTH(4)) xcd_barrier(bar, T0, wave == 0);
    }
    for (int rep_ = 0; rep_ < (IN(5) ? args.rep[5] : 0); ++rep_) {
        pg8::Gemm g{(const hbits*)args.out, Wout_t, M, D, D}; pg8::StaticOrder Sc; Sc.init(M, D, G, bx);
        pg8::EpiRes<true, true> E{XH, (hbits*)(ws + WS_X1H), (float*)(ws + WS_SS1), (const float*)(ws + WS_RMS0)};
        pg8::gemm_phase<pg8::EpiRes<true, true>, pg8::StaticOrder, true, true>(L + RING_OFF, g, Sc, E, wave);
        if (BOTH(5)) xcd_barrier(bar, T0, wave == 0);
    }
    for (int rep_ = 0; rep_ < (IN(6) ? args.rep[6] : 0); ++rep_) {
        pg8::Gemm g{(const hbits*)(ws + WS_X1H), Wq_t, M, 512, D}; pg8::StaticOrder Sc; Sc.init(M, 512, G, bx);
        pg8::EpiWq E{(const float*)(ws + WS_SS1), (hbits*)(ws + WS_QM)};
        if (bx >= 128 && G == 256) {
            LAS float* scr = (LAS float*)(L + RING_OFF + wave * 16384);
            const int gw2 = (bx - 128) * NWAVES + wave, NGW2 = 128 * NWAVES;
            constexpr int I6 = 8192, I7 = 4096;
            for (int it = gw2; it < I6 + I7; it += NGW2) {
                int r = it;
                if (r < I6) { const int e = r >> 8, q = r & 255, kb = q >> 4, bb = q & 15, T = bb >> 3, cb = bb & 7, bj = cb >> 2;
                    const float* src = (bj ? wup : wgate) + (size_t)e * 1024 * 256;
                    tr_item(src, 256, 128 * T + 32 * (cb & 3), 32, ffn_norm, nullptr, Wgu_t + (size_t)e * 512 * 1024, 1024, 32 * bb, 64 * kb, scr, lane); continue; }
                r -= I6;
                { const int e = r >> 7, q = r & 127, kb = q >> 5, nb = q & 31;
                    tr_item(wdown + (size_t)e * 256 * 1024, 1024, 32 * nb, 32, nullptr, nullptr, Wd_t + (size_t)e * 1024 * 256, 256, 32 * nb, 64 * kb, scr, lane); }
            }
        } else
        pg8::gemm_phase<pg8::EpiWq, pg8::StaticOrder, true, true>(L + RING_OFF, g, Sc, E, wave);
        if (BOTH(6)) xcd_barrier(bar, T0, wave == 0);
    }

    for (int rep_ = 0; rep_ < (IN(7) ? args.rep[7] : 0); ++rep_) {
        fx::xattn_phase(bx, G, tid, lane, wave, (const hbits*)(ws + WS_QM), args.in[14], args.in[15], (const hbits*)(ws + WS_KMEM), (const hbits*)(ws + WS_VMEM), (hbits*)(ws + WS_OX), L + RING_OFF);
        if (BOTH(7)) xcd_barrier(bar, T0, wave == 0);
    }
    for (int rep_ = 0; rep_ < (IN(8) ? args.rep[8] : 0); ++rep_) {
        pg8::Gemm g{(const hbits*)(ws + WS_OX), Wo_t, M, D, 512}; pg8::StaticOrder Sc; Sc.init(M, D, G, bx);
        pg8::EpiRes<true, false> E{(const hbits*)(ws + WS_X1H), (hbits*)(ws + WS_X2H), (float*)(ws + WS_SS2), nullptr};
        pg8::gemm_phase<pg8::EpiRes<true, false>, pg8::StaticOrder, true, true>(L + RING_OFF, g, Sc, E, wave);
        if (BOTH(8)) xcd_barrier(bar, T0, wave == 0);
    }

    LAS int* TB = (LAS int*)(L + LDSCTL_OFF + 1024); LAS int* TC = TB + 32; LAS int* TTp = TB + 64; LAS int* lc = TB + 96; LAS int* lbase = TB + 128;
#define gcnt ((int*)(ws + WS_CTL) + CW_CNT)
#define rlist ((int*)(ws + WS_RLIST))
#define rwt ((float*)(ws + WS_RW))
#define RSTD2 ((float*)(ws + WS_RSTD2))
#define rsl ((float*)(ws + WS_RSL))
    if (IN(9)) {
        const float* RWT = (const float*)(ws + WS_RWT); const hbits* X2 = (const hbits*)(ws + WS_X2H); const float* SS2 = (const float*)(ws + WS_SS2);
        const float* rgb = args.in[19]; const float* reb = args.in[21];
        for (int it = bx; it < M / 64; it += G) {
            const int tok0 = it * 64;
            LAS float* xs = (LAS float*)(L + wave * 9216);
            for (int r9 = 0; r9 < args.rep[9]; ++r9) {
            const int l9 = lane, r32 = l9 & 31, hi9 = l9 >> 5;
            fx::f32x16 a00 = fx::f32x16{}, a01 = fx::f32x16{}, a10 = fx::f32x16{}, a11 = fx::f32x16{};
            const hbits* xa = X2 + (size_t)(tok0 + r32) * D + wave * 128 + hi9 * 8;
            const hbits* wb = (const hbits*)(ws + WS_RWT) + (size_t)r32 * 1024 + wave * 128 + hi9 * 8;
#pragma unroll
            for (int ks = 0; ks < 8; ++ks) {
                const fx::s16x8 x0 = *(const fx::s16x8*)(xa + ks * 16), x1 = *(const fx::s16x8*)(xa + (size_t)32 * D + ks * 16);
                const fx::s16x8 w0 = *(const fx::s16x8*)(wb + ks * 16), w1 = *(const fx::s16x8*)(wb + (size_t)32 * 1024 + ks * 16);
                a00 = FX_MFMA(x0, w0, a00); a01 = FX_MFMA(x0, w1, a01); a10 = FX_MFMA(x1, w0, a10); a11 = FX_MFMA(x1, w1, a11);
            }
#pragma unroll
            for (int rr = 0; rr < 16; ++rr) { const int tk = (rr & 3) + 8 * (rr >> 2) + 4 * hi9;
                xs[r32 * 64 + tk] = a00[rr]; xs[r32 * 64 + 32 + tk] = a10[rr];
                if (r32 < 4) { xs[(32 + r32) * 64 + tk] = a01[rr]; xs[(32 + r32) * 64 + 32 + tk] = a11[rr]; } }
            }
            if (tid < 32) lc[tid] = 0;
            __syncthreads();
            LAS float* lg = (LAS float*)(L + 8 * 9216);
            for (int o = tid; o < 2304; o += 512) { float sm = 0.f;
#pragma unroll
                for (int w = 0; w < 8; ++w) sm += ((LAS float*)(L + w * 9216))[o];
                lg[o] = sm; }
            __syncthreads();
            if (wave == 0) {
                const int tok = tok0 + lane;
                const f32x4 a4 = *(const f32x4*)(SS2 + (size_t)tok * 16), b4 = *(const f32x4*)(SS2 + (size_t)tok * 16 + 4), c4 = *(const f32x4*)(SS2 + (size_t)tok * 16 + 8), d4 = *(const f32x4*)(SS2 + (size_t)tok * 16 + 12);
                const float tt = ((a4[0] + a4[1]) + (a4[2] + a4[3])) + ((b4[0] + b4[1]) + (b4[2] + b4[3])) + ((c4[0] + c4[1]) + (c4[2] + c4[3])) + ((d4[0] + d4[1]) + (d4[2] + d4[3]));
                const float r = rsqrtf(tt * (1.0f / 1024.0f) + EPS);
                RSTD2[tok] = r;
                float gl[4]; int g = 0;
#pragma unroll
                for (int j = 0; j < 4; ++j) gl[j] = lg[j * 64 + lane] * r + rgb[j];
#pragma unroll
                for (int j = 1; j < 4; ++j) if (gl[j] > gl[g]) g = j;
                float gs = 0.f;
#pragma unroll
                for (int j = 0; j < 4; ++j) gs += expf(gl[j] - gl[g]);
                const float gwt = 1.f / gs;
                float el[8];
#pragma unroll
                for (int j = 0; j < 8; ++j) el[j] = lg[(4 + g * 8 + j) * 64 + lane] * r + reb[g * 8 + j];
                int i0 = 0;
#pragma unroll
                for (int j = 1; j < 8; ++j) if (el[j] > el[i0]) i0 = j;
                int i1 = (i0 == 0) ? 1 : 0;
#pragma unroll
                for (int j = 0; j < 8; ++j) if (j != i0 && el[j] > el[i1]) i1 = j;
                float v0 = el[0], v1 = el[0];
#pragma unroll
                for (int j = 0; j < 8; ++j) { if (j == i0) v0 = el[j]; if (j == i1) v1 = el[j]; }
                const float e1 = expf(v1 - v0);
                const float w0 = gwt / (1.f + e1), w1 = gwt * e1 / (1.f + e1);
                const int e0g = g * 8 + i0, e1g = g * 8 + i1;
                const int p0 = __hip_atomic_fetch_add(lc + e0g, 1, __ATOMIC_RELAXED, __HIP_MEMORY_SCOPE_WORKGROUP);
                const int p1 = __hip_atomic_fetch_add(lc + e1g, 1, __ATOMIC_RELAXED, __HIP_MEMORY_SCOPE_WORKGROUP);
                LDS_WAIT(); asm volatile("" ::: "memory");
                if (lane < 32) { const int n = ((volatile LAS int*)lc)[lane]; int bs = 0; if (n > 0) bs = atomicAdd(gcnt + lane, n); ((volatile LAS int*)lbase)[lane] = bs; }
                LDS_WAIT(); asm volatile("" ::: "memory");
                const int b0 = ((volatile LAS int*)lbase)[e0g], b1 = ((volatile LAS int*)lbase)[e1g];
                rlist[(size_t)e0g * M + b0 + p0] = (tok << 1); rwt[(size_t)e0g * M + b0 + p0] = w0; rsl[(size_t)e0g * M + b0 + p0] = r;
                rlist[(size_t)e1g * M + b1 + p1] = (tok << 1) | 1; rwt[(size_t)e1g * M + b1 + p1] = w1; rsl[(size_t)e1g * M + b1 + p1] = r;
            }
            __syncthreads();
        }
        if (BOTH(9)) xcd_barrier(bar, T0, wave == 0);
    }
    if (IN(10)) {
        if (wave == 0) {
            const int n = (lane < 32) ? __hip_atomic_load(gcnt + (lane & 31), __ATOMIC_RELAXED, __HIP_MEMORY_SCOPE_AGENT) : 0;
            const int nt = (n + 255) >> 8; int inc = nt;
#pragma unroll
            for (int o = 1; o < 32; o <<= 1) { const int t = __shfl_up(inc, o); if ((lane & 31) >= o) inc += t; }
            if (lane < 32) { TB[lane] = inc - nt; TC[lane] = n; }
            if (lane == 31) TTp[0] = inc;
        }
        __syncthreads();
    }
    for (int rep_ = 0; rep_ < (IN(10) ? args.rep[10] : 0); ++rep_) {
        pg8::MoeTab tab{TB, TC, __builtin_amdgcn_readfirstlane(TTp[0])};
        unsigned* tdone = (unsigned*)(ws + WS_CTL) + CW_MOE + rep_ * 4096;
        const int ngu = 2 * tab.TT, R_ = (ngu > G && ngu <= 2 * G) ? ngu - G : 0, nd_ = G - R_;
        if (ngu <= 2 * G) {
            int ub_ = bx - R_;
            if (G == 256 && bx >= R_) { const int x_ = bx & 7; int base_ = 0;
                for (int y = 0; y < x_; ++y) base_ += 32 - ((R_ > y) ? ((R_ - y + 7) >> 3) : 0);
                ub_ = base_ + (bx >> 3) - ((R_ > x_) ? ((R_ - x_ + 7) >> 3) : 0); }
            int tile = -1, T = 0, nun = 0;
            if (bx < R_) { int pa_ = bx;
                if (G == 256) { const int x_ = bx & 7; int base_ = 0;
                    for (int y = 0; y < x_; ++y) base_ += (R_ > y) ? ((R_ - y + 7) >> 3) : 0;
                    pa_ = base_ + (bx >> 3); }
                tile = tab.TT - R_ + pa_; nun = 2; }
            else if (ub_ < ngu - 2 * R_) { tile = ub_ >> 1; T = ub_ & 1; nun = 1; }
            if (nun) {
                const int e = __builtin_amdgcn_readfirstlane(tab.expert_of(tile)), rt = tile - __builtin_amdgcn_readfirstlane(TB[e]); int nvalid = __builtin_amdgcn_readfirstlane(TC[e]) - rt * 256; if (nvalid > 256) nvalid = 256;
                pg8::Gemm g{(const hbits*)(ws + WS_X2H), Wgu_t, M, 512, D, rlist + (size_t)e * M + rt * 256, nvalid};
                pg8::SchedTwo Sc{{tile, 2 * e + T}, {tile, 2 * e + 1}, nun};
                pg8::EpiGU E{(hbits*)(ws + WS_HID), rwt + (size_t)e * M + rt * 256, rsl + (size_t)e * M + rt * 256, nvalid, tile * 256};
                pg8::gemm_phase<pg8::EpiGU, pg8::SchedTwo, true, true, true, true>(L + RING_OFF, g, Sc, E, wave);
                asm volatile("s_waitcnt vmcnt(0)" ::: "memory"); __syncthreads();
                if (T0) __hip_atomic_fetch_add(tdone + 16 * tile, (unsigned)nun, __ATOMIC_RELAXED, __HIP_MEMORY_SCOPE_AGENT);
            }
            const int n_dn_mine = (bx >= R_) ? (4 * tab.TT - ub_ + nd_ - 1) / nd_ : 0;
            for (int it_ = 0; it_ < n_dn_mine; ++it_) {
                const int dn = ub_ + it_ * nd_, tile2 = dn >> 2, cn = dn & 3, e = __builtin_amdgcn_readfirstlane(tab.expert_of(tile2));
                if (T0) { unsigned sp = 0;
                    while (__hip_atomic_load(tdone + 16 * tile2, __ATOMIC_RELAXED, __HIP_MEMORY_SCOPE_AGENT) < 2u) { __builtin_amdgcn_s_sleep(2); if (++sp > (1u << 22)) break; }
                    __builtin_amdgcn_fence(__ATOMIC_ACQUIRE, "agent"); asm volatile("s_waitcnt vmcnt(0)" ::: "memory"); }
                __syncthreads();
                int nv_ = __builtin_amdgcn_readfirstlane(TC[e]) - (tile2 - __builtin_amdgcn_readfirstlane(TB[e])) * 256; if (nv_ > 256) nv_ = 256;
                pg8::Gemm g{(const hbits*)(ws + WS_HID), Wd_t, 40960, 32768, 256, nullptr, nv_};
                pg8::SchedOne Sc{{tile2, 4 * e + cn}};
                pg8::EpiDown E{tab, rlist, (hbits*)(ws + WS_P)};
                pg8::gemm_phase<pg8::EpiDown, pg8::SchedOne, false, true, false, true>(L + RING_OFF, g, Sc, E, wave);
            }
        }
        if (IN(12)) xcd_barrier(bar, T0, wave == 0);
    }
    if (IN(11)) { for (int rep_ = 1; rep_ < args.rep[11]; ++rep_) { xcd_barrier(bar, T0, wave == 0); xcd_barrier(bar, T0, wave == 0); xcd_barrier(bar, T0, wave == 0); xcd_barrier(bar, T0, wave == 0); } }
    for (int rep_ = 0; rep_ < (IN(12) ? args.rep[12] : 0); ++rep_) {
        const hbits* P0 = (const hbits*)(ws + WS_P); const hbits* P1 = P0 + (size_t)M * D;
#pragma unroll 4
        for (size_t i = (size_t)bx * 512 + tid; i < (size_t)M * D / 8; i += (size_t)G * 512) {
            f32x4 a, b;
            { const v4u xr = __builtin_nontemporal_load((const v4u*)((const hbits*)(ws + WS_X2H) + i * 8)); const unsigned xa = xr.x, xb = xr.y, xc = xr.z, xd = xr.w;
              const h2v x0 = __builtin_bit_cast(h2v, xa), x1 = __builtin_bit_cast(h2v, xb), x2 = __builtin_bit_cast(h2v, xc), x3 = __builtin_bit_cast(h2v, xd);
              a = (f32x4){(float)x0[0], (float)x0[1], (float)x1[0], (float)x1[1]}; b = (f32x4){(float)x2[0], (float)x2[1], (float)x3[0], (float)x3[1]}; }
            const v4u p = __builtin_nontemporal_load((const v4u*)(P0 + i * 8)), q = __builtin_nontemporal_load((const v4u*)(P1 + i * 8));
            const unsigned px = p.x, py = p.y, pz = p.z, pw = p.w, qx = q.x, qy = q.y, qz = q.z, qw = q.w;
            const h2v p0 = __builtin_bit_cast(h2v, px), p1 = __builtin_bit_cast(h2v, py), p2 = __builtin_bit_cast(h2v, pz), p3 = __builtin_bit_cast(h2v, pw);
            const h2v q0 = __builtin_bit_cast(h2v, qx), q1 = __builtin_bit_cast(h2v, qy), q2 = __builtin_bit_cast(h2v, qz), q3 = __builtin_bit_cast(h2v, qw);
            a[0] += (float)p0[0] + (float)q0[0]; a[1] += (float)p0[1] + (float)q0[1]; a[2] += (float)p1[0] + (float)q1[0]; a[3] += (float)p1[1] + (float)q1[1];
            b[0] += (float)p2[0] + (float)q2[0]; b[1] += (float)p2[1] + (float)q2[1]; b[2] += (float)p3[0] + (float)q3[0]; b[3] += (float)p3[1] + (float)q3[1];
#if DBG_ATTN
            { const unsigned* dbg = (const unsigned*)(ws + WS_CTL) + 16384; const float s0 = __uint_as_float(dbg[0]); const float frac = (float)dbg[1] / ((float)M * 512.f); const unsigned mr = 4096u - dbg[2];
              const float delta = DBG_CH_RVR == 0 ? sqrtf(frac) : sqrtf((float)dbg[3] / (4.f * 256.f * 512.f));
              a = a + delta; b = b + delta; if (i == 0) a[0] += DBG_CH_ABS == 0 ? 1000.f * s0 : (float)(mr & 4095u); }
#endif
            __builtin_nontemporal_store(a, (f32x4*)(args.out + i * 8)); __builtin_nontemporal_store(b, (f32x4*)(args.out + i * 8 + 4));
        }
    }
#undef IN
#undef BOTH
#undef lane
#undef tid
#undef T0
#undef Win_t
#undef Wkv_t
#undef Wout_t
#undef Wq_t
#undef Wo_t
#undef Wgu_t
#undef Wd_t
#undef Pw_t
#undef XH
#undef cosT
#undef sinT
#undef gcnt
#undef rlist
#undef rwt
#undef RSTD2
#undef rsl
}
static void launch_mk(hipStream_t stream, int grid, const Args& base, int lo, int hi) {
    Args a = base; a.ph_lo = lo; a.ph_hi = hi;
    hipLaunchKernelGGL(mk, dim3(grid), dim3(NWAVES * 64), LDS_BYTES, stream, a);
}
extern "C" void kernel_launch(void* const* d_in, const int* in_sizes, int n_in, void* d_out, int out_size, void* d_ws, size_t ws_size, hipStream_t stream) {
    static int grid = 0;
    if (grid == 0) {
        if (n_in != 25 || in_sizes[0] != M * D || out_size != M * D || ws_size < WS_END) { fprintf(stderr, "kernel_launch: unexpected shapes (n_in %d, ws %zu)\n", n_in, ws_size); grid = -1; return; }
        int dev = 0, cus = 0, per_cu = 0;
        if (hipGetDevice(&dev) != hipSuccess || hipDeviceGetAttribute(&cus, hipDeviceAttributeMultiprocessorCount, dev) != hipSuccess) { grid = -1; return; }
        if (hipFuncSetAttribute((const void*)mk, hipFuncAttributeMaxDynamicSharedMemorySize, LDS_BYTES) != hipSuccess) { fprintf(stderr, "kernel_launch: hipFuncSetAttribute failed\n"); grid = -1; return; }
        if (hipOccupancyMaxActiveBlocksPerMultiprocessor(&per_cu, (const void*)mk, NWAVES * 64, LDS_BYTES) != hipSuccess || per_cu < 1) { fprintf(stderr, "kernel_launch: occupancy query says %d blocks/CU\n", per_cu); grid = -1; (void)hipGetLastError(); return; }
        grid = cus;
    }
    if (grid < 0) return;
    unsigned char* ws = (unsigned char*)d_ws; float* out = (float*)d_out;
    (void)hipMemsetAsync(ws + WS_CTL, 0, CTL_ZERO_BYTES, stream);
    Args a{};
    for (int i = 0; i < 25; ++i) a.in[i] = (const float*)d_in[i];
    a.out = out; a.ws = ws;
    for (int k = 0; k < 16; ++k) a.rep[k] = (k == PROBE_DOUBLE) ? 2 : 1;
    const float* pool_w = a.in[4]; const float* pool_scale = a.in[5]; const float* xq_norm = a.in[14]; const float* xk_norm = a.in[15]; const float* ffn_norm = a.in[17];
    const float* rgw = a.in[18]; const float* rgb = a.in[19]; const float* rew = a.in[20]; const float* reb = a.in[21];
    const float* wgate = a.in[22]; const float* wup = a.in[23]; const float* wdown = a.in[24];
    hbits* U = (hbits*)(ws + WS_U); hbits* Qa = (hbits*)(ws + WS_QA); hbits* Ka = (hbits*)(ws + WS_KA); hbits* Va = (hbits*)(ws + WS_VA);
    hbits* Qi = (hbits*)(ws + WS_QI); hbits* Ki = (hbits*)(ws + WS_KI); float* WI = (float*)(ws + WS_WI);
    unsigned long long* MASK = (unsigned long long*)(ws + WS_MASK);
    hbits* Y = (hbits*)out; hbits* MIX = (hbits*)(ws + 234 * MiB);
    float* rstd2 = (float*)(ws + WS_MISC); int* cnt = (int*)(rstd2 + M); int* offs = cnt + 32;
    int* list = (int*)(ws + WS_RLIST); float* wlist = (float*)(ws + WS_RW);
    float* X2c = (float*)(ws + WS_X1);
    float* HID = (float*)(ws + WS_XH);
#if ONE_LAUNCH
    launch_mk(stream, grid, a, 0, 13);
#else
    for (int ph = 0; ph < 13; ++ph) launch_mk(stream, grid, a, ph, ph + 1);
#endif
}
```

```cpp
#include <hip/hip_runtime.h>
#include <stdint.h>
#include <math.h>
#include <stdio.h>
#ifndef PROBE_DOUBLE
#define PROBE_DOUBLE -1
#endif
#define PH_REP(k) (PROBE_DOUBLE == (k) ? 2 : 1)
#ifndef DBG_ATTN
#define DBG_ATTN 0
#endif
#define DBG_TOL 0.03f
#define DBG_CH_RVR 1
#define DBG_CH_ABS 1
#ifndef ONE_LAUNCH
#define ONE_LAUNCH 1
#endif
#ifndef DBG_T1
#define DBG_T1 0
#endif
#ifndef DBG_T3
#define DBG_T3 0
#endif
#ifndef DBG_T2
#define DBG_T2 0
#endif

constexpr int NB = 4, S = 4096, D = 1024, M = NB * S, INC = 2632, MEMT = 256, MR = NB * MEMT;
constexpr float EPS = 1e-6f;
constexpr float C2Q = 0.125f * 1.4426950408889634f;
constexpr float IDX_SCALE = 0.125f * 0.35355339059327373f;
typedef unsigned short hbits;
typedef _Float16 h2v __attribute__((ext_vector_type(2)));
typedef _Float16 h8v __attribute__((ext_vector_type(8)));
typedef float f32x2 __attribute__((ext_vector_type(2)));
__device__ __forceinline__ unsigned pkh(float a, float b) { f32x2 v = {a, b}; return __builtin_bit_cast(unsigned, __builtin_convertvector(v, h2v)); }
__device__ __forceinline__ float h2f(hbits b) { return (float)__builtin_bit_cast(_Float16, b); }
__device__ __forceinline__ hbits f2h(float f) { return __builtin_bit_cast(hbits, (_Float16)f); }

__device__ __forceinline__ int fx_lane() { int l; asm volatile("v_mbcnt_lo_u32_b32 %0, -1, 0\n\tv_mbcnt_hi_u32_b32 %0, -1, %0" : "=v"(l)); return l; }

constexpr size_t MiB = 1u << 20;
constexpr size_t WS_CTL = 0, CTL_ZERO_BYTES = 256 * 1024;
constexpr size_t WS_ROPE = 1 * MiB;
constexpr size_t WS_SS1 = 2 * MiB, WS_SS2 = 3 * MiB;
constexpr size_t WS_RLIST = 4 * MiB, WS_RW = 6 * MiB;
constexpr size_t WS_KVRAW = 8 * MiB;
constexpr size_t WS_RSL = 8 * MiB;
constexpr size_t WS_KMEM = 12 * MiB, WS_VMEM = 13 * MiB;
constexpr size_t WS_WI = 14 * MiB;
constexpr size_t WS_MISC = 14 * MiB + 512 * 1024;
constexpr size_t WS_PWT = 15 * MiB;
constexpr size_t WS_RWT = 15 * MiB + 256 * 1024;
constexpr size_t WS_RSTD2 = 14 * MiB + 768 * 1024;
constexpr size_t WS_RMS0 = 14 * MiB + 512 * 1024;
constexpr size_t WS_HID = 76 * MiB;
constexpr size_t WS_P = 110 * MiB;
constexpr int CW_CNT = 8192; constexpr int CW_MOE = 12288;
constexpr size_t WS_WIN = 16 * MiB;
constexpr size_t WS_WOUT = 24 * MiB, WS_WQ = 26 * MiB, WS_WO = 27 * MiB;
constexpr size_t WS_WGU = 28 * MiB, WS_WD = 60 * MiB;
constexpr size_t WS_XH = 76 * MiB;
constexpr size_t WS_U = 110 * MiB, WS_QA = 126 * MiB, WS_KA = 142 * MiB, WS_VA = 158 * MiB, WS_QI = 174 * MiB, WS_KI = 190 * MiB;
constexpr size_t WS_MASK = 192 * MiB;
constexpr size_t WS_SC2 = 200 * MiB;
constexpr size_t WS_X1 = 110 * MiB;
constexpr size_t WS_X1H = 76 * MiB;
constexpr size_t WS_QM = 174 * MiB;
constexpr size_t WS_OX = 200 * MiB;
constexpr size_t WS_X2H = 216 * MiB;
constexpr size_t WS_END = 256 * MiB;
constexpr size_t SC_BATCH_ELEMS = (size_t)4096 * 64 * 65 / 2;
__host__ __device__ __forceinline__ unsigned char* sc_batch_ptr(unsigned char* ws, unsigned char* outb, int b) {
    return (b == 0) ? (outb + 32 * MiB) : (b == 1) ? (ws + 234 * MiB) : (ws + WS_SC2 + (size_t)(b - 2) * SC_BATCH_ELEMS * 2); }
static_assert(32 * MiB + SC_BATCH_ELEMS * 2 <= 64 * MiB && 234 * MiB + SC_BATCH_ELEMS * 2 <= WS_END && WS_SC2 + 2 * SC_BATCH_ELEMS * 2 <= 234 * MiB, "SC layout");
namespace pg8 {
#define PG8_LAS __attribute__((address_space(3)))
typedef unsigned short bf16_t;
typedef short bf16x8 __attribute__((ext_vector_type(8)));
typedef float f32x4 __attribute__((ext_vector_type(4)));
typedef unsigned u32x4 __attribute__((ext_vector_type(4)));
constexpr int BM = 256, BK = 64, HALF = 128, HTB = HALF * BK * 2  , STAGE_BYTES = 8 * HTB, NXCD = 8, WGM = 8;

__host__ __device__ __forceinline__ int lds_byte(int r, int c) { const int st = (r >> 4) * 2 + (c >> 5), rr = r & 15, cc = c & 31, ob = rr * 64 + cc * 2; return st * 1024 + (ob ^ (((ob >> 9) & 1) << 5)); }
__host__ __device__ __forceinline__ void stage_rc(int b, int& R, int& C) { const int st = b / 1024, sb = b % 1024, swz = sb ^ (((sb >> 9) & 1) << 5); R = (st >> 1) * 16 + swz / 64; C = (st & 1) * 32 + (swz % 64) / 2; }
__host__ __device__ __forceinline__ int perm32(int rho) { const int n = rho >> 4, i = rho & 15; return 8 * (i >> 2) + 4 * n + (i & 3); }

struct Unit { int pm, pn; };
struct Gemm { const bf16_t* A; const bf16_t* Bt; int M, N, K; const int* glist; int gvalid; };

struct StaticOrder {
    int nM, nN, nwg, G, c;
    __host__ __device__ void init(int M, int N, int G_, int c_) { nM = M / BM; nN = N / BM; nwg = nM * nN; G = G_; c = c_; }
    __host__ __device__ bool next(int i, Unit& u) const {
        const long L = (long)i * G + c; if (L >= nwg) return false;
        int wgid = (int)L; { const int q = nwg / NXCD, r = nwg % NXCD, xcd = wgid % NXCD, off = wgid / NXCD; wgid = (xcd < r ? xcd * (q + 1) : r * (q + 1) + (xcd - r) * q) + off; }
        const int nig = WGM * nN, gid = wgid / nig, fm = gid * WGM, gsz = (nM - fm) < WGM ? (nM - fm) : WGM;
        u.pm = fm + ((wgid % nig) % gsz); u.pn = (wgid % nig) / gsz; return true;
    }
    __device__ __forceinline__ void a_ready(const Unit&) const {}
    __device__ __forceinline__ void done(const Unit&) const {}
};


template <class Epi, class Sched, bool ALIGN_EPI = false, bool SP2 = false, bool GATHER = false, bool ROWLIM = false>
__device__ __forceinline__ void gemm_phase(PG8_LAS unsigned char* lds, const Gemm g, const Sched& S, const Epi& E, int wid_in) {
    const int lane = fx_lane(), wid = wid_in, tid = wid * 64 + lane, wr = wid >> 2, wc = wid & 3, fr = lane & 15, fq = lane >> 4;
    const int K = g.K, nt = K / BK;
    const bool skip_hi_ = ROWLIM && (g.gvalid <= 128 || (g.gvalid <= 192 && wr == 1)), skip_lo_ = ROWLIM && (g.gvalid <= 64 && wr == 1);
    unsigned voffA[2], voffB[2];
#pragma unroll
    for (int i = 0; i < 2; ++i) { int R, C; stage_rc(tid * 16 + i * 8192, R, C); const int Rb = Epi::PERM ? ((R & ~31) + perm32(R & 31)) : R;
        voffA[i] = (unsigned)(R * K + C) * 2u; voffB[i] = (unsigned)(Rb * K + C) * 2u; }
    unsigned voffA0[2], voffA1[2];
#pragma unroll
    for (int i = 0; i < 2; ++i) {
        if constexpr (GATHER) { int R, C; stage_rc(tid * 16 + i * 8192, R, C);
            const bool ok0_ = R < g.gvalid, ok1_ = R + HALF < g.gvalid;
            const int e0_ = g.glist[ok0_ ? R : 0], e1_ = g.glist[ok1_ ? R + HALF : 0];
            const int t0 = ok0_ ? (e0_ >> 1) : 0, t1 = ok1_ ? (e1_ >> 1) : 0;
            voffA0[i] = (unsigned)(t0 * K + C) * 2u; voffA1[i] = (unsigned)(t1 * K + C) * 2u; }
        else { voffA0[i] = voffA[i]; voffA1[i] = voffA[i]; }
    }
    const size_t kstep = (size_t)(BK * 2);
    const size_t hstep = (size_t)HALF * K * 2;
    const size_t tstep = 2 * hstep; const size_t hstepA = GATHER ? (size_t)0 : hstep;
    const unsigned ldsw = (unsigned)wid * 1024u;
    const int aoff = lds_byte(wr * 64 + fr, fq * 8), boff = lds_byte(wc * 32 + fr, fq * 8);
#define PG8_SA(b, h) (((b) * 2 + (h)) * HTB)
#define PG8_SB(b, h) ((4 + (b) * 2 + (h)) * HTB)
#define PG8_STAGE(bufoff, gbase, voff) do { _Pragma("unroll") for (int _i = 0; _i < 2; ++_i) \
        __builtin_amdgcn_global_load_lds((const unsigned*)((const char*)(gbase) + (voff)[_i]), (PG8_LAS unsigned*)(lds + (bufoff) + ldsw + _i * 8192), 16, 0, 0); } while (0)
#define PG8_LDA(dst, b, h) do { _Pragma("unroll") for (int m = 0; m < 4; ++m) _Pragma("unroll") for (int k = 0; k < 2; ++k) dst[m][k] = *(const PG8_LAS bf16x8*)(lds + PG8_SA(b, h) + aoff + m * 2048 + k * 1024); } while (0)
#define PG8_LDB(dst, b, h) do { _Pragma("unroll") for (int n = 0; n < 2; ++n) _Pragma("unroll") for (int k = 0; k < 2; ++k) dst[n][k] = *(const PG8_LAS bf16x8*)(lds + PG8_SB(b, h) + boff + n * 2048 + k * 1024); } while (0)
#define PG8_MMA(ai, bj, At, Bt) do { if (ROWLIM && ((ai) == 1 ? skip_hi_ : skip_lo_)) break; __builtin_amdgcn_s_setprio(1); _Pragma("unroll") for (int m = 0; m < 4; ++m) _Pragma("unroll") for (int n = 0; n < 2; ++n) _Pragma("unroll") for (int k = 0; k < 2; ++k) \
        acc[ai][bj][m][n] = __builtin_amdgcn_mfma_f32_16x16x32_f16(__builtin_bit_cast(h8v, Bt[n][k]), __builtin_bit_cast(h8v, At[m][k]), acc[ai][bj][m][n], 0, 0, 0); __builtin_amdgcn_s_setprio(0); } while (0)
#define PG8_WAIT_V(n) asm volatile("s_waitcnt vmcnt(" #n ")" ::: "memory")
#define PG8_WAIT_L(n) asm volatile("s_waitcnt lgkmcnt(" #n ")" ::: "memory")
#define PG8_BAR __builtin_amdgcn_s_barrier()
#define PG8_SCHED __builtin_amdgcn_sched_barrier(0)
    Unit cur, nxt; int ui = 0;
    if (!S.next(0, cur)) return;
    f32x4 acc[2][2][4][2];
#pragma unroll
    for (int a = 0; a < 2; ++a)
#pragma unroll
        for (int b = 0; b < 2; ++b)
#pragma unroll
            for (int m = 0; m < 4; ++m)
#pragma unroll
                for (int n = 0; n < 2; ++n) acc[a][b][m][n] = (f32x4){0.f, 0.f, 0.f, 0.f};
    bf16x8 At[4][2], B0[2][2], B1[2][2];
    const char* cA = (const char*)g.A + (GATHER ? (size_t)0 : (size_t)cur.pm * tstep); const char* cB = (const char*)g.Bt + (size_t)cur.pn * tstep;
    S.a_ready(cur);
    if constexpr (SP2) {
        PG8_STAGE(PG8_SB(0, 0), cB, voffB); PG8_STAGE(PG8_SB(0, 1), cB + hstep, voffB); PG8_STAGE(PG8_SA(0, 0), cA, voffA0); PG8_STAGE(PG8_SA(0, 1), cA + hstepA, voffA1);
        if (wr == 1) PG8_BAR;
        PG8_WAIT_V(2); PG8_BAR;
        PG8_STAGE(PG8_SB(1, 0), cB + kstep, voffB); PG8_STAGE(PG8_SA(1, 0), cA + kstep, voffA0); PG8_STAGE(PG8_SB(1, 1), cB + hstep + kstep, voffB);
        PG8_WAIT_V(6); PG8_BAR;
    } else {
        PG8_STAGE(PG8_SB(0, 0), cB, voffB); PG8_STAGE(PG8_SA(0, 0), cA, voffA0); PG8_STAGE(PG8_SB(0, 1), cB + hstep, voffB); PG8_STAGE(PG8_SA(0, 1), cA + hstepA, voffA1);
        if (wr == 1) PG8_BAR;
        PG8_WAIT_V(4); PG8_BAR;
        PG8_STAGE(PG8_SB(1, 0), cB + kstep, voffB); PG8_STAGE(PG8_SA(1, 0), cA + kstep, voffA0); PG8_STAGE(PG8_SB(1, 1), cB + hstep + kstep, voffB);
        PG8_WAIT_V(6); PG8_BAR;
    }
    for (;;) {
        const bool has_next = S.next(ui + 1, nxt);
        const char* nA = (has_next && !GATHER) ? (const char*)g.A + (size_t)nxt.pm * tstep : cA; const char* nB = has_next ? (const char*)g.Bt + (size_t)nxt.pn * tstep : cB;
        for (int t = 0; t < nt; t += 2) {
            const bool last = (t == nt - 2);
            const char* a1 = cA + (size_t)(t + 1) * kstep;
            const char* a2 = last ? nA : cA + (size_t)(t + 2) * kstep; const char* b2 = last ? nB : cB + (size_t)(t + 2) * kstep;
            const char* a3 = a2 + kstep; const char* b3 = b2 + kstep;
            if (last && has_next) S.a_ready(nxt);
            if constexpr (SP2) {
            PG8_LDB(B0, 0, 0); PG8_LDB(B1, 0, 1); PG8_SCHED; PG8_LDA(At, 0, 0); PG8_STAGE(PG8_SA(1, 1), a1 + hstepA, voffA1);
            PG8_WAIT_V(8); PG8_WAIT_L(0); PG8_BAR; PG8_MMA(0, 0, At, B0); PG8_MMA(0, 1, At, B1); PG8_BAR; PG8_SCHED;
            PG8_LDA(At, 0, 1); PG8_STAGE(PG8_SB(0, 0), b2, voffB); PG8_STAGE(PG8_SB(0, 1), b2 + hstep, voffB); PG8_STAGE(PG8_SA(0, 0), a2, voffA0);
            PG8_WAIT_V(8); PG8_WAIT_L(0); PG8_BAR; PG8_MMA(1, 0, At, B0); PG8_MMA(1, 1, At, B1); PG8_BAR; PG8_SCHED;
            PG8_LDB(B0, 1, 0); PG8_LDB(B1, 1, 1); PG8_SCHED; PG8_LDA(At, 1, 0); PG8_STAGE(PG8_SA(0, 1), a2 + hstepA, voffA1);
            PG8_WAIT_V(8); PG8_WAIT_L(0); PG8_BAR; PG8_MMA(0, 0, At, B0); PG8_MMA(0, 1, At, B1); PG8_BAR; PG8_SCHED;
            PG8_LDA(At, 1, 1); PG8_STAGE(PG8_SB(1, 0), b3, voffB); PG8_STAGE(PG8_SB(1, 1), b3 + hstep, voffB); PG8_STAGE(PG8_SA(1, 0), a3, voffA0);
            PG8_WAIT_V(8); PG8_WAIT_L(0); PG8_BAR; PG8_MMA(1, 0, At, B0); PG8_MMA(1, 1, At, B1); PG8_BAR; PG8_SCHED;
            } else {
            PG8_LDB(B0, 0, 0); PG8_SCHED; PG8_LDA(At, 0, 0); PG8_STAGE(PG8_SA(1, 1), a1 + hstepA, voffA1);
            PG8_WAIT_L(8); PG8_BAR; PG8_WAIT_L(0); PG8_MMA(0, 0, At, B0); PG8_BAR; PG8_SCHED;
            PG8_LDB(B1, 0, 1); PG8_STAGE(PG8_SB(0, 0), b2, voffB);
            PG8_BAR; PG8_WAIT_L(0); PG8_MMA(0, 1, At, B1); PG8_BAR;
            PG8_LDA(At, 0, 1); PG8_STAGE(PG8_SA(0, 0), a2, voffA0);
            PG8_BAR; PG8_WAIT_L(0); PG8_MMA(1, 0, At, B0); PG8_BAR; PG8_SCHED;
            PG8_STAGE(PG8_SB(0, 1), b2 + hstep, voffB);
            PG8_WAIT_V(6); PG8_BAR; PG8_MMA(1, 1, At, B1); PG8_BAR;
            PG8_LDB(B0, 1, 0); PG8_SCHED; PG8_LDA(At, 1, 0); PG8_STAGE(PG8_SA(0, 1), a2 + hstepA, voffA1);
            PG8_WAIT_L(8); PG8_BAR; PG8_WAIT_L(0); PG8_MMA(0, 0, At, B0); PG8_BAR; PG8_SCHED;
            PG8_LDB(B1, 1, 1); PG8_STAGE(PG8_SB(1, 0), b3, voffB);
            PG8_BAR; PG8_WAIT_L(0); PG8_MMA(0, 1, At, B1); PG8_BAR;
            PG8_LDA(At, 1, 1); PG8_STAGE(PG8_SA(1, 0), a3, voffA0);
            PG8_BAR; PG8_WAIT_L(0); PG8_MMA(1, 0, At, B0); PG8_BAR; PG8_SCHED;
            PG8_STAGE(PG8_SB(1, 1), b3 + hstep, voffB);
            PG8_WAIT_V(6); PG8_BAR; PG8_MMA(1, 1, At, B1); PG8_BAR;
            }
        }
        if constexpr (ALIGN_EPI) { if (wr == 0) PG8_BAR; }
        if constexpr (!Epi::AFTER_DRAIN) { int l2_ = lane; asm volatile("" : "+v"(l2_)); E(acc, cur, wr, wc, l2_ & 15, l2_ >> 4); S.done(cur); }
        if (!has_next) break;
#pragma unroll
        for (int a = 0; a < 2; ++a)
#pragma unroll
            for (int b = 0; b < 2; ++b)
#pragma unroll
                for (int m = 0; m < 4; ++m)
#pragma unroll
                    for (int n = 0; n < 2; ++n) acc[a][b][m][n] = (f32x4){0.f, 0.f, 0.f, 0.f};
        cur = nxt; cA = nA; cB = nB; ++ui;
        if constexpr (ALIGN_EPI) { if (wr == 1) PG8_BAR; }
    }
    PG8_WAIT_V(0);
    if constexpr (!ALIGN_EPI) { if (wr == 0) PG8_BAR; }
    PG8_BAR;
    if constexpr (Epi::AFTER_DRAIN) { E.fused(acc, cur, wr, wc, fr, fq, lds, wid, lane); S.done(cur); }
#undef PG8_SA
#undef PG8_SB
#undef PG8_STAGE
#undef PG8_LDA
#undef PG8_LDB
#undef PG8_MMA
#undef PG8_WAIT_V
#undef PG8_WAIT_L
#undef PG8_BAR
#undef PG8_SCHED
}
}

#ifndef PG8_SP2
#define PG8_SP2 true
#endif
#ifndef PG8_ALIGN
#define PG8_ALIGN true
#endif
namespace pg8 {
template <bool NORM>
__device__ __forceinline__ void head_store(const f32x4 (&acc)[2][2][4][2], int row0, hbits* dst, int ldd, int col0, const float* gain, float scale, int fq,
                                           const float* __restrict__ cosT, const float* __restrict__ sinT) {
    f32x4 g[2][2];
    if (NORM) {
#pragma unroll
        for (int bj = 0; bj < 2; ++bj)
#pragma unroll
            for (int n = 0; n < 2; ++n) g[bj][n] = *(const f32x4*)(gain + 32 * bj + 8 * fq + 4 * n);
    }
#pragma unroll
    for (int ai = 0; ai < 2; ++ai)
#pragma unroll
        for (int mp = 0; mp < 2; ++mp) {
            f32x4 cc[2][2], sn[2][2];
#pragma unroll
            for (int mi = 0; mi < 2; ++mi) { const int pos = (row0 + ai * HALF + (2 * mp + mi) * 16) & (S - 1);
#pragma unroll
                for (int n = 0; n < 2; ++n) { cc[mi][n] = *(const f32x4*)(cosT + pos * 32 + 8 * fq + 4 * n); sn[mi][n] = *(const f32x4*)(sinT + pos * 32 + 8 * fq + 4 * n); } }
#pragma unroll
            for (int mi = 0; mi < 2; ++mi) {
            const int m = 2 * mp + mi;
            const int row = row0 + ai * HALF + m * 16;
            f32x4 v[2][2];
#pragma unroll
            for (int bj = 0; bj < 2; ++bj)
#pragma unroll
                for (int n = 0; n < 2; ++n) v[bj][n] = acc[ai][bj][m][n];
            if (NORM) {
                float ss = 0.f;
#pragma unroll
                for (int bj = 0; bj < 2; ++bj)
#pragma unroll
                    for (int n = 0; n < 2; ++n) ss += (v[bj][n][0] * v[bj][n][0] + v[bj][n][1] * v[bj][n][1]) + (v[bj][n][2] * v[bj][n][2] + v[bj][n][3] * v[bj][n][3]);
                ss += __shfl_xor(ss, 16); ss += __shfl_xor(ss, 32);
                const float r = rsqrtf(ss * (1.0f / 64.0f) + EPS);
#pragma unroll
                for (int bj = 0; bj < 2; ++bj)
#pragma unroll
                    for (int n = 0; n < 2; ++n) v[bj][n] = v[bj][n] * r * g[bj][n];
            }
            f32x4 olo[2], ohi[2];
#pragma unroll
            for (int n = 0; n < 2; ++n) {
                const f32x4 c = cc[mi][n], s = sn[mi][n];
                olo[n] = (v[0][n] * c - v[1][n] * s) * scale; ohi[n] = (v[1][n] * c + v[0][n] * s) * scale;
            }
            u32x4 w0, w1;
            w0.x = pkh(olo[0][0], olo[0][1]); w0.y = pkh(olo[0][2], olo[0][3]); w0.z = pkh(olo[1][0], olo[1][1]); w0.w = pkh(olo[1][2], olo[1][3]);
            w1.x = pkh(ohi[0][0], ohi[0][1]); w1.y = pkh(ohi[0][2], ohi[0][3]); w1.z = pkh(ohi[1][0], ohi[1][1]); w1.w = pkh(ohi[1][2], ohi[1][3]);
            hbits* p = dst + (size_t)row * ldd + col0;
            *(u32x4*)p = w0; *(u32x4*)(p + 32) = w1;
            }
        }
}
__device__ __forceinline__ void plain_store_h(const f32x4 (&acc)[2][2][4][2], int row0, hbits* dst, int ldd, int col0) {
#pragma unroll
    for (int ai = 0; ai < 2; ++ai)
#pragma unroll
        for (int m = 0; m < 4; ++m) {
            hbits* p = dst + (size_t)(row0 + ai * HALF + m * 16) * ldd + col0;
#pragma unroll
            for (int bj = 0; bj < 2; ++bj) {
                const f32x4 v0 = acc[ai][bj][m][0], v1 = acc[ai][bj][m][1];
                u32x4 w; w.x = pkh(v0[0], v0[1]); w.y = pkh(v0[2], v0[3]); w.z = pkh(v1[0], v1[1]); w.w = pkh(v1[2], v1[3]);
                *(u32x4*)(p + bj * HALF) = w;
            }
        }
}
struct EpiIn {
    static constexpr bool PERM = true, AFTER_DRAIN = false;
    hbits *U, *Qa, *Ka, *Va, *Qi, *Ki; float *WI, *KVraw;
    const float *cosT, *sinT, *qg, *kg, *kig;
    __device__ __forceinline__ void operator()(const f32x4 (&acc)[2][2][4][2], const Unit& u, int wr, int wc, int fr, int fq) const {
        const int pn = u.pn;
        if (u.pm >= 64) {
            const int row0 = (u.pm - 64) * BM + wr * 64 + fr, col0 = (pn - 11) * BM + wc * 32 + 8 * fq;
#pragma unroll
            for (int ai = 0; ai < 2; ++ai)
#pragma unroll
                for (int m = 0; m < 4; ++m) { float* p = KVraw + (size_t)(row0 + ai * HALF + m * 16) * 1024 + col0;
#pragma unroll
                    for (int bj = 0; bj < 2; ++bj) { *(f32x4*)(p + bj * HALF) = acc[ai][bj][m][0]; *(f32x4*)(p + bj * HALF + 4) = acc[ai][bj][m][1]; } }
            return;
        }
        const int row0 = u.pm * BM + wr * 64 + fr;
        if (pn < 2) { plain_store_h(acc, row0, U, 512, pn * BM + wc * 32 + 8 * fq); }
        else if (pn == 6 || pn == 7) { plain_store_h(acc, row0, Va, 512, (pn - 6) * BM + wc * 32 + 8 * fq); }
        else if (pn == 2 || pn == 3) { head_store<true>(acc, row0, Qa, 512, (4 * (pn & 1) + wc) * 64 + 8 * fq, qg, C2Q, fq, cosT, sinT); }
        else if (pn == 4 || pn == 5) { head_store<true>(acc, row0, Ka, 512, (4 * (pn & 1) + wc) * 64 + 8 * fq, kg, 1.0f, fq, cosT, sinT); }
        else if (pn == 8 || pn == 9) { head_store<false>(acc, row0, Qi, 512, (4 * (pn & 1) + wc) * 64 + 8 * fq, nullptr, 1.0f, fq, cosT, sinT); }
        else {
            if (wc == 0) head_store<true>(acc, row0, Ki, 64, 8 * fq, kig, 1.0f, fq, cosT, sinT);
            else if (wc == 1 && fq == 0) {
#pragma unroll
                for (int ai = 0; ai < 2; ++ai)
#pragma unroll
                    for (int m = 0; m < 4; ++m) { float* p = WI + (size_t)(row0 + ai * HALF + m * 16) * 8;
                        *(f32x4*)p = acc[ai][0][m][0] * IDX_SCALE; *(f32x4*)(p + 4) = acc[ai][0][m][1] * IDX_SCALE; }
            }
        }
    }
};
struct SchedIn {
    StaticOrder so; int G, c;
    __device__ void init(int G_, int c_) { so.init(M, 2816, G_, c_); G = G_; c = c_; }
    __device__ bool next(int i, Unit& u) const {
        if (so.next(i, u)) return true;
        const long L = (long)i * G + c - 704; if (L >= 16) return false;
        u.pm = 64 + (int)(L >> 2); u.pn = 11 + (int)(L & 3); return true;
    }
    __device__ __forceinline__ void a_ready(const Unit&) const {}
    __device__ __forceinline__ void done(const Unit&) const {}
};
template <bool RH, bool RS = false>
struct EpiRes {
    static constexpr bool PERM = true, AFTER_DRAIN = false;
    const void* resid; hbits* outh; float* ss; const float* rs;
    __device__ __forceinline__ void operator()(const f32x4 (&acc)[2][2][4][2], const Unit& u, int wr, int wc, int fr, int fq) const {
        const int row0 = u.pm * BM + wr * 64 + fr, col0 = u.pn * BM + wc * 32 + 8 * fq;
#pragma unroll
        for (int ai = 0; ai < 2; ++ai)
#pragma unroll
            for (int mp = 0; mp < 2; ++mp) {
                float rsv[2] = {1.f, 1.f};
                if (RS) { rsv[0] = rs[row0 + ai * HALF + (2 * mp) * 16]; rsv[1] = rs[row0 + ai * HALF + (2 * mp + 1) * 16]; }
                f32x4 r0[2][2], r1[2][2];
#pragma unroll
                for (int mi = 0; mi < 2; ++mi) { const int m = 2 * mp + mi; const size_t off = (size_t)(row0 + ai * HALF + m * 16) * D + col0;
#pragma unroll
                    for (int bj = 0; bj < 2; ++bj) {
                        if (RH) { const u32x4 rv = *(const u32x4*)((const hbits*)resid + off + bj * HALF); const unsigned a = rv.x, b = rv.y, c = rv.z, d = rv.w;
                            const h2v h0 = __builtin_bit_cast(h2v, a), h1 = __builtin_bit_cast(h2v, b), h2 = __builtin_bit_cast(h2v, c), h3 = __builtin_bit_cast(h2v, d);
                            r0[mi][bj] = (f32x4){(float)h0[0], (float)h0[1], (float)h1[0], (float)h1[1]}; r1[mi][bj] = (f32x4){(float)h2[0], (float)h2[1], (float)h3[0], (float)h3[1]}; }
                        else { r0[mi][bj] = *(const f32x4*)((const float*)resid + off + bj * HALF); r1[mi][bj] = *(const f32x4*)((const float*)resid + off + bj * HALF + 4); } } }
#pragma unroll
                for (int mi = 0; mi < 2; ++mi) { const int m = 2 * mp + mi; const int row = row0 + ai * HALF + m * 16; const size_t off = (size_t)row * D + col0; float q = 0.f;
#pragma unroll
                    for (int bj = 0; bj < 2; ++bj) {
                        const f32x4 v0 = (RS ? r0[mi][bj] * rsv[mi] : r0[mi][bj]) + acc[ai][bj][m][0], v1 = (RS ? r1[mi][bj] * rsv[mi] : r1[mi][bj]) + acc[ai][bj][m][1];
                        u32x4 w; w.x = pkh(v0[0], v0[1]); w.y = pkh(v0[2], v0[3]); w.z = pkh(v1[0], v1[1]); w.w = pkh(v1[2], v1[3]);
                        *(u32x4*)(outh + off + bj * HALF) = w;
                        q += (v0[0] * v0[0] + v0[1] * v0[1]) + (v0[2] * v0[2] + v0[3] * v0[3]) + (v1[0] * v1[0] + v1[1] * v1[1]) + (v1[2] * v1[2] + v1[3] * v1[3]);
                    }
                    q += __shfl_xor(q, 16); q += __shfl_xor(q, 32);
                    if (fq == 0) ss[(size_t)row * 16 + u.pn * 4 + wc] = q; }
            }
    }
};
struct EpiWq {
    static constexpr bool PERM = true, AFTER_DRAIN = false;
    const float* ss; hbits* out;
    __device__ __forceinline__ void operator()(const f32x4 (&acc)[2][2][4][2], const Unit& u, int wr, int wc, int fr, int fq) const {
        const int row0 = u.pm * BM + wr * 64 + fr, col0 = u.pn * BM + wc * 32 + 8 * fq;
        f32x4 pv[2][4];
#pragma unroll
        for (int ai = 0; ai < 2; ++ai)
#pragma unroll
            for (int m = 0; m < 4; ++m) pv[ai][m] = *(const f32x4*)(ss + (size_t)(row0 + ai * HALF + m * 16) * 16 + 4 * fq);
#pragma unroll
        for (int ai = 0; ai < 2; ++ai)
#pragma unroll
            for (int m = 0; m < 4; ++m) {
                const int row = row0 + ai * HALF + m * 16;
                float t = (pv[ai][m][0] + pv[ai][m][1]) + (pv[ai][m][2] + pv[ai][m][3]);
                t += __shfl_xor(t, 16); t += __shfl_xor(t, 32);
                const float r = rsqrtf(t * (1.0f / 1024.0f) + EPS);
                hbits* p = out + (size_t)row * 512 + col0;
#pragma unroll
                for (int bj = 0; bj < 2; ++bj) { const f32x4 v0 = acc[ai][bj][m][0] * r, v1 = acc[ai][bj][m][1] * r;
                    u32x4 w; w.x = pkh(v0[0], v0[1]); w.y = pkh(v0[2], v0[3]); w.z = pkh(v1[0], v1[1]); w.w = pkh(v1[2], v1[3]);
                    *(u32x4*)(p + bj * HALF) = w; }
            }
    }
};

struct SchedTwo {
    Unit ua, ub; int n;
    __device__ bool next(int i, Unit& u) const { if (i >= n) return false; u = i ? ub : ua; return true; }
    __device__ __forceinline__ void a_ready(const Unit&) const {}
    __device__ __forceinline__ void done(const Unit&) const {}
};
struct SchedOne {
    Unit un;
    __device__ bool next(int i, Unit& u) const { if (i != 0) return false; u = un; return true; }
    __device__ __forceinline__ void a_ready(const Unit&) const {}
    __device__ __forceinline__ void done(const Unit&) const {}
};
struct EpiGU {
    static constexpr bool PERM = true, AFTER_DRAIN = false;
    hbits* HID; const float* gw; const float* grs; int nvalid, hidrow0;
    __device__ __forceinline__ void operator()(const f32x4 (&acc)[2][2][4][2], const Unit& u, int wr, int wc, int fr, int fq) const {
#pragma unroll
        for (int ai = 0; ai < 2; ++ai) {
            float rr_[4], ww_[4];
#pragma unroll
            for (int i = 0; i < 4; ++i) { const int rl = wr * 64 + fr + ai * HALF + i * 16; const int rc = (rl < nvalid) ? rl : 0; ww_[i] = gw[rc]; rr_[i] = grs[rc]; }
#pragma unroll
            for (int i = 0; i < 4; ++i) { const int rl = wr * 64 + fr + ai * HALF + i * 16; const bool ok = rl < nvalid; ww_[i] = ok ? ww_[i] : 0.f; rr_[i] = ok ? rr_[i] : 0.f; }
#pragma unroll
            for (int m = 0; m < 4; ++m) {
                const int rl = wr * 64 + fr + ai * HALF + m * 16;
                const float r = rr_[m], w = ww_[m];
                f32x4 h[2];
#pragma unroll
                for (int n = 0; n < 2; ++n) {
                    const f32x4 g = acc[ai][0][m][n] * r, uu = acc[ai][1][m][n] * r;
#pragma unroll
                    for (int j = 0; j < 4; ++j) { const float sg = g[j] * __builtin_amdgcn_rcpf(1.0f + __builtin_amdgcn_exp2f(-1.4426950408889634f * g[j])); h[n][j] = sg * uu[j] * w; }
                }
                u32x4 o; o.x = pkh(h[0][0], h[0][1]); o.y = pkh(h[0][2], h[0][3]); o.z = pkh(h[1][0], h[1][1]); o.w = pkh(h[1][2], h[1][3]);
                { hbits* hp_ = HID + (size_t)(hidrow0 + rl) * 256 + 128 * (u.pn & 1) + 32 * wc + 8 * fq;
                  asm volatile("global_store_dwordx4 %0, %1, off sc0 sc1\n\ts_nop 1" :: "v"(hp_), "v"(o) : "memory"); }
            }
        }
    }
};
struct MoeTab { const PG8_LAS int* TB; const PG8_LAS int* TC; int TT;
    __device__ __forceinline__ int expert_of(int tile) const { int e = 0;
#pragma unroll 1
        for (int i = 1; i < 32; ++i) if (TB[i] <= tile) e = i; return e; } };
struct SchedList {
    const PG8_LAS int* UL; int n;
    __device__ bool next(int i, Unit& u) const { if (i >= n) return false; u.pm = __builtin_amdgcn_readfirstlane(UL[2 * i]); u.pn = __builtin_amdgcn_readfirstlane(UL[2 * i + 1]); return true; }
    __device__ __forceinline__ void a_ready(const Unit&) const {}
    __device__ __forceinline__ void done(const Unit&) const {}
};
struct EpiDown {
    static constexpr bool PERM = true, AFTER_DRAIN = false;
    MoeTab tab; const int* rlist; hbits* P;
    __device__ __forceinline__ void operator()(const f32x4 (&acc)[2][2][4][2], const Unit& u, int wr, int wc, int fr, int fq) const {
        const int e = u.pn >> 2, cn = u.pn & 3, rt = u.pm - __builtin_amdgcn_readfirstlane(tab.TB[e]), nvalid = __builtin_amdgcn_readfirstlane(tab.TC[e]) - rt * 256;
        const int* gl = rlist + (size_t)e * M + rt * 256;
#pragma unroll
        for (int ai = 0; ai < 2; ++ai) {
            int ent_[4];
#pragma unroll
            for (int i = 0; i < 4; ++i) { const int rl = wr * 64 + fr + ai * HALF + i * 16; ent_[i] = gl[(rl < nvalid) ? rl : 0]; }
#pragma unroll
            for (int i = 0; i < 4; ++i) { const int rl = wr * 64 + fr + ai * HALF + i * 16; ent_[i] = (rl < nvalid) ? ent_[i] : -1; }
#pragma unroll
            for (int m = 0; m < 4; ++m) {
                const int ent = ent_[m];
                if (ent >= 0) {
                    hbits* p = P + ((size_t)(ent & 1) * M + (ent >> 1)) * D + cn * BM + 32 * wc + 8 * fq;
#pragma unroll
                    for (int bj = 0; bj < 2; ++bj) { const f32x4 v0 = acc[ai][bj][m][0], v1 = acc[ai][bj][m][1];
                        u32x4 w; w.x = pkh(v0[0], v0[1]); w.y = pkh(v0[2], v0[3]); w.z = pkh(v1[0], v1[1]); w.w = pkh(v1[2], v1[3]);
                        __builtin_nontemporal_store(w, (u32x4*)(p + bj * HALF)); }
                }
            }
        }
    }
};
}
namespace attn_body {
using bf16=unsigned short;
using bf16x8=__attribute__((ext_vector_type(8)))short;
using s16x4=__attribute__((ext_vector_type(4)))short;
using f32x16=__attribute__((ext_vector_type(16)))float;
using u32x4=__attribute__((ext_vector_type(4)))unsigned;
constexpr int BATCH=4,NHEAD=8,SEQ=4096,D=64,DM=NHEAD*D,OPITCH=1024,OCOL0=512;
constexpr int NW=8,QBLK=32,QB=QBLK*NW,KVBLK=64,NQB=SEQ/QB;
constexpr int ATTN_PITCH=DM, ATTN_UNIT_ROWS=QB;
__device__ __forceinline__ int crow(int r,int hi){return (r&3)+8*(r>>2)+4*hi;}
#define SBAR() __builtin_amdgcn_sched_barrier(0)
#define MFMA16H(a,b,c,x,y,z) __builtin_amdgcn_mfma_f32_32x32x16_f16(__builtin_bit_cast(h8v,(a)),__builtin_bit_cast(h8v,(b)),(c),0,0,0)
constexpr int NSLOT=3, SLOTB=8192;
constexpr int LDS_K=0, LDS_V=NSLOT*SLOTB, LDS_WS=2*NSLOT*SLOTB, LDS_OST=LDS_WS+NW*64*4, LDS_BYTES=LDS_OST+NW*4096;
constexpr float C2=0.125f*1.4426950408889634f;
__device__ __forceinline__ void glds16(const void*gsrc,unsigned lds_dst){unsigned keep;
  asm volatile("s_mov_b32 %0, m0\n\ts_mov_b32 m0, %2\n\ts_nop 0\n\tglobal_load_lds_dwordx4 %1, off\n\ts_mov_b32 m0, %0":"=&s"(keep):"v"(gsrc),"s"(lds_dst):"memory");}
__device__ __forceinline__ float max3f(float a,float b,float c){float r;asm("v_max3_f32 %0, %1, %2, %3":"=v"(r):"v"(a),"v"(b),"v"(c));return r;}
__device__ __forceinline__ float max2f(float a,float b){float r;asm("v_max_f32_e32 %0, %1, %2":"=v"(r):"v"(a),"v"(b));return r;}
__device__ __forceinline__ float fadd_s(float a,float b){float r;asm("v_add_f32_e32 %0, %1, %2":"=v"(r):"v"(a),"v"(b));return r;}
__device__ __forceinline__ float fsub_s(float a,float b){float r;asm("v_sub_f32_e32 %0, %1, %2":"=v"(r):"v"(a),"v"(b));return r;}
__device__ __forceinline__ unsigned cvtpk_s(float lo,float hi){return pkh(lo,hi);}
#define WAIT_BAR(N) asm volatile("s_waitcnt vmcnt(" #N ") lgkmcnt(0)\n\ts_barrier":::"memory")
#define WAIT_BARM(N,MK) asm volatile("s_waitcnt vmcnt(" #N ") lgkmcnt(0)\n\ts_barrier":"+v"(MK)::"memory")

__device__ __forceinline__ void qkt(f32x16&p0,f32x16&p1,const char*Kslot,const bf16x8*qr,const f32x16&negm,int r32,int hi){
  const char*kb=Kslot+hi*1024+r32*16;
  #pragma unroll
  for(int d0=0;d0<4;++d0){
    const bf16x8 b0=*reinterpret_cast<const bf16x8*>(kb+d0*2048);
    const bf16x8 b1=*reinterpret_cast<const bf16x8*>(kb+d0*2048+512);
    if(d0==0){p0=MFMA16H(b0,qr[0],negm,0,0,0);p1=MFMA16H(b1,qr[0],negm,0,0,0);}
    else{p0=MFMA16H(b0,qr[d0],p0,0,0,0);p1=MFMA16H(b1,qr[d0],p1,0,0,0);}}
}
typedef __attribute__((address_space(3))) const char* lds_cptr;
typedef short v4i16_t __attribute__((ext_vector_type(4)));
__device__ __forceinline__ void kload8(bf16x8*kf,lds_cptr kp){
  kf[0]=*(const __attribute__((address_space(3))) bf16x8*)(kp);      kf[1]=*(const __attribute__((address_space(3))) bf16x8*)(kp+512);
  kf[2]=*(const __attribute__((address_space(3))) bf16x8*)(kp+2048); kf[3]=*(const __attribute__((address_space(3))) bf16x8*)(kp+2560);
  kf[4]=*(const __attribute__((address_space(3))) bf16x8*)(kp+4096); kf[5]=*(const __attribute__((address_space(3))) bf16x8*)(kp+4608);
  kf[6]=*(const __attribute__((address_space(3))) bf16x8*)(kp+6144); kf[7]=*(const __attribute__((address_space(3))) bf16x8*)(kp+6656);
}
__device__ __forceinline__ void kload2(bf16x8*kf,lds_cptr kp,int j){ kf[2*j]=*(const __attribute__((address_space(3))) bf16x8*)(kp+j*2048); kf[2*j+1]=*(const __attribute__((address_space(3))) bf16x8*)(kp+j*2048+512); }
__device__ __forceinline__ s16x4 vtr(lds_cptr p){ return __builtin_bit_cast(s16x4,__builtin_amdgcn_ds_read_tr16_b64_v4i16((__attribute__((address_space(3))) v4i16_t*)p)); }
__device__ __forceinline__ float rowmax(const f32x16&p0,const f32x16&p1){
  float a=max3f(p0[0],p0[1],p1[0]),b=max3f(p0[2],p0[3],p1[1]);a=max3f(a,p1[2],p1[3]);
  #pragma unroll
  for(int r=4;r<16;r+=4){a=max3f(a,p0[r],p0[r+1]);b=max3f(b,p0[r+2],p0[r+3]);a=max3f(a,p1[r],p1[r+1]);b=max3f(b,p1[r+2],p1[r+3]);}
  const float m=max2f(a,b);
  auto rr=__builtin_amdgcn_permlane32_swap(__float_as_uint(m),__float_as_uint(m),false,false);
  return max2f(__uint_as_float(rr[0]),__uint_as_float(rr[1]));
}
__device__ __forceinline__ void pv(f32x16*o,int vb,bf16x8 pa0,bf16x8 pa1,bf16x8 pa2,bf16x8 pa3){
  #pragma unroll
  for(int d0=0;d0<2;++d0){s16x4 lo[4],hi[4];
    #pragma unroll
    for(int ks=0;ks<4;++ks){
      asm volatile("ds_read_b64_tr_b16 %0,%1 offset:%c2":"=&v"(lo[ks]):"v"(vb),"i"(d0*4096+ks*1024):"memory");
      asm volatile("ds_read_b64_tr_b16 %0,%1 offset:%c2":"=&v"(hi[ks]):"v"(vb),"i"(d0*4096+ks*1024+512):"memory");}
    asm volatile("s_waitcnt lgkmcnt(0)":::"memory");SBAR();
    #define PK(k) (bf16x8){lo[k][0],lo[k][1],lo[k][2],lo[k][3],hi[k][0],hi[k][1],hi[k][2],hi[k][3]}
    o[d0]=MFMA16H(pa0,PK(0),o[d0],0,0,0);
    o[d0]=MFMA16H(pa1,PK(1),o[d0],0,0,0);
    o[d0]=MFMA16H(pa2,PK(2),o[d0],0,0,0);
    o[d0]=MFMA16H(pa3,PK(3),o[d0],0,0,0);
    #undef PK
  }
}

__device__ __forceinline__ float msel(float x,int t){ const int xi=__builtin_bit_cast(int,x); return __builtin_bit_cast(float,__builtin_amdgcn_bitop3_b32(xi,(int)0xc76a6000,t,0xE4)); }
#ifndef ATTN_STORE16
#define ATTN_STORE16(p,v) __builtin_nontemporal_store((v),(u32x4*)(p))
#endif
__device__ __forceinline__ void attn_unit(int b,int h,int qb,const bf16*Q,const bf16*__restrict__ K,const bf16*__restrict__ V,bf16*O,const unsigned long long*__restrict__ MASK,float mref,char*shm,int wid){
  const int lane=fx_lane(),tid=wid*64+lane,r32=lane&31,hi=lane>>5; (void)tid;
  const long rowbase=(long)b*SEQ; const int q0=qb*QB;
  const bf16*Qw=Q+(rowbase+q0+wid*QBLK)*DM+h*D;
  const bf16*Kh=K+rowbase*DM+h*D,*Vh=V+rowbase*DM+h*D;
  const unsigned lds0=(unsigned)(uintptr_t)shm;
  float*wsf=(float*)(shm+LDS_WS)+wid*64;
  const bf16*ksrc=Kh+(long)lane*DM+wid*8;
  const bf16*vsrc=Vh+(long)(16*(wid&3)+(lane>>2))*DM+(wid>>2)*32+(lane&3)*8;
  const unsigned kdst=lds0+LDS_K+wid*1024, vdst=lds0+LDS_V+wid*1024;
  #define DMA_K(t,slot) glds16(ksrc+(long)(t)*KVBLK*DM,(unsigned)__builtin_amdgcn_readfirstlane(kdst+(slot)))
  #define DMA_V(t,slot) glds16(vsrc+(long)(t)*KVBLK*DM,(unsigned)__builtin_amdgcn_readfirstlane(vdst+(slot)))
  const int vb0=(int)(lds0+LDS_V)+((lane>>4)&1)*32+(lane&3)*8+(4*hi+((lane&15)>>2))*64;
  const char*Kbase=shm+LDS_K; bf16x8 kf[8];
  const lds_cptr shm3=(lds_cptr)shm; const lds_cptr kp0=shm3+LDS_K+hi*1024+r32*16; const lds_cptr vp0=shm3+LDS_V+((lane>>4)&1)*32+(lane&3)*8+(4*hi+((lane&15)>>2))*64;
  const int NT=(q0+QB)/KVBLK;
  const unsigned long long*mbase=MASK+((size_t)(rowbase+q0+wid*QBLK))*64; const unsigned mvoff=(unsigned)r32*512u; unsigned long long mkA,mkB;
  #define MLOAD(dst,t) dst=*(const unsigned long long*)((const char*)(mbase+(t))+mvoff)
  #define MPIN(x) asm volatile("":"+v"(x))
  const int sh4=4*hi; const int NEGI=(int)0xc76a6000;
  #define MAPPLY(C0,C1,MK) do{ const unsigned lo_=((unsigned)(MK))>>sh4, hi_=((unsigned)((MK)>>32))>>sh4; \
    _Pragma("unroll") for(int r=0;r<16;++r){ const int kb_=(r&3)+8*(r>>2); \
      const int t0_=__builtin_amdgcn_sbfe((int)lo_,kb_,1), t1_=__builtin_amdgcn_sbfe((int)hi_,kb_,1); \
      C0[r]=msel(C0[r],t0_); C1[r]=msel(C1[r],t1_); } }while(0)
  MLOAD(mkA,0);MLOAD(mkB,1);
  DMA_K(0,0);DMA_V(0,0);DMA_K(1,SLOTB);
  bf16x8 qr[4];
  #pragma unroll
  for(int d0=0;d0<4;++d0)qr[d0]=*reinterpret_cast<const bf16x8*>(&Qw[(long)r32*DM+d0*16+hi*8]);
  float l_reg=0.f;f32x16 o[2];o[0]=f32x16{};o[1]=f32x16{};const f32x16 negm=f32x16{};
  const int qrel=wid*QBLK+r32;
  f32x16 pA0,pA1,pB0,pB1;
  int sl_prev=0,sl_cur=0,sl_next=SLOTB;
  #define ROT() do{sl_prev=sl_cur;sl_cur=sl_next;sl_next=(sl_next==(NSLOT-1)*SLOTB)?0:sl_next+SLOTB;}while(0)
  DMA_K(2,2*SLOTB);
  WAIT_BAR(3);
  qkt(pA0,pA1,Kbase,qr,negm,r32,hi);asm volatile("s_nop 15\n\ts_nop 7":"+v"(pA0),"+v"(pA1));MAPPLY(pA0,pA1,mkA);
  _Pragma("unroll") for(int r=0;r<16;++r)pA0[r]=__builtin_amdgcn_exp2f(pA0[r]);
  _Pragma("unroll") for(int r=0;r<16;++r)pA1[r]=__builtin_amdgcn_exp2f(pA1[r]);
  WAIT_BAR(0);
  DMA_K(3,0);DMA_V(1,SLOTB);
  ROT();
  kload8(kf,kp0+sl_cur);
  WAIT_BAR(2);
  s16x4 vlo[8],vhi[8]; u32x4 pw0,pw1,pw2,pw3;
  #define PKW(P,B) cvtpk_s(P[B],P[B+1])
  #define PAF(k) __builtin_bit_cast(bf16x8,pw##k)
  #define VFR(i) (bf16x8){vlo[i][0],vlo[i][1],vlo[i][2],vlo[i][3],vhi[i][0],vhi[i][1],vhi[i][2],vhi[i][3]}
  #define PIN(x) asm volatile("":"+v"(x))
  #define MX3(a,b,c) __builtin_fmaxf(__builtin_fmaxf((a),(b)),(c))
  #define GAPA(MF,A0,A1,A2,A3,W0,W1,PW) do{ MF; sacc+=A0; sacc+=A1; sacc+=A2; sacc+=A3; PIN(sacc); W0; W1; PIN(PW); SBAR(); }while(0)
  #define EX(v) __builtin_amdgcn_exp2f(v)
  #define GAPB(MF,X,B) do{ MF; X[B]=EX(X[B]); X[B+1]=EX(X[B+1]); X[B+2]=EX(X[B+2]); X[B+3]=EX(X[B+3]); PIN(X); SBAR(); }while(0)
  #define VRD(i) do{ vlo[i]=vtr(vp_+(((i)>>2)*4096+((i)&3)*1024)); vhi[i]=vtr(vp_+(((i)>>2)*4096+((i)&3)*1024+512)); }while(0)
  #define KRD(G,j) do{ if(G){ kload2(kf,kp0+sl_next,j); SBAR(); } }while(0)
  #define STEP(C0,C1,P0,P1,t,GK,GV,GL,MKU,MKL) do{ SBAR(); \
    const lds_cptr vp_=vp0+sl_prev; \
    VRD(0); SBAR(); float sacc=(P0[0]+P0[1]); \
    GAPA(C0=MFMA16H(kf[0],qr[0],negm,0,0,0), P0[2],P0[3],P0[4],P0[5],     pw0[0]=PKW(P0,0), pw0[1]=PKW(P0,2), pw0); \
    VRD(4); SBAR(); GAPA(C1=MFMA16H(kf[1],qr[0],negm,0,0,0), P0[6],P0[7],P0[8],P0[9],     pw0[2]=PKW(P0,4), pw0[3]=PKW(P0,6), pw0); \
    VRD(1); SBAR(); GAPA(C0=MFMA16H(kf[2],qr[1],C0,0,0,0),   P0[10],P0[11],P0[12],P0[13], pw1[0]=PKW(P0,8), pw1[1]=PKW(P0,10), pw1); \
    VRD(5); SBAR(); GAPA(C1=MFMA16H(kf[3],qr[1],C1,0,0,0),   P0[14],P0[15],P1[0],P1[1],   pw1[2]=PKW(P0,12),pw1[3]=PKW(P0,14), pw1); \
    VRD(2); SBAR(); GAPA(C0=MFMA16H(kf[4],qr[2],C0,0,0,0),   P1[2],P1[3],P1[4],P1[5],     pw2[0]=PKW(P1,0), pw2[1]=PKW(P1,2), pw2); \
    VRD(6); SBAR(); GAPA(C1=MFMA16H(kf[5],qr[2],C1,0,0,0),   P1[6],P1[7],P1[8],P1[9],     pw2[2]=PKW(P1,4), pw2[3]=PKW(P1,6), pw2); \
    VRD(3); SBAR(); GAPA(C0=MFMA16H(kf[6],qr[3],C0,0,0,0),   P1[10],P1[11],P1[12],P1[13], pw3[0]=PKW(P1,8), pw3[1]=PKW(P1,10), pw3); \
    VRD(7); SBAR(); GAPA(C1=MFMA16H(kf[7],qr[3],C1,0,0,0),   P1[14],P1[15],0.f,0.f,       pw3[2]=PKW(P1,12),pw3[3]=PKW(P1,14), pw3); \
    l_reg+=sacc; MPIN(MKU); SBAR(); \
    if(GK){DMA_K((t)+3,sl_cur);} if(GV){DMA_V((t)+1,sl_next);} \
    MAPPLY(C0,C1,MKU); if(GL){MLOAD(MKL,(t)+1);} \
    SBAR(); \
    GAPB(o[0]=MFMA16H(PAF(0),VFR(0),o[0],0,0,0), C0,0); \
    GAPB(o[1]=MFMA16H(PAF(0),VFR(4),o[1],0,0,0), C0,4); \
    KRD(GL,0); GAPB(o[0]=MFMA16H(PAF(1),VFR(1),o[0],0,0,0), C0,8); \
    KRD(GL,1); GAPB(o[1]=MFMA16H(PAF(1),VFR(5),o[1],0,0,0), C0,12); \
    KRD(GL,2); GAPB(o[0]=MFMA16H(PAF(2),VFR(2),o[0],0,0,0), C1,0); \
    KRD(GL,3); GAPB(o[1]=MFMA16H(PAF(2),VFR(6),o[1],0,0,0), C1,4); \
    GAPB(o[0]=MFMA16H(PAF(3),VFR(3),o[0],0,0,0), C1,8); \
    GAPB(o[1]=MFMA16H(PAF(3),VFR(7),o[1],0,0,0), C1,12); \
    }while(0)
  int t=1;
  for(;t+5<NT;t+=2){
    STEP(pB0,pB1,pA0,pA1,t,true,true,true,mkB,mkA);     WAIT_BAR(2); ROT();
    STEP(pA0,pA1,pB0,pB1,t+1,true,true,true,mkA,mkB);   WAIT_BAR(2); ROT();
  }
  #define ENDW(tt,MK) do{ if((tt)+3<NT){WAIT_BAR(2);} else if((tt)+2<NT){WAIT_BAR(1);} else {WAIT_BAR(0);} }while(0)
  for(;t+1<NT;t+=2){
    STEP(pB0,pB1,pA0,pA1,t,(t+3<NT),(t+1<NT),(t+1<NT),mkB,mkA);       ENDW(t,mkA);   ROT();
    STEP(pA0,pA1,pB0,pB1,t+1,(t+4<NT),(t+2<NT),(t+2<NT),mkA,mkB);     ENDW(t+1,mkB); ROT();
  }
  STEP(pB0,pB1,pA0,pA1,NT-1,false,false,false,mkB,mkA);
  { float sacc=pB0[0]+pB0[1]; _Pragma("unroll") for(int r=2;r<16;++r)sacc+=pB0[r]; _Pragma("unroll") for(int r=0;r<16;++r)sacc+=pB1[r]; l_reg+=sacc;
    pw0=(u32x4){PKW(pB0,0),PKW(pB0,2),PKW(pB0,4),PKW(pB0,6)};pw1=(u32x4){PKW(pB0,8),PKW(pB0,10),PKW(pB0,12),PKW(pB0,14)};pw2=(u32x4){PKW(pB1,0),PKW(pB1,2),PKW(pB1,4),PKW(pB1,6)};pw3=(u32x4){PKW(pB1,8),PKW(pB1,10),PKW(pB1,12),PKW(pB1,14)};
    SBAR(); pv(o,vb0+sl_cur,PAF(0),PAF(1),PAF(2),PAF(3)); }
  #undef PKW
  #undef PAF
  #undef VFR
  #undef PIN
  #undef MX3
  #undef GAPA
  #undef GAPB
  #undef EX
  #undef VRD
  #undef KRD
  #undef STEP
  #undef ENDW
  int le_=lane; asm volatile("":"+v"(le_)); const int r32e=le_&31,hie=le_>>5;
  {auto rr=__builtin_amdgcn_permlane32_swap(__float_as_uint(l_reg),__float_as_uint(l_reg),false,false);l_reg=__uint_as_float(rr[0])+__uint_as_float(rr[1]);}
  if(hie==0)wsf[32+r32e]=l_reg;asm volatile("s_waitcnt lgkmcnt(0)":::"memory");
  float rli[16];
  #pragma unroll
  for(int r=0;r<16;++r)rli[r]=__builtin_amdgcn_rcpf(wsf[32+crow(r,hie)]);
  bf16*Ow=O+(rowbase+q0+wid*QBLK)*OPITCH+OCOL0+h*D;
  { bf16*stg=(bf16*)(shm+LDS_OST)+wid*2048;
    #pragma unroll
    for(int r=0;r<16;++r){const int orow=crow(r,hie);
      #pragma unroll
      for(int d0=0;d0<2;++d0)stg[orow*64+d0*32+r32e]=f2h(o[d0][r]*rli[r]);}
    asm volatile("s_waitcnt lgkmcnt(0)":::"memory");
    #pragma unroll
    for(int i=0;i<4;++i){const int row=i*8+(le_>>3),ch=le_&7; const u32x4 v=*(const u32x4*)(stg+row*64+ch*8); ATTN_STORE16(Ow+(long)row*OPITCH+ch*8,v);} }
  asm volatile("s_waitcnt lgkmcnt(0)\n\ts_barrier":::"memory");
  #undef DMA_K
  #undef DMA_V
  #undef MLOAD
  #undef MAPPLY
  #undef MPIN
  #undef ROT
}
constexpr int ATTN_LDS_BYTES=LDS_BYTES;
struct AttnTensors { const bf16* Q; const bf16* K; const bf16* V; bf16* O; const unsigned long long* MASK; float mref; };
struct AttnUnit { int bh; int qb; };
struct StaticOrder {
  int vcu;
  __device__ __forceinline__ explicit StaticOrder(int grid,int block):vcu((block%8)*(grid/8)+block/8){}
  __device__ __forceinline__ bool next(int i,AttnUnit&u)const{ if(i>=2)return false; const int s=vcu&7; u.bh=vcu>>3; u.qb=(i==0)?s:15-s; return true; }
  __device__ __forceinline__ void a_ready(const AttnUnit&)const{}
  __device__ __forceinline__ void done(const AttnUnit&)const{}
};
template<class Sched> __device__ __forceinline__ void attn_phase(char*lds,const AttnTensors&T,const Sched&S,int wid){
  AttnUnit u;
  for(int i=0;S.next(i,u);++i){ S.a_ready(u); attn_unit(u.bh/NHEAD,u.bh%NHEAD,u.qb,T.Q,T.K,T.V,T.O,T.MASK,T.mref,lds,wid); S.done(u); }
}
#undef SBAR
#undef WAIT_BAR
}
#define GAS __attribute__((address_space(1)))
#define LAS __attribute__((address_space(3)))
typedef unsigned short bf16;
typedef unsigned v4u __attribute__((ext_vector_type(4)));
typedef float f32x4 __attribute__((ext_vector_type(4)));
typedef short bf16x8 __attribute__((ext_vector_type(8)));
typedef GAS unsigned gu32;
typedef GAS unsigned long long gu64;
#define RLX_AGENT __ATOMIC_RELAXED, __HIP_MEMORY_SCOPE_AGENT
#define LDS_WAIT() asm volatile("s_waitcnt lgkmcnt(0)" ::: "memory")
#define VM_WAIT() asm volatile("s_waitcnt vmcnt(0)" ::: "memory")
__device__ __forceinline__ unsigned long long rt() { return __builtin_amdgcn_s_memrealtime(); }
__device__ __forceinline__ unsigned f2bf(float f) { unsigned u = __builtin_bit_cast(unsigned, f); return (u + 0x7fffu + ((u >> 16) & 1u)) >> 16; }
__device__ __forceinline__ unsigned pk2(float lo, float hi) { return f2bf(lo) | (f2bf(hi) << 16); }

#define XB_TMO      128
#define XB_XCNT(j)  (256  + 64 * (j))
#define XB_XSUB(j)  (1280 + 64 * (j))
#define XB_XGEN(j)  (2304 + 64 * (j))
#define XB_TOP      3328
#define XB_TOPGEN   3392
#define XCD_BAR_WORDS 3456
#define XB_SPIN_CAP (1u << 18)

__device__ __forceinline__ unsigned xb_ld(unsigned* p)              { return __hip_atomic_load(p, __ATOMIC_RELAXED, __HIP_MEMORY_SCOPE_AGENT); }
__device__ __forceinline__ unsigned xb_add(unsigned* p, unsigned v) { return __hip_atomic_fetch_add(p, v, __ATOMIC_RELAXED, __HIP_MEMORY_SCOPE_AGENT); }
__device__ __forceinline__ unsigned xb_xcc_id() { return (unsigned)__builtin_amdgcn_s_getreg((3 << 11) | 20) & 0xFu; }
#define XB_SPIN(cond, bar) do { unsigned _sp = 0; while (cond) { __builtin_amdgcn_s_sleep(1); \
    if ((++_sp & 255u) == 0u) { if (xb_ld(&(bar)[XB_TMO])) break; if (_sp > XB_SPIN_CAP) { atomicAdd(&(bar)[XB_TMO], 1u); break; } } } } while (0)

struct XcdBarrier {
    unsigned* bar; unsigned x;
    volatile LAS unsigned* st;
};

__device__ __forceinline__ XcdBarrier xcd_barrier_post(unsigned* bar, volatile LAS unsigned* st, bool t0) {
    XcdBarrier b; b.bar = bar; b.x = xb_xcc_id(); b.st = st;
    if (t0) (void)xb_add(&bar[XB_XCNT(b.x)], 1u);
    return b;
}
__device__ __forceinline__ void xcd_barrier_complete(unsigned* bar, unsigned x, volatile LAS unsigned* st) {
    const unsigned G = gridDim.x * gridDim.y * gridDim.z;
    const int l = fx_lane();
    unsigned c, sum, sp = 0u;
    for (;;) {
        c = (l < 16) ? xb_ld(&bar[XB_XCNT(l & 15)]) : 0u;
        sum = c;
#pragma unroll
        for (int o = 1; o < 16; o <<= 1) sum += (unsigned)__shfl_xor((int)sum, o);
        sum = (unsigned)__builtin_amdgcn_readfirstlane((int)sum);
        if (sum == G) break;
        __builtin_amdgcn_s_sleep(1);
        if ((++sp & 255u) == 0u) { if (xb_ld(&bar[XB_TMO])) break; if (sp > XB_SPIN_CAP) { if (l == 0) atomicAdd(&bar[XB_TMO], 1u); break; } }
    }
    const unsigned msk = (unsigned)(__ballot(c > 0u) & 0xffffull) | (1u << x);
    const unsigned mine = (unsigned)__builtin_amdgcn_readlane((int)c, (int)x);
    if (l == 0) { st[0] = mine > 0u ? mine : 1u; st[1] = msk; }
}

__device__ __forceinline__ void xcd_barrier(const XcdBarrier& b, bool t0, bool w0) {
    asm volatile("s_waitcnt vmcnt(0)" ::: "memory");
    __syncthreads();
    if (w0) {
        unsigned* bar = b.bar;
        __builtin_amdgcn_s_waitcnt(0);
        if (b.st[0] == 0u) { xcd_barrier_complete(bar, b.x, b.st); LDS_WAIT(); }
        const unsigned nloc = b.st[0], xmask = b.st[1];
        const int l = fx_lane();
        unsigned old = 0u;
        if (l == 0) old = xb_add(&bar[XB_XSUB(b.x)], 1u);
        old = (unsigned)__builtin_amdgcn_readfirstlane((int)old);
        const unsigned gen = old / nloc;
        if (old + 1u == (gen + 1u) * nloc) {
            __builtin_amdgcn_fence(__ATOMIC_RELEASE, "agent");
            asm volatile("s_waitcnt vmcnt(0)" ::: "memory");
            if (l == 0) xb_add(&bar[XB_XGEN(b.x)], 1u);
        }
        { unsigned sp = 0u; const bool need = (l < 16) && (((xmask >> (l & 15)) & 1u) != 0u);
          for (;;) {
              const unsigned v = need ? xb_ld(&bar[XB_XGEN(l & 15)]) : 0xffffffffu;
              if (__ballot(need && !(v > gen)) == 0ull) break;
              __builtin_amdgcn_s_sleep(1);
              if ((++sp & 255u) == 0u) { if (xb_ld(&bar[XB_TMO])) break; if (sp > XB_SPIN_CAP) { if (l == 0) atomicAdd(&bar[XB_TMO], 1u); break; } }
          } }
        __builtin_amdgcn_fence(__ATOMIC_ACQUIRE, "agent");
        asm volatile("s_waitcnt vmcnt(0)" ::: "memory");
    }
    __syncthreads();
}
namespace sl {
__device__ __forceinline__ float wsum(float v) {
#pragma unroll
  for (int o = 32; o > 0; o >>= 1) v += __shfl_xor(v, o);
  return v;
}
__device__ __forceinline__ float wmax(float v) {
#pragma unroll
  for (int o = 32; o > 0; o >>= 1) v = fmaxf(v, __shfl_xor(v, o));
  return v;
}
__device__ __forceinline__ void pool_phase(LAS unsigned char* L, int bx, int G, int tid, const hbits* __restrict__ U, const float* __restrict__ pool_w, const float* __restrict__ pool_scale, hbits* __restrict__ Y) {
  const int sb = tid >> 8, t = tid & 255, tx = t & 15, ty = t >> 4;
  LAS float* As = (LAS float*)(L + sb * 16384);
  LAS float* Bs = As + 16 * 65;
  for (int kk_ = 0; kk_ < (256 * 4 * 2 + 2 * G - 1) / (2 * G); ++kk_) {
    const int it = bx * 2 + sb + kk_ * 2 * G; const bool live = it < 256 * 4 * 2;
    const int mb = (it >> 3), g = (it >> 1) & 3, nb = it & 1, m0 = mb * 64, n0 = nb * 64, w = 2 << g;
    float acc[4][4] = {};
    const int ar = t >> 2, ak = (t & 3) * 4, bk = t >> 4, bn = (t & 15) * 4;
    for (int k0 = 0; k0 < 128; k0 += 16) {
      if (live) {
#pragma unroll
        for (int i = 0; i < 4; ++i) { const int m = m0 + ar, c = g * 128 + k0 + ak + i, tt = m & (S - 1); const int cnt = (tt + 1 < w) ? (tt + 1) : w; float s = 0.f;
          for (int j = 0; j < cnt; ++j) s += h2f(U[(size_t)(m - j) * 512 + c]);
          As[(ak + i) * 65 + ar] = s / (float)cnt - h2f(U[(size_t)m * 512 + c]); }
#pragma unroll
        for (int i = 0; i < 4; ++i) Bs[bk * 65 + bn + i] = pool_w[((size_t)g * 128 + k0 + bk) * 128 + n0 + bn + i];
      }
      __syncthreads();
      if (live) {
#pragma unroll
        for (int k = 0; k < 16; ++k) { float a[4], b[4];
#pragma unroll
          for (int i = 0; i < 4; ++i) { a[i] = As[k * 65 + ty * 4 + i]; b[i] = Bs[k * 65 + tx * 4 + i]; }
#pragma unroll
          for (int i = 0; i < 4; ++i)
#pragma unroll
            for (int j = 0; j < 4; ++j) acc[i][j] = fmaf(a[i], b[j], acc[i][j]); }
      }
      __syncthreads();
    }
    if (live) {
#pragma unroll
      for (int i = 0; i < 4; ++i)
#pragma unroll
        for (int j = 0; j < 4; ++j) { const int d = n0 + tx * 4 + j; Y[(size_t)(m0 + ty * 4 + i) * 1024 + g * 128 + d] = f2h(acc[i][j] * pool_scale[g * 128 + d]); }
    }
  }
}
__device__ __forceinline__ void kmem_phase(int gw, int NGW, int lane, const float* __restrict__ KVraw, const float* __restrict__ kgain, hbits* __restrict__ Kmem, hbits* __restrict__ Vmem) {
  const float g0 = kgain[lane], g1 = kgain[lane + 64];
  for (int w = gw; w < MR * 4; w += 2 * NGW) {
    const int w2 = (w + NGW < MR * 4) ? w + NGW : w;
    const int rowa = w >> 2, ha = w & 3, rowb = w2 >> 2, hb = w2 & 3;
    const float* pa = KVraw + (size_t)rowa * 1024 + ha * 128; const float* pb = KVraw + (size_t)rowb * 1024 + hb * 128;
    const float a0 = pa[lane], a1 = pa[lane + 64], a2 = pa[512 + lane], a3 = pa[512 + lane + 64];
    const float b0 = pb[lane], b1 = pb[lane + 64], b2 = pb[512 + lane], b3 = pb[512 + lane + 64];
    const float ra = rsqrtf(wsum(a0 * a0 + a1 * a1) / 128.f + EPS), rb = rsqrtf(wsum(b0 * b0 + b1 * b1) / 128.f + EPS);
    { const int b = rowa >> 8, key = rowa & 255; hbits* ko = Kmem + (((size_t)b * 4 + ha) * 256 + key) * 128; hbits* vo = Vmem + (((size_t)b * 4 + ha) * 256 + key) * 128;
      ko[lane] = f2h(a0 * ra * g0); ko[lane + 64] = f2h(a1 * ra * g1); vo[lane] = f2h(a2); vo[lane + 64] = f2h(a3); }
    { const int b = rowb >> 8, key = rowb & 255; hbits* ko = Kmem + (((size_t)b * 4 + hb) * 256 + key) * 128; hbits* vo = Vmem + (((size_t)b * 4 + hb) * 256 + key) * 128;
      ko[lane] = f2h(b0 * rb * g0); ko[lane + 64] = f2h(b1 * rb * g1); vo[lane] = f2h(b2); vo[lane + 64] = f2h(b3); }
  }
}
__device__ __forceinline__ void indexer_phase(LAS unsigned char* L, int bx, int G, int tid, const hbits* __restrict__ QI, const hbits* __restrict__ KI, const float* __restrict__ WI, unsigned char* ws) {
  const int sb = tid >> 8, t = tid & 255, tx = t & 15, ty = t >> 4;
  LAS float* Qs = (LAS float*)(L + sb * 40960);
  LAS float* Ks = Qs + 64 * 65;
  constexpr int NT = 4 * 2080;
  for (int kk_ = 0; kk_ < (NT + 2 * G - 1) / (2 * G); ++kk_) {
    const int it = bx * 2 + sb + kk_ * 2 * G; const bool live = it < NT;
    int b = 0, qc = 0, kc = 0;
    if (live) { b = it / 2080; int r = it % 2080; qc = (int)((sqrtf(8.f * (float)r + 1.f) - 1.f) * 0.5f); while ((qc + 1) * (qc + 2) / 2 <= r) ++qc; while (qc * (qc + 1) / 2 > r) --qc; kc = r - qc * (qc + 1) / 2; }
    const size_t qrow0 = (size_t)b * S + qc * 64, krow0 = (size_t)b * S + kc * 64;
    __syncthreads();
    if (live) for (int i = t; i < 64 * 64; i += 256) { const int r = i >> 6, d = i & 63; Ks[r * 65 + d] = h2f(KI[(krow0 + r) * 64 + d]); }
    float acc[4][4] = {};
    for (int h = 0; h < 8; ++h) {
      __syncthreads();
      if (live) for (int i = t; i < 64 * 64; i += 256) { const int r = i >> 6, d = i & 63; Qs[r * 65 + d] = h2f(QI[(qrow0 + r) * 512 + h * 64 + d]); }
      __syncthreads();
      if (live) {
        float s[4][4] = {};
        for (int d = 0; d < 64; ++d) { float a[4], k[4];
#pragma unroll
          for (int i = 0; i < 4; ++i) { a[i] = Qs[(ty * 4 + i) * 65 + d]; k[i] = Ks[(tx * 4 + i) * 65 + d]; }
#pragma unroll
          for (int i = 0; i < 4; ++i)
#pragma unroll
            for (int j = 0; j < 4; ++j) s[i][j] = fmaf(a[i], k[j], s[i][j]); }
#pragma unroll
        for (int i = 0; i < 4; ++i) { const float w = WI[(qrow0 + ty * 4 + i) * 8 + h];
#pragma unroll
          for (int j = 0; j < 4; ++j) acc[i][j] += fmaxf(s[i][j], 0.f) * w; }
      }
    }
    if (live) {
      hbits* SC = (hbits*)sc_batch_ptr((unsigned char*)ws, (unsigned char*)ws, b) + (size_t)4096 * qc * (qc + 1) / 2;
#pragma unroll
      for (int i = 0; i < 4; ++i)
#pragma unroll
        for (int j = 0; j < 4; ++j) SC[(size_t)(ty * 4 + i) * 64 * (qc + 1) + kc * 64 + tx * 4 + j] = f2h(acc[i][j]);
    }
  }
}
__device__ __forceinline__ unsigned comp_key(hbits hb, int s) {
  unsigned u = hb; u = (u & 0x8000u) ? (~u & 0xffffu) : (u | 0x8000u);
  return (u << 12) | (unsigned)(4095 - s);
}
__device__ __forceinline__ void select_phase(int gw, int NGW, int lane, const unsigned char* __restrict__ ws, unsigned long long* __restrict__ MASK) {
  for (int rw = gw; rw < M; rw += NGW) {
    const int b = rw >> 12, t = rw & 4095, c = t >> 6, N = 64 * (c + 1), nj = c + 1;
    unsigned long long* mrow = MASK + (size_t)rw * 64;
    const hbits* row = (const hbits*)sc_batch_ptr((unsigned char*)ws, (unsigned char*)ws, b) + (size_t)4096 * c * (c + 1) / 2 + (size_t)(t & 63) * N;
    if (N <= 256) { mrow[lane] = (lane < nj) ? ~0ull : 0ull; continue; }
    unsigned T = 0;
    for (int bit = 27; bit >= 0; --bit) { const unsigned cand = T | (1u << bit); int cnt = 0;
      for (int j = 0; j < nj; ++j) { const unsigned k = comp_key(row[j * 64 + lane], j * 64 + lane); cnt += __popcll(__ballot(k >= cand)); }
      if (cnt >= 256) T = cand; }
    for (int j = 0; j < 64; ++j) { unsigned long long mk = 0;
      if (j < nj) { const unsigned k = comp_key(row[j * 64 + lane], j * 64 + lane); mk = __ballot(k >= T); }
      if (lane == 0) mrow[j] = mk; }
  }
}
__device__ __forceinline__ void dsa_phase(LAS unsigned char* L, int bx, int G, int tid, const hbits* __restrict__ Q, const hbits* __restrict__ K, const hbits* __restrict__ V,
                                          const unsigned long long* __restrict__ MASK, hbits* __restrict__ Y) {
  const int sb = tid >> 8, t = tid & 255, lane = t & 63, wid = t >> 6;
  LAS float* qs = (LAS float*)(L + sb * 16384);
  LAS int* list = (LAS int*)(qs + 512);
  LAS int* cnts = list + 256;
  LAS int* ntot = cnts + 64;
  LAS float* sc = (LAS float*)(ntot + 16);
  for (int kk_ = 0; kk_ < (M + 2 * G - 1) / (2 * G); ++kk_) { const int m = bx * 2 + sb + kk_ * 2 * G; if (m >= M) break;
    const int b = m / S;
    __syncthreads();
    qs[t] = h2f(Q[(size_t)m * 512 + t]); qs[t + 256] = h2f(Q[(size_t)m * 512 + t + 256]);
    unsigned long long word = 0;
    if (t < 64) { word = MASK[(size_t)m * 64 + t]; cnts[t] = __popcll(word); }
    __syncthreads();
    if (t < 64) { int off = 0; for (int j = 0; j < t; ++j) off += cnts[j];
      if (t == 63) ntot[0] = off + cnts[63];
      while (word) { const int bpos = __ffsll((long long)word) - 1; word &= word - 1; if (off < 256) list[off] = t * 64 + bpos; ++off; } }
    __syncthreads();
    const int n = ntot[0] < 256 ? ntot[0] : 256;
    if (t < n) { const hbits* kr = K + ((size_t)b * S + list[t]) * 512;
      for (int h = 0; h < 8; ++h) { float s = 0.f; for (int d = 0; d < 64; ++d) s = fmaf(qs[h * 64 + d], h2f(kr[h * 64 + d]), s); sc[h * 256 + t] = s; } }
    __syncthreads();
    for (int h = wid * 2; h < wid * 2 + 2; ++h) { float mx = -INFINITY;
      for (int k = lane; k < n; k += 64) mx = fmaxf(mx, sc[h * 256 + k]);
      mx = wmax(mx); float sm = 0.f;
      for (int k = lane; k < n; k += 64) { const float e = exp2f(sc[h * 256 + k] - mx); sc[h * 256 + k] = e; sm += e; }
      sm = wsum(sm); const float inv = 1.f / sm;
      for (int k = lane; k < n; k += 64) sc[h * 256 + k] *= inv; }
    __syncthreads();
    for (int col = t; col < 512; col += 256) { const int h = col >> 6; float acc = 0.f;
      for (int k = 0; k < n; ++k) acc = fmaf(sc[h * 256 + k], h2f(V[((size_t)b * S + list[k]) * 512 + col]), acc);
      Y[(size_t)m * 1024 + 512 + col] = f2h(acc); }
  }
}
__device__ __forceinline__ void xattn_phase(LAS unsigned char* L, int bx, int G, int tid, const hbits* __restrict__ Qm, const float* __restrict__ qgain, const hbits* __restrict__ Kmem, const hbits* __restrict__ Vmem, hbits* __restrict__ O) {
  const int sb = tid >> 8, t = tid & 255, lane = t & 63, wid = t >> 6;
  LAS float* qs = (LAS float*)(L + sb * 8192);
  LAS float* sc = qs + 512;
  for (int kk_ = 0; kk_ < (M + 2 * G - 1) / (2 * G); ++kk_) { const int m = bx * 2 + sb + kk_ * 2 * G; if (m >= M) break;
    const int b = m / S;
    __syncthreads();
    { const float v0 = h2f(Qm[(size_t)m * 512 + wid * 128 + lane]), v1 = h2f(Qm[(size_t)m * 512 + wid * 128 + 64 + lane]);
      const float r = rsqrtf(wsum(v0 * v0 + v1 * v1) / 128.f + EPS);
      qs[wid * 128 + lane] = v0 * r * qgain[lane]; qs[wid * 128 + 64 + lane] = v1 * r * qgain[lane + 64]; }
    __syncthreads();
    for (int h = 0; h < 4; ++h) { const hbits* kr = Kmem + (((size_t)b * 4 + h) * 256 + t) * 128; float s = 0.f;
      for (int d = 0; d < 128; ++d) s = fmaf(qs[h * 128 + d], h2f(kr[d]), s);
      sc[h * 256 + t] = s * 0.08838834764831845f; }
    __syncthreads();
    { const int h = wid; float mx = -INFINITY;
      for (int k = lane; k < 256; k += 64) mx = fmaxf(mx, sc[h * 256 + k]);
      mx = wmax(mx); float sm = 0.f;
      for (int k = lane; k < 256; k += 64) { const float e = expf(sc[h * 256 + k] - mx); sc[h * 256 + k] = e; sm += e; }
      sm = wsum(sm); const float inv = 1.f / sm;
      for (int k = lane; k < 256; k += 64) sc[h * 256 + k] *= inv; }
    __syncthreads();
    for (int col = t; col < 512; col += 256) { const int h = col >> 7, d = col & 127; float acc = 0.f;
      for (int k = 0; k < 256; ++k) acc = fmaf(sc[h * 256 + k], h2f(Vmem[(((size_t)b * 4 + h) * 256 + k) * 128 + d]), acc);
      O[(size_t)m * 512 + col] = f2h(acc); }
  }
}
}
namespace fx {
typedef float f32x16 __attribute__((ext_vector_type(16)));
typedef short s16x8 __attribute__((ext_vector_type(8)));
typedef unsigned u32x4v __attribute__((ext_vector_type(4)));
typedef unsigned u32x2v __attribute__((ext_vector_type(2)));
#define FX_MFMA(a, b, c) __builtin_amdgcn_mfma_f32_32x32x16_f16(__builtin_bit_cast(h8v, (a)), __builtin_bit_cast(h8v, (b)), (c), 0, 0, 0)
constexpr int IDX_Q_LDS = 65536, IDX_STG = 4608;
__device__ __forceinline__ void indexer_item(int b, int c, int t_lo, int t_hi, int tid, int lane, int wave, const hbits* __restrict__ Qi, const hbits* __restrict__ Ki, const float* __restrict__ WI,
                                             unsigned char* ws, unsigned char* outb, LAS unsigned char* L) {
    asm volatile("" : "+v"(tid), "+v"(lane));
    const int r32 = lane & 31, hi = lane >> 5, grp = wave >> 2, wq = wave & 3;
    __syncthreads();
#pragma unroll
    for (int i = 0; i < 8; ++i) { const int pc = i * 512 + tid, q64 = pc >> 6, within = pc & 63, h = within >> 3, d0 = (within >> 1) & 3, h8 = within & 1;
        const u32x4v v = *(const u32x4v*)(Qi + ((size_t)b * S + 64 * c + q64) * 512 + within * 8);
        *(LAS u32x4v*)(L + (q64 >> 5) * 32768 + ((h * 4 + d0) * 2 + h8) * 512 + (q64 & 31) * 16) = v; }
    const size_t qrow = (size_t)b * S + 64 * c + 32 * grp + r32;
    float w[8];
    { const f32x4 wa = *(const f32x4*)(WI + qrow * 8), wb = *(const f32x4*)(WI + qrow * 8 + 4);
      w[0] = wa[0]; w[1] = wa[1]; w[2] = wa[2]; w[3] = wa[3]; w[4] = wb[0]; w[5] = wb[1]; w[6] = wb[2]; w[7] = wb[3]; }
    __syncthreads();
    const LAS unsigned char* qb = L + grp * 32768 + hi * 512 + r32 * 16;
    LAS unsigned char* stg = L + IDX_Q_LDS + wave * IDX_STG;
    hbits* scg = (hbits*)sc_batch_ptr(ws, outb, b) + (size_t)4096 * c * (c + 1) / 2 + (size_t)(32 * grp) * 64 * (c + 1);
#pragma unroll 1
    for (int kt = t_lo + wq; kt < t_hi; kt += 4) {
        const hbits* kbase = Ki + ((size_t)b * S + 64 * kt + r32) * 64 + hi * 8;
        s16x8 k0[4], k1[4];
#pragma unroll
        for (int d0 = 0; d0 < 4; ++d0) { k0[d0] = *(const s16x8*)(kbase + d0 * 16); k1[d0] = *(const s16x8*)(kbase + 32 * 64 + d0 * 16); }
#pragma unroll
        for (int half = 0; half < 2; ++half) {
            f32x16 sc = f32x16{}, aA = f32x16{}, aB = f32x16{};
#pragma unroll
            for (int d0 = 0; d0 < 4; ++d0) { const s16x8 qv = *(const LAS s16x8*)(qb + d0 * 1024); aA = FX_MFMA(half ? k1[d0] : k0[d0], qv, aA); }
#pragma unroll
            for (int h = 0; h < 8; ++h) {
                if (h < 7) {
                    if (h & 1) { aA = f32x16{};
#pragma unroll
                        for (int d0 = 0; d0 < 4; ++d0) { const s16x8 qv = *(const LAS s16x8*)(qb + ((h + 1) * 4 + d0) * 1024); aA = FX_MFMA(half ? k1[d0] : k0[d0], qv, aA); } }
                    else { aB = f32x16{};
#pragma unroll
                        for (int d0 = 0; d0 < 4; ++d0) { const s16x8 qv = *(const LAS s16x8*)(qb + ((h + 1) * 4 + d0) * 1024); aB = FX_MFMA(half ? k1[d0] : k0[d0], qv, aB); } }
                }
                if (h & 1) {
#pragma unroll
                    for (int rr = 0; rr < 16; ++rr) sc[rr] = fmaf(__builtin_amdgcn_fmed3f(aB[rr], 0.f, 3.0e38f), w[h], sc[rr]);
                } else {
#pragma unroll
                    for (int rr = 0; rr < 16; ++rr) sc[rr] = fmaf(__builtin_amdgcn_fmed3f(aA[rr], 0.f, 3.0e38f), w[h], sc[rr]);
                }
                asm volatile("" : "+v"(sc));
                __builtin_amdgcn_sched_barrier(0);
            }
#pragma unroll
            for (int g4 = 0; g4 < 4; ++g4) { u32x2v o; o.x = pkh(sc[4 * g4], sc[4 * g4 + 1]); o.y = pkh(sc[4 * g4 + 2], sc[4 * g4 + 3]);
                *(LAS u32x2v*)(stg + r32 * 144 + (32 * half + 8 * g4 + 4 * hi) * 2) = o; }
        }
        LDS_WAIT(); asm volatile("" ::: "memory");
        int l2 = lane; asm volatile("" : "+v"(l2));
#pragma unroll
        for (int i = 0; i < 4; ++i) { const int row = i * 8 + (l2 >> 3), ch = l2 & 7;
            const u32x4v v = *(const LAS u32x4v*)(stg + row * 144 + ch * 16);
            __builtin_nontemporal_store(v, (u32x4v*)(scg + (size_t)row * 64 * (c + 1) + 64 * kt + ch * 8)); }
        LDS_WAIT(); asm volatile("" ::: "memory");
    }
}
__device__ __forceinline__ void indexer_phase(int bx, int G, int tid, int lane, int wave, const hbits* __restrict__ Qi, const hbits* __restrict__ Ki, const float* __restrict__ WI, unsigned char* ws, unsigned char* outb, LAS unsigned char* L) {
    for (int it = bx; it < 256; it += G) {
        const int b = it >> 6, j = it & 63;
#pragma unroll 1
        for (int part = 0; part < 2; ++part) {
            const int c = part ? 63 - j : j, t_lo = part ? (65 - j) >> 1 : 0, t_hi = part ? 64 - j : (j + 2) >> 1;
            indexer_item(b, c, t_lo, t_hi, tid, lane, wave, Qi, Ki, WI, ws, outb, L);
        }
    }
}

typedef short s16x2 __attribute__((ext_vector_type(2)));
typedef unsigned short u16x2 __attribute__((ext_vector_type(2)));
__device__ __forceinline__ int wave_isum(int v) {
    v += __builtin_amdgcn_update_dpp(0, v, 0xB1, 0xf, 0xf, false);
    v += __builtin_amdgcn_update_dpp(0, v, 0x4E, 0xf, 0xf, false);
    v += __builtin_amdgcn_update_dpp(0, v, 0x141, 0xf, 0xf, false);
    v += __builtin_amdgcn_update_dpp(0, v, 0x140, 0xf, 0xf, false);
    v += __builtin_amdgcn_update_dpp(0, v, 0x142, 0xa, 0xf, false);
    v += __builtin_amdgcn_update_dpp(0, v, 0x143, 0xc, 0xf, false);
    return __builtin_amdgcn_readlane(v, 63);
}
__device__ __forceinline__ unsigned cnt_lt(const unsigned (&kv)[8][4], int nj8, int T) {
    const s16x2 tp = {(short)T, (short)T}; u16x2 c = {0, 0};
#pragma unroll
    for (int j = 0; j < 8; ++j) if (j < nj8) {
#pragma unroll
        for (int v = 0; v < 4; ++v) { const unsigned kk = kv[j][v]; const s16x2 d = __builtin_elementwise_sub_sat(__builtin_bit_cast(s16x2, kk), tp);
            c += __builtin_bit_cast(u16x2, d) >> (unsigned short)15; } }
    const unsigned cc = __builtin_bit_cast(unsigned, c);
    return ((cc & 0xffffu) + (cc >> 16)) << 15;
}
__device__ __forceinline__ int wave_iscan(int x) {
    x += __builtin_amdgcn_update_dpp(0, x, 0x111, 0xf, 0xf, false);
    x += __builtin_amdgcn_update_dpp(0, x, 0x112, 0xf, 0xf, false);
    x += __builtin_amdgcn_update_dpp(0, x, 0x114, 0xf, 0xf, false);
    x += __builtin_amdgcn_update_dpp(0, x, 0x118, 0xf, 0xf, false);
    x += __builtin_amdgcn_update_dpp(0, x, 0x142, 0xa, 0xf, false);
    x += __builtin_amdgcn_update_dpp(0, x, 0x143, 0xc, 0xf, false);
    return x;
}
__device__ __forceinline__ void find_bucket(const LAS unsigned* H, int lane, int tgt, int& B, int& above, int& cnt) {
    const int base = 252 - 4 * lane;
    const u32x4v c = *(const LAS u32x4v*)(H + base);
    const int c0 = (int)c.x, c1 = (int)c.y, c2 = (int)c.z, c3 = (int)c.w, s4 = (c0 + c1) + (c2 + c3);
    const int P = wave_iscan(s4), A = P - s4;
    const bool hit = (A < tgt) && (tgt <= P);
    int b = base, ab = A + c3 + c2 + c1, ct = c0;
    if (A + c3 >= tgt) { b = base + 3; ab = A; ct = c3; }
    else if (A + c3 + c2 >= tgt) { b = base + 2; ab = A + c3; ct = c2; }
    else if (A + c3 + c2 + c1 >= tgt) { b = base + 1; ab = A + c3 + c2; ct = c1; }
    const unsigned long long hm = __ballot(hit);
    const int sl = hm ? (__ffsll((long long)hm) - 1) : 0;
    B = __builtin_amdgcn_readlane(b, sl); above = __builtin_amdgcn_readlane(ab, sl); cnt = __builtin_amdgcn_readlane(ct, sl);
}
__device__ __forceinline__ void find_bucket4(const LAS unsigned* H, int lane, int tgt, int& B, int& above, int& cnt) {
    const int base = 252 - 4 * lane;
    const u32x4v q0 = *(const LAS u32x4v*)(H + 4 * base), q1 = *(const LAS u32x4v*)(H + 4 * base + 4), q2 = *(const LAS u32x4v*)(H + 4 * base + 8), q3 = *(const LAS u32x4v*)(H + 4 * base + 12);
    const int c0 = (int)((q0.x + q0.y) + (q0.z + q0.w)), c1 = (int)((q1.x + q1.y) + (q1.z + q1.w)), c2 = (int)((q2.x + q2.y) + (q2.z + q2.w)), c3 = (int)((q3.x + q3.y) + (q3.z + q3.w)), s4 = (c0 + c1) + (c2 + c3);
    const int P = wave_iscan(s4), A = P - s4;
    const bool hit = (A < tgt) && (tgt <= P);
    int b = base, ab = A + c3 + c2 + c1, ct = c0;
    if (A + c3 >= tgt) { b = base + 3; ab = A; ct = c3; }
    else if (A + c3 + c2 >= tgt) { b = base + 2; ab = A + c3; ct = c2; }
    else if (A + c3 + c2 + c1 >= tgt) { b = base + 1; ab = A + c3 + c2; ct = c1; }
    const unsigned long long hm = __ballot(hit);
    const int sl = hm ? (__ffsll((long long)hm) - 1) : 0;
    B = __builtin_amdgcn_readlane(b, sl); above = __builtin_amdgcn_readlane(ab, sl); cnt = __builtin_amdgcn_readlane(ct, sl);
}
__device__ __forceinline__ void select_load(int b, int t, int lane, const unsigned char* __restrict__ ws, const unsigned char* __restrict__ outb, u32x4v (&raw)[8]) {
    const int c = t >> 6, N = 64 * (c + 1);
    const hbits* row = (const hbits*)sc_batch_ptr((unsigned char*)ws, (unsigned char*)outb, b) + (size_t)4096 * c * (c + 1) / 2 + (size_t)(t & 63) * N;
#pragma unroll
    for (int j = 0; j < 8; ++j) { const int off = j * 512 + lane * 8; raw[j] = __builtin_nontemporal_load((const u32x4v*)(row + (off < N ? off : 0))); }
}
__device__ __forceinline__ void select_rows2(int b0, int t, int lane, u32x4v (&raw)[2][8], unsigned char* __restrict__ MASKB, LAS unsigned* H) {
    const int c = t >> 6, N = 64 * (c + 1), nj8 = (N + 511) >> 9;
    unsigned char* mrow[2] = {MASKB + ((size_t)b0 * S + t) * 512, MASKB + ((size_t)(b0 + 1) * S + t) * 512};
    if (N <= 256) { const unsigned char v = (8 * lane < N) ? 0xff : 0x00; mrow[0][lane] = v; mrow[1][lane] = v; return; }
#define kv_(r, j, v) raw[r][j][v]
#pragma unroll
    for (int j = 0; j < 8; ++j) {
        const bool ok = (j * 512 + lane * 8 < N);
#pragma unroll
        for (int r = 0; r < 2; ++r) {
            const unsigned ux = raw[r][j].x, uy = raw[r][j].y, uz = raw[r][j].z, uw = raw[r][j].w;
            const s16x2 sx = __builtin_bit_cast(s16x2, ux), sy = __builtin_bit_cast(s16x2, uy), sz = __builtin_bit_cast(s16x2, uz), sw = __builtin_bit_cast(s16x2, uw);
            const s16x2 kx = sx ^ ((sx >> (short)15) & (short)0x7fff), ky = sy ^ ((sy >> (short)15) & (short)0x7fff), kz = sz ^ ((sz >> (short)15) & (short)0x7fff), kw = sw ^ ((sw >> (short)15) & (short)0x7fff);
            u32x4v kq; kq.x = ok ? __builtin_bit_cast(unsigned, kx) : 0x80008000u; kq.y = ok ? __builtin_bit_cast(unsigned, ky) : 0x80008000u;
            kq.z = ok ? __builtin_bit_cast(unsigned, kz) : 0x80008000u; kq.w = ok ? __builtin_bit_cast(unsigned, kw) : 0x80008000u; raw[r][j] = kq;
        }
    }
    { const u32x4v z = {0u, 0u, 0u, 0u};
#pragma unroll
      for (int q = 0; q < 10; ++q) *(LAS u32x4v*)(H + 256 * q + 4 * lane) = z; }
    LDS_WAIT(); asm volatile("" ::: "memory");
#pragma unroll
    for (int j = 0; j < 8; ++j) if (j < nj8) {
#pragma unroll
        for (int v = 0; v < 4; ++v)
#pragma unroll
            for (int r = 0; r < 2; ++r) { const unsigned ku = kv_(r, j, v) ^ 0x80008000u; LAS unsigned* H1 = H + 1280 * r + (lane & 3);
                __hip_atomic_fetch_add(H1 + ((ku >> 6) & 0x3fcu), 1u, __ATOMIC_RELAXED, __HIP_MEMORY_SCOPE_WORKGROUP);
                __hip_atomic_fetch_add(H1 + ((ku >> 22) & 0x3fcu), 1u, __ATOMIC_RELAXED, __HIP_MEMORY_SCOPE_WORKGROUP); } }
    LDS_WAIT(); asm volatile("" ::: "memory");
    int B1[2], above1[2], cnt1[2];
#pragma unroll
    for (int r = 0; r < 2; ++r) find_bucket4(H + 1280 * r, lane, 256, B1[r], above1[r], cnt1[r]);
#pragma unroll
    for (int j = 0; j < 8; ++j) if (j < nj8) {
#pragma unroll
        for (int v = 0; v < 4; ++v)
#pragma unroll
            for (int r = 0; r < 2; ++r) { const unsigned ku = kv_(r, j, v) ^ 0x80008000u; LAS unsigned* H2 = H + 1280 * r + 1024;
                if (((ku >> 8) & 0xffu) == (unsigned)B1[r]) __hip_atomic_fetch_add(H2 + (ku & 0xffu), 1u, __ATOMIC_RELAXED, __HIP_MEMORY_SCOPE_WORKGROUP);
                if ((ku >> 24) == (unsigned)B1[r]) __hip_atomic_fetch_add(H2 + ((ku >> 16) & 0xffu), 1u, __ATOMIC_RELAXED, __HIP_MEMORY_SCOPE_WORKGROUP); } }
    LDS_WAIT(); asm volatile("" ::: "memory");
    int T[2], cgt[2], cge[2], need[2];
#pragma unroll
    for (int r = 0; r < 2; ++r) { int B2, above2, cnt2; find_bucket(H + 1280 * r + 1024, lane, 256 - above1[r], B2, above2, cnt2);
        T[r] = ((B1[r] << 8) | B2) - 32768;
        cgt[r] = above1[r] + above2; cge[r] = cgt[r] + cnt2; need[r] = 256 - cgt[r]; }
    if (cge[0] - cgt[0] == need[0] && cge[1] - cgt[1] == need[1]) {
#pragma unroll
        for (int j = 0; j < 8; ++j) if (j < nj8) {
#pragma unroll
            for (int r = 0; r < 2; ++r) { const s16x2 tp = {(short)T[r], (short)T[r]}; unsigned sel8 = 0u;
#pragma unroll
                for (int v = 0; v < 4; ++v) { const unsigned kk = kv_(r, j, v); const unsigned dl = ~__builtin_bit_cast(unsigned, __builtin_elementwise_sub_sat(__builtin_bit_cast(s16x2, kk), tp));
                    sel8 |= (((dl >> 15) & 1u) | ((dl >> 30) & 2u)) << (2 * v); }
                mrow[r][j * 64 + lane] = (unsigned char)sel8; } }
        return;
    }
#pragma unroll 1
    for (int r = 0; r < 2; ++r) {
        const s16x2 tp = {(short)T[r], (short)T[r]};
        int base = 0;
#pragma unroll
        for (int j = 0; j < 8; ++j) if (j < nj8) {
            unsigned gtb = 0u, eqb = 0u;
#pragma unroll
            for (int v = 0; v < 4; ++v) { const unsigned kk = (r ? kv_(1, j, v) : kv_(0, j, v)); const s16x2 ks = __builtin_bit_cast(s16x2, kk);
                const unsigned dg = __builtin_bit_cast(unsigned, __builtin_elementwise_sub_sat(tp, ks));
                const unsigned dl = __builtin_bit_cast(unsigned, __builtin_elementwise_sub_sat(ks, tp));
                const unsigned g2 = ((dg >> 15) & 1u) | ((dg >> 30) & 2u), l2 = ((dl >> 15) & 1u) | ((dl >> 30) & 2u);
                gtb |= g2 << (2 * v); eqb |= ((~(g2 | l2)) & 3u) << (2 * v); }
            const int ce = __popc(eqb);
            const int inc = wave_iscan(ce);
            const int tot = __builtin_amdgcn_readlane(inc, 63);
            int allow = (r ? need[1] : need[0]) - base - (inc - ce); allow = allow < 0 ? 0 : allow;
            unsigned sel = 0u;
            if (allow >= ce) sel = eqb;
            else {
#pragma unroll
                for (int e = 0; e < 8; ++e) { if ((eqb >> e) & 1u) { if (allow > 0) { sel |= 1u << e; --allow; } } }
            }
            (r ? mrow[1] : mrow[0])[j * 64 + lane] = (unsigned char)(gtb | sel);
            base += tot;
        }
    }
}
#undef kv_
__device__ __forceinline__ void select_load2(int b0, int t, int lane, const unsigned char* __restrict__ ws, const unsigned char* __restrict__ outb, u32x4v (&raw)[2][8]) {
    select_load(b0, t, lane, ws, outb, raw[0]); select_load(b0 + 1, t, lane, ws, outb, raw[1]);
}
__device__ __forceinline__ void select_phase(int gw, int NGW, int lane, const unsigned char* __restrict__ ws, const unsigned char* __restrict__ outb, unsigned char* __restrict__ MASKB, LAS unsigned* H) {
    for (int i = gw; i < 2048; i += NGW) {
#pragma unroll 1
        for (int q = 0; q < 4; ++q) { const int bp = (q >> 1) * 2, t = (q & 1) ? 4095 - i : i;
            u32x4v raw[2][8];
            select_load2(bp, t, lane, ws, outb, raw);
            select_rows2(bp, t, lane, raw, MASKB, H);
        }
    }
}

typedef short s16x4v __attribute__((ext_vector_type(4)));
typedef short v4i16_t __attribute__((ext_vector_type(4)));
__device__ __forceinline__ s16x4v xvtr(const LAS unsigned char* p) { return __builtin_bit_cast(s16x4v, __builtin_amdgcn_ds_read_tr16_b64_v4i16((LAS v4i16_t*)p)); }
__device__ __forceinline__ void xattn_unit(int b, int h, int qb, int tid, int lane, int wave, const hbits* __restrict__ Qm, const float* __restrict__ qgain, const hbits* __restrict__ Kmem, const hbits* __restrict__ Vmem,
                                           hbits* __restrict__ O, float mref, LAS unsigned char* L) {
    asm volatile("" : "+v"(tid), "+v"(lane));
    const int r32 = lane & 31, hi = lane >> 5;
    LAS unsigned char* LK = L; LAS unsigned char* LV = L + 65536;
    __syncthreads();
    { const hbits* kg = Kmem + ((size_t)b * 4 + h) * 256 * 128; const hbits* vg = Vmem + ((size_t)b * 4 + h) * 256 * 128;
#pragma unroll
      for (int i = 0; i < 8; ++i) { const int pc = i * 512 + tid, key = pc >> 4, dc = pc & 15;
          const u32x4v kvv = *(const u32x4v*)(kg + (size_t)key * 128 + dc * 8); *(LAS u32x4v*)(LK + dc * 4096 + key * 16) = kvv;
          const u32x4v vvv = *(const u32x4v*)(vg + (size_t)key * 128 + dc * 8); *(LAS u32x4v*)(LV + (dc >> 2) * 16384 + key * 64 + (dc & 3) * 16) = vvv; } }
    const size_t qrow = (size_t)b * S + 256 * qb + 32 * wave + r32;
    s16x8 qf[8];
    { float qv[8][8]; float ss = 0.f;
#pragma unroll
      for (int d0 = 0; d0 < 8; ++d0) { const u32x4v u = *(const u32x4v*)(Qm + qrow * 512 + h * 128 + d0 * 16 + hi * 8);
          const unsigned ux = u.x, uy = u.y, uz = u.z, uw = u.w;
          const h2v a0 = __builtin_bit_cast(h2v, ux), a1 = __builtin_bit_cast(h2v, uy), a2 = __builtin_bit_cast(h2v, uz), a3 = __builtin_bit_cast(h2v, uw);
          qv[d0][0] = (float)a0[0]; qv[d0][1] = (float)a0[1]; qv[d0][2] = (float)a1[0]; qv[d0][3] = (float)a1[1]; qv[d0][4] = (float)a2[0]; qv[d0][5] = (float)a2[1]; qv[d0][6] = (float)a3[0]; qv[d0][7] = (float)a3[1];
#pragma unroll
          for (int j = 0; j < 8; ++j) ss += qv[d0][j] * qv[d0][j]; }
      ss += __shfl_xor(ss, 32);
      const float r = rsqrtf(ss * (1.0f / 128.0f) + EPS) * (0.08838834764831845f * 1.4426950408889634f);
#pragma unroll
      for (int d0 = 0; d0 < 8; ++d0) { const f32x4 g0 = *(const f32x4*)(qgain + d0 * 16 + hi * 8), g1 = *(const f32x4*)(qgain + d0 * 16 + hi * 8 + 4);
          u32x4v o; o.x = pkh(qv[d0][0] * r * g0[0], qv[d0][1] * r * g0[1]); o.y = pkh(qv[d0][2] * r * g0[2], qv[d0][3] * r * g0[3]);
          o.z = pkh(qv[d0][4] * r * g1[0], qv[d0][5] * r * g1[1]); o.w = pkh(qv[d0][6] * r * g1[2], qv[d0][7] * r * g1[3]);
          qf[d0] = __builtin_bit_cast(s16x8, o); } }
    f32x16 o4[4]; o4[0] = f32x16{}; o4[1] = f32x16{}; o4[2] = f32x16{}; o4[3] = f32x16{};
    float l_reg = 0.f;
    __syncthreads();
    const LAS unsigned char* kp = LK + hi * 4096 + r32 * 16;
    const LAS unsigned char* vp = LV + ((lane >> 4) & 1) * 32 + (lane & 3) * 8 + (4 * hi + ((lane & 15) >> 2)) * 64;
#pragma unroll 1
    for (int half = 0; half < 2; ++half) {
        f32x16 sv[4];
#pragma unroll
        for (int kb = 0; kb < 4; ++kb) {
            f32x16 a = f32x16{};
#pragma unroll
            for (int d0 = 0; d0 < 8; ++d0) { const s16x8 kfr = *(const LAS s16x8*)(kp + d0 * 8192 + (half * 4 + kb) * 512); a = FX_MFMA(kfr, qf[d0], a); }
            sv[kb] = a;
        }
        u32x4v pw[4][2];
#pragma unroll
        for (int kb = 0; kb < 4; ++kb) { float sacc = 0.f; f32x16 pv_ = sv[kb];
#pragma unroll
            for (int rr = 0; rr < 16; ++rr) { pv_[rr] = __builtin_amdgcn_exp2f(pv_[rr] - mref); sacc += pv_[rr]; }
            l_reg += sacc;
            pw[kb][0].x = pkh(pv_[0], pv_[1]); pw[kb][0].y = pkh(pv_[2], pv_[3]); pw[kb][0].z = pkh(pv_[4], pv_[5]); pw[kb][0].w = pkh(pv_[6], pv_[7]);
            pw[kb][1].x = pkh(pv_[8], pv_[9]); pw[kb][1].y = pkh(pv_[10], pv_[11]); pw[kb][1].z = pkh(pv_[12], pv_[13]); pw[kb][1].w = pkh(pv_[14], pv_[15]); }
#pragma unroll
        for (int db = 0; db < 4; ++db)
#pragma unroll
            for (int kb = 0; kb < 4; ++kb)
#pragma unroll
                for (int s2 = 0; s2 < 2; ++s2) { const LAS unsigned char* vq = vp + db * 16384 + ((half * 4 + kb) * 32 + s2 * 16) * 64;
                    const s16x4v lo = xvtr(vq), hi4 = xvtr(vq + 512);
                    const s16x8 vf = {lo[0], lo[1], lo[2], lo[3], hi4[0], hi4[1], hi4[2], hi4[3]};
                    o4[db] = FX_MFMA(pw[kb][s2], vf, o4[db]); }
    }
    l_reg += __shfl_xor(l_reg, 32);
    __syncthreads();
    LAS float* lw = (LAS float*)(LK + wave * 8192 + 7936);
    LAS unsigned char* stg = LV + wave * 8192;
    if (hi == 0) lw[r32] = l_reg;
    LDS_WAIT(); asm volatile("" ::: "memory");
#pragma unroll
    for (int rr = 0; rr < 16; ++rr) { const int qr_ = (rr & 3) + 8 * (rr >> 2) + 4 * hi; const float rl = __builtin_amdgcn_rcpf(lw[qr_]);
#pragma unroll
        for (int db = 0; db < 4; ++db) *(LAS hbits*)(stg + qr_ * 256 + (db * 32 + r32) * 2) = f2h(o4[db][rr] * rl); }
    LDS_WAIT(); asm volatile("" ::: "memory");
    hbits* og = O + ((size_t)b * S + 256 * qb + 32 * wave) * 512 + h * 128;
#pragma unroll
    for (int i = 0; i < 8; ++i) { const int row = i * 4 + (lane >> 4), ch = lane & 15;
        const u32x4v v = *(const LAS u32x4v*)(stg + row * 256 + ch * 16);
        __builtin_nontemporal_store(v, (u32x4v*)(og + (size_t)row * 512 + ch * 8)); }
    LDS_WAIT(); asm volatile("" ::: "memory");
}
__device__ __forceinline__ void xattn_phase(int bx, int G, int tid, int lane, int wave, const hbits* __restrict__ Qm, const float* __restrict__ qgain, const float* __restrict__ kgain,
                                            const hbits* __restrict__ Kmem, const hbits* __restrict__ Vmem, hbits* __restrict__ O, LAS unsigned char* L) {
    float gm = fmaxf(fabsf(qgain[lane]), fabsf(qgain[lane + 64])), km = fmaxf(fabsf(kgain[lane]), fabsf(kgain[lane + 64]));
#pragma unroll
    for (int o = 1; o < 64; o <<= 1) { gm = fmaxf(gm, __shfl_xor(gm, o)); km = fmaxf(km, __shfl_xor(km, o)); }
    const float mref = fmaxf(0.f, 128.f * gm * km * (0.08838834764831845f * 1.4426950408889634f) - 14.f);
#pragma unroll 1
    for (int u = bx; u < 256; u += G) { const int bh = u >> 4, qb = u & 15; xattn_unit(bh >> 2, bh & 3, qb, tid, lane, wave, Qm, qgain, Kmem, Vmem, O, mref, L); }
}

template <int W>
__device__ __forceinline__ void pool_mix(int m0, int g, int tid, const hbits* __restrict__ U, LAS unsigned char* L) {
    const int c2 = tid & 63, seg = tid >> 6, ms = m0 + 32 * seg, pos0 = ms & (S - 1);
    const hbits* up = U + (size_t)ms * 512 + g * 128 + 2 * c2;
    unsigned uv[W - 1 + 32];
#pragma unroll
    for (int j = 0; j < W - 1 + 32; ++j) { const int rel = j - (W - 1); uv[j] = *(const unsigned*)(up + (ptrdiff_t)((pos0 + rel >= 0) ? rel : 0) * 512); }
    __builtin_amdgcn_sched_barrier(0);
#pragma unroll
    for (int j = 0; j < W - 1; ++j) { const int rel = j - (W - 1); uv[j] = (pos0 + rel >= 0) ? uv[j] : 0u; }
    float s0 = 0.f, s1 = 0.f;
#pragma unroll
    for (int j = 0; j < W - 1; ++j) { const unsigned u = uv[j]; const h2v hv = __builtin_bit_cast(h2v, u); s0 += (float)hv[0]; s1 += (float)hv[1]; }
#pragma unroll
    for (int i = 0; i < 32; ++i) { const int pos = pos0 + i;
        const unsigned u = uv[W - 1 + i]; const h2v hv = __builtin_bit_cast(h2v, u); const float u0 = (float)hv[0], u1 = (float)hv[1];
        s0 += u0; s1 += u1;
        const float rc = 1.0f / (float)((pos + 1 < W) ? pos + 1 : W);
        *(LAS unsigned*)(L + (32 * seg + i) * 272 + c2 * 4) = pkh(s0 * rc - u0, s1 * rc - u1);
        const unsigned uo = uv[i]; const h2v ho = __builtin_bit_cast(h2v, uo); s0 -= (float)ho[0]; s1 -= (float)ho[1]; }
}
__device__ __forceinline__ void pool_item(int g, int tb, int tid, int lane, int wave, const hbits* __restrict__ U, const hbits* __restrict__ Pwt, hbits* __restrict__ Y, LAS unsigned char* L) {
    asm volatile("" : "+v"(tid), "+v"(lane));
    const int m0 = tb * 256;
    __syncthreads();
    u32x4v wst_[4];
#pragma unroll
    for (int i = 0; i < 4; ++i) { const int pc = i * 512 + tid; wst_[i] = *(const u32x4v*)(Pwt + (size_t)g * 128 * 128 + (size_t)(pc >> 4) * 128 + (pc & 15) * 8); }
    if (g == 0) pool_mix<2>(m0, g, tid, U, L); else if (g == 1) pool_mix<4>(m0, g, tid, U, L); else if (g == 2) pool_mix<8>(m0, g, tid, U, L); else pool_mix<16>(m0, g, tid, U, L);
#pragma unroll
    for (int i = 0; i < 4; ++i) { const int pc = i * 512 + tid; *(LAS u32x4v*)(L + 69632 + (pc >> 4) * 272 + (pc & 15) * 16) = wst_[i]; }
    __syncthreads();
    const int r32 = lane & 31, hi = lane >> 5;
    const LAS unsigned char* mp = L + (32 * wave + r32) * 272 + hi * 16;
    const LAS unsigned char* wl = L + 69632 + r32 * 272 + hi * 16;
    hbits* yp = Y + (size_t)(m0 + 32 * wave + r32) * 1024 + g * 128 + 4 * hi;
#pragma unroll 1
    for (int db = 0; db < 4; ++db) {
        f32x16 acc = f32x16{};
        s16x8 wf[8];
#pragma unroll
        for (int ks = 0; ks < 8; ++ks) wf[ks] = *(const LAS s16x8*)(wl + (32 * db) * 272 + ks * 32);
        asm volatile("" : "+v"(wf[0]), "+v"(wf[1]), "+v"(wf[2]), "+v"(wf[3]), "+v"(wf[4]), "+v"(wf[5]), "+v"(wf[6]), "+v"(wf[7]));
#pragma unroll
        for (int ks = 0; ks < 8; ++ks) { const s16x8 mf = *(const LAS s16x8*)(mp + ks * 32); acc = FX_MFMA(wf[ks], mf, acc); }
#pragma unroll
        for (int q4 = 0; q4 < 4; ++q4) { u32x2v o; o.x = pkh(acc[4 * q4], acc[4 * q4 + 1]); o.y = pkh(acc[4 * q4 + 2], acc[4 * q4 + 3]); *(u32x2v*)(yp + 32 * db + 8 * q4) = o; }
    }
}
__device__ __forceinline__ void pool_phase(int bx, int G, int tid, int lane, int wave, const hbits* __restrict__ U, const hbits* __restrict__ Pwt, hbits* __restrict__ Y, LAS unsigned char* L) {
#pragma unroll 1
    for (int it = bx; it < 256; it += G) pool_item(it & 3, it >> 2, tid, lane, wave, U, Pwt, Y, L);
}
}
constexpr int NWAVES = 8;
constexpr int RING_OFF = 0, RING_BYTES = 131072, LDSCTL_OFF = RING_BYTES, MISC_OFF = LDSCTL_OFF + 320, LDS_BYTES = 147456;
constexpr int CW_BAR = 4096;

__device__ __forceinline__ float wave_sum_x(float v) {
#define FDPP(ctrl, rm) __builtin_bit_cast(float, __builtin_amdgcn_update_dpp(0, __builtin_bit_cast(int, v), ctrl, rm, 0xf, false))
    v += FDPP(0xB1, 0xf); v += FDPP(0x4E, 0xf); v += FDPP(0x141, 0xf); v += FDPP(0x140, 0xf); v += FDPP(0x142, 0xa); v += FDPP(0x143, 0xc);
#undef FDPP
    return __builtin_bit_cast(float, __builtin_amdgcn_readlane(__builtin_bit_cast(int, v), 63));
}
__device__ __forceinline__ void tr_item(const float* __restrict__ W, int ldw, int src0, int nvalid, const float* __restrict__ kgain, const float* __restrict__ nscale,
                                        hbits* WT, int ldt, int dst_row0, int k0, LAS float* scr, int lane) {
    { const int n = lane & 31, kh = lane >> 5; float vals[32];
#pragma unroll
      for (int i = 0; i < 32; ++i) vals[i] = (n < nvalid) ? __builtin_nontemporal_load(&W[(size_t)(k0 + 2 * i + kh) * ldw + src0 + n]) : 0.f;
      if (kgain) {
#pragma unroll
        for (int i = 0; i < 32; ++i) vals[i] *= kgain[k0 + 2 * i + kh]; }
#pragma unroll
      for (int i = 0; i < 32; ++i) scr[(2 * i + kh) * 33 + n] = vals[i]; }
    LDS_WAIT(); asm volatile("" ::: "memory");
    const int c = lane & 7;
#pragma unroll
    for (int j = 0; j < 4; ++j) { const int n = (lane >> 3) + 8 * j; const LAS float* s = scr + (8 * c) * 33 + n; const float sc = nscale ? nscale[n] : 1.0f;
        v4u o; o.x = pkh(s[0 * 33] * sc, s[1 * 33] * sc); o.y = pkh(s[2 * 33] * sc, s[3 * 33] * sc); o.z = pkh(s[4 * 33] * sc, s[5 * 33] * sc); o.w = pkh(s[6 * 33] * sc, s[7 * 33] * sc);
        *(GAS v4u*)(WT + (size_t)(dst_row0 + n) * ldt + k0 + 8 * c) = o; }
    LDS_WAIT(); asm volatile("" ::: "memory");
}
__device__ __forceinline__ void rms_row_to_h(const float* xrow, hbits* orow, int lane) {
    const GAS f32x4* xr = (const GAS f32x4*)xrow + lane;
    f32x4 v[4]; float s = 0.f;
#pragma unroll
    for (int j = 0; j < 4; ++j) { v[j] = xr[64 * j]; s += (v[j].x * v[j].x + v[j].y * v[j].y) + (v[j].z * v[j].z + v[j].w * v[j].w); }
    const float rstd = rsqrtf(wave_sum_x(s) * (1.f / D) + EPS);
    GAS unsigned long long* o8 = (GAS unsigned long long*)orow + lane;
#pragma unroll
    for (int j = 0; j < 4; ++j) o8[64 * j] = (unsigned long long)pkh(v[j].x * rstd, v[j].y * rstd) | ((unsigned long long)pkh(v[j].z * rstd, v[j].w * rstd) << 32);
}

__device__ __forceinline__ void rms_rows2_to_h(const float* xa, hbits* oa, const float* xb, hbits* ob, float* rmsa, float* rmsb, int lane) {
    const GAS f32x4* pa = (const GAS f32x4*)xa + lane; const GAS f32x4* pb = (const GAS f32x4*)xb + lane;
    f32x4 va[4], vb[4]; float sa = 0.f, sb = 0.f;
#pragma unroll
    for (int j = 0; j < 4; ++j) { va[j] = __builtin_nontemporal_load(pa + 64 * j); vb[j] = __builtin_nontemporal_load(pb + 64 * j); }
#pragma unroll
    for (int j = 0; j < 4; ++j) { sa += (va[j].x * va[j].x + va[j].y * va[j].y) + (va[j].z * va[j].z + va[j].w * va[j].w); sb += (vb[j].x * vb[j].x + vb[j].y * vb[j].y) + (vb[j].z * vb[j].z + vb[j].w * vb[j].w); }
    const float ra = rsqrtf(wave_sum_x(sa) * (1.f / D) + EPS), rb = rsqrtf(wave_sum_x(sb) * (1.f / D) + EPS);
    if (lane == 0) { if (rmsa) *rmsa = __builtin_amdgcn_rcpf(ra); if (rmsb) *rmsb = __builtin_amdgcn_rcpf(rb); }
    GAS unsigned long long* qa = (GAS unsigned long long*)oa + lane; GAS unsigned long long* qb = (GAS unsigned long long*)ob + lane;
#pragma unroll
    for (int j = 0; j < 4; ++j) { qa[64 * j] = (unsigned long long)pkh(va[j].x * ra, va[j].y * ra) | ((unsigned long long)pkh(va[j].z * ra, va[j].w * ra) << 32);
        qb[64 * j] = (unsigned long long)pkh(vb[j].x * rb, vb[j].y * rb) | ((unsigned long long)pkh(vb[j].z * rb, vb[j].w * rb) << 32); }
}

struct Args { const float* in[25]; float* out; unsigned char* ws; int ph_lo, ph_hi, li, pad; int rep[16]; };

__global__ void __launch_bounds__(NWAVES * 64, 2) mk(Args args) {
    extern __shared__ __attribute__((aligned(16))) unsigned char lds[];
    LAS unsigned char* L = (LAS unsigned char*)lds;
    volatile LAS unsigned* MISC = (volatile LAS unsigned*)(L + MISC_OFF);
    const int wave = __builtin_amdgcn_readfirstlane((int)threadIdx.x >> 6);
#define lane (fx_lane())
#define tid (wave * 64 + fx_lane())
#define T0 (wave == 0 && fx_lane() == 0)
    const int G = gridDim.x; const int bx = blockIdx.x;
    unsigned char* ws = args.ws;
    for (int u = tid; u < (LDS_BYTES - LDSCTL_OFF) / 4; u += NWAVES * 64) ((LAS unsigned*)(L + LDSCTL_OFF))[u] = 0u;
    __syncthreads();
    XcdBarrier bar = xcd_barrier_post((unsigned*)(ws + WS_CTL) + CW_BAR, MISC + 8, T0);
    const int lo = args.ph_lo, hi = args.ph_hi;
#define IN(k) (lo <= (k) && (k) < hi)
#define BOTH(k) (IN(k) && IN((k) + 1))
    const float* x = args.in[0]; const float* mem = args.in[1]; const float* mix_norm = args.in[2]; const float* w_in = args.in[3];
    const float* pool_w = args.in[4]; const float* pool_scale = args.in[5]; const float* q_norm = args.in[6]; const float* k_norm = args.in[7]; const float* idx_k_norm = args.in[8];
    const float* w_out = args.in[9]; const float* xattn_norm = args.in[10]; const float* mem_norm = args.in[11]; const float* wq = args.in[12]; const float* wkv = args.in[13];
    const float* wo = args.in[16]; const float* ffn_norm = args.in[17]; const float* wgate = args.in[22]; const float* wup = args.in[23]; const float* wdown = args.in[24];
#define Win_t ((hbits*)(ws + WS_WIN))
#define Wkv_t (Win_t + (size_t)2816 * 1024)
#define Wout_t ((hbits*)(ws + WS_WOUT))
#define Wq_t ((hbits*)(ws + WS_WQ))
#define Wo_t ((hbits*)(ws + WS_WO))
#define Wgu_t ((hbits*)(ws + WS_WGU))
#define Wd_t ((hbits*)(ws + WS_WD))
#define Pw_t ((hbits*)(ws + WS_PWT))
#define XH ((hbits*)(ws + WS_XH))
#define cosT ((float*)(ws + WS_ROPE))
#define sinT (cosT + 4096 * 32)

    for (int rep_ = 0; rep_ < (IN(0) ? args.rep[0] : 0); ++rep_) {
        LAS float* scr = (LAS float*)(L + RING_OFF + wave * 16384);
        const int gw = bx * NWAVES + wave, NGW = G * NWAVES;
        constexpr int I0 = 16 * 88, I1 = 512, I2 = 512, I3 = 256, I4 = 256, I5 = 32, I6 = 8192, I7 = 4096, NITEMS = I0 + I1 + I2 + I3 + I4 + I5;
        for (int it = gw; it < NITEMS; it += NGW) {
            int r = it;
            if (r < I0) { const int kb = r / 88, bb = r % 88, T = bb >> 3, cb = bb & 7, wc = cb & 3, bj = cb >> 2; int src0, nv = 32;
                if (T < 2) src0 = 256 * T + 32 * cb;
                else if (T == 6 || T == 7) src0 = 1536 + 256 * (T - 6) + 32 * cb;
                else if (T == 10) { if (cb == 0) src0 = 2560; else if (cb == 4) src0 = 2592; else if (cb == 1) { src0 = 2624; nv = 8; } else { src0 = 0; nv = 0; } }
                else { const int base = (T < 4) ? 512 : (T < 6) ? 1024 : 2048; src0 = base + 64 * (4 * (T & 1) + wc) + 32 * bj; }
                tr_item(w_in, INC, src0, nv, mix_norm, nullptr, Win_t, 1024, 32 * bb, 64 * kb, scr, lane); continue; }
            r -= I0;
            if (r < I1) { const int kb = r / 32, nb = r % 32; tr_item(wkv, 1024, 32 * nb, 32, mem_norm, nullptr, Wkv_t, 1024, 32 * nb, 64 * kb, scr, lane); continue; }
            r -= I1;
            if (r < I2) { const int kb = r / 32, nb = r % 32; tr_item(w_out, 1024, 32 * nb, 32, nullptr, nullptr, Wout_t, 1024, 32 * nb, 64 * kb, scr, lane); continue; }
            r -= I2;
            if (r < I3) { const int kb = r / 16, nb = r % 16; tr_item(wq, 512, 32 * nb, 32, xattn_norm, nullptr, Wq_t, 1024, 32 * nb, 64 * kb, scr, lane); continue; }
            r -= I3;
            if (r < I4) { const int kb = r / 32, nb = r % 32; tr_item(wo, 1024, 32 * nb, 32, nullptr, nullptr, Wo_t, 512, 32 * nb, 64 * kb, scr, lane); continue; }
            r -= I4;
            if (r < I5) { const int g = r >> 3, kb = (r >> 2) & 1, nb = r & 3;
                tr_item(pool_w + (size_t)g * 128 * 128, 128, 32 * nb, 32, nullptr, pool_scale + g * 128 + 32 * nb, Pw_t + (size_t)g * 128 * 128, 128, 32 * nb, 64 * kb, scr, lane); continue; }
        }
        for (int m = gw; m < M + MR; m += 2 * NGW) {
            const int m2 = m + NGW; const bool has2 = m2 < M + MR; const int mm2 = has2 ? m2 : m;
            rms_rows2_to_h(m < M ? x + (size_t)m * D : mem + (size_t)(m - M) * D, XH + (size_t)m * D, mm2 < M ? x + (size_t)mm2 * D : mem + (size_t)(mm2 - M) * D, XH + (size_t)mm2 * D, m < M ? (float*)(ws + WS_RMS0) + m : nullptr, mm2 < M ? (float*)(ws + WS_RMS0) + mm2 : nullptr, lane); }
        for (int i = bx * 512 + tid; i < 4096 * 32; i += G * 512) { const int pos = i >> 5, k = i & 31;
            const float inv = powf(10000.f, -(float)(2 * k) / 64.f), ang = (float)pos * inv; cosT[i] = cosf(ang); sinT[i] = sinf(ang); }
        { hbits* RWT = (hbits*)(ws + WS_RWT); const float* rgw = args.in[18]; const float* rew = args.in[20];
          for (int i = bx * 512 + tid; i < 64 * 1024; i += G * 512) { const int j = i >> 10, k = i & 1023; RWT[i] = (j < 36) ? f2h(ffn_norm[k] * (j < 4 ? rgw[k * 4 + j] : rew[k * 32 + (j - 4)])) : (hbits)0; } }
        if (BOTH(0)) xcd_barrier(bar, T0, wave == 0);
    }
    constexpr int I6 = 8192, I7 = 4096, NI1 = 48 * NWAVES * 8;
#define MOE_CONV(it_) do { int r = (it_); LAS float* scr = (LAS float*)(L + RING_OFF + wave * 16384); \
        if (r < I6) { const int e = r >> 8, q = r & 255, kb = q >> 4, bb = q & 15, T = bb >> 3, cb = bb & 7, bj = cb >> 2; \
            tr_item((bj ? wup : wgate) + (size_t)e * 1024 * 256, 256, 128 * T + 32 * (cb & 3), 32, ffn_norm, nullptr, Wgu_t + (size_t)e * 512 * 1024, 1024, 32 * bb, 64 * kb, scr, lane); } \
        else { r -= I6; const int e = r >> 7, q = r & 127, kb = q >> 5, nb = q & 31; \
            tr_item(wdown + (size_t)e * 256 * 1024, 1024, 32 * nb, 32, nullptr, nullptr, Wd_t + (size_t)e * 1024 * 256, 256, 32 * nb, 64 * kb, scr, lane); } } while (0)
    const bool conv_split = (G == 256) && IN(1) && IN(6);
    for (int rep_ = 0; rep_ < (IN(1) ? args.rep[1] : 0); ++rep_) {
        pg8::Gemm g{XH, Win_t, M + MR, 3840, D}; pg8::SchedIn Sc; Sc.init(G, bx);
        pg8::EpiIn E{(hbits*)(ws + WS_U), (hbits*)(ws + WS_QA), (hbits*)(ws + WS_KA), (hbits*)(ws + WS_VA), (hbits*)(ws + WS_QI), (hbits*)(ws + WS_KI), (float*)(ws + WS_WI), (float*)(ws + WS_KVRAW),
                     cosT, sinT, q_norm, k_norm, idx_k_norm};
        pg8::gemm_phase<pg8::EpiIn, pg8::SchedIn, true, true>(L + RING_OFF, g, Sc, E, wave);
        if (conv_split && bx >= 208 && rep_ == 0) {
#pragma unroll 1
            for (int it = (bx - 208) * NWAVES + wave; it < NI1; it += 48 * NWAVES) MOE_CONV(it);
        }
        if (BOTH(1)) xcd_barrier(bar, T0, wave == 0);
    }

    for (int rep_ = 0; rep_ < (IN(2) ? args.rep[2] : 0); ++rep_) {
        for (int r2 = 0; r2 < args.rep[13]; ++r2) fx::pool_phase(bx, G, tid, lane, wave, (const hbits*)(ws + WS_U), Pw_t, (hbits*)args.out, L + RING_OFF);
        for (int r2 = 0; r2 < args.rep[14]; ++r2) sl::kmem_phase(bx * NWAVES + wave, G * NWAVES, lane, (const float*)(ws + WS_KVRAW), args.in[15], (hbits*)(ws + WS_KMEM), (hbits*)(ws + WS_VMEM));
        __syncthreads();
        for (int r2 = 0; r2 < args.rep[15]; ++r2) fx::indexer_phase(bx, G, tid, lane, wave, (const hbits*)(ws + WS_QI), (const hbits*)(ws + WS_KI), (const float*)(ws + WS_WI), ws, (unsigned char*)args.out, L + RING_OFF);
        if (BOTH(2)) xcd_barrier(bar, T0, wave == 0);
    }
    for (int rep_ = 0; rep_ < (IN(3) ? args.rep[3] : 0); ++rep_) {
        fx::select_phase(bx * NWAVES + wave, G * NWAVES, lane, ws, (const unsigned char*)args.out, (unsigned char*)(ws + WS_MASK), (LAS unsigned*)(L + RING_OFF + wave * 10240));
        if (BOTH(3)) xcd_barrier(bar, T0, wave == 0);
    }
    for (int rep_ = 0; rep_ < (IN(4) ? args.rep[4] : 0); ++rep_) {
        float gm = fabsf(q_norm[lane]), km = fabsf(k_norm[lane]);
#pragma unroll
        for (int o = 1; o < 64; o <<= 1) { gm = fmaxf(gm, __shfl_xor(gm, o)); km = fmaxf(km, __shfl_xor(km, o)); }
        const bool fast_ok = (G == 256) && (64.f * gm * km * C2Q <= 14.f);
#if DBG_ATTN
        sl::dsa_phase(L, bx, G, tid, (const hbits*)(ws + WS_QA), (const hbits*)(ws + WS_KA), (const hbits*)(ws + WS_VA), (const unsigned long long*)(ws + WS_MASK), (hbits*)args.out);
        __syncthreads();
        { const attn_body::AttnTensors AT{(const hbits*)(ws + WS_QA), (const hbits*)(ws + WS_KA), (const hbits*)(ws + WS_VA), (hbits*)(ws + WS_X1H), (const unsigned long long*)(ws + WS_MASK), 0.f};
          const attn_body::StaticOrder SA(G, bx);
          attn_body::attn_phase<attn_body::StaticOrder>((char*)lds + RING_OFF, AT, SA, wave); }
        xcd_barrier(bar, T0, wave == 0);
        { unsigned* dbg = (unsigned*)(ws + WS_CTL) + 16384;
          const hbits* Ya = (const hbits*)args.out; const hbits* Yb = (const hbits*)(ws + WS_X1H);
          float mx = 0.f; unsigned cntb = 0, cnt2 = 0, minrow = 0xffffffffu;
          for (size_t i = (size_t)bx * 512 + tid; i < (size_t)M * 512; i += (size_t)G * 512) { const int m = (int)(i >> 9), cidx = (int)(i & 511);
              const float d = fabsf(h2f(Ya[(size_t)m * 1024 + 512 + cidx]) - h2f(Yb[(size_t)m * 1024 + 512 + cidx]));
              mx = fmaxf(mx, d); if (d > DBG_TOL) { ++cntb; if ((m & 4095) < 256) ++cnt2; if ((unsigned)(m & 4095) < minrow) minrow = (unsigned)(m & 4095); } }
          atomicMax(dbg + 0, __float_as_uint(mx)); atomicAdd(dbg + 1, cntb); if (minrow != 0xffffffffu) atomicMax(dbg + 2, 4096u - minrow); atomicAdd(dbg + 3, cnt2); }
#else
        if (fast_ok) {
            static_assert(attn_body::ATTN_LDS_BYTES <= RING_BYTES, "attention LDS");
            const attn_body::AttnTensors AT{(const hbits*)(ws + WS_QA), (const hbits*)(ws + WS_KA), (const hbits*)(ws + WS_VA), (hbits*)args.out, (const unsigned long long*)(ws + WS_MASK), 0.f};
            const attn_body::StaticOrder SA(G, bx);
            attn_body::attn_phase<attn_body::StaticOrder>((char*)lds + RING_OFF, AT, SA, wave);
        } else
        sl::dsa_phase(L, bx, G, tid, (const hbits*)(ws + WS_QA), (const hbits*)(ws + WS_KA), (const hbits*)(ws + WS_VA), (const unsigned long long*)(ws + WS_MASK), (hbits*)args.out);
#endif
        if (BOTH(4)) xcd_barrier(bar, T0, wave == 0);
    }
    for (int rep_ = 0; rep_ < (IN(5) ? args.rep[5] : 0); ++rep_) {
        pg8::Gemm g{(const hbits*)args.out, Wout_t, M, D, D}; pg8::StaticOrder Sc; Sc.init(M, D, G, bx);
        pg8::EpiRes<true, true> E{XH, (hbits*)(ws + WS_X1H), (float*)(ws + WS_SS1), (const float*)(ws + WS_RMS0)};
        pg8::gemm_phase<pg8::EpiRes<true, true>, pg8::StaticOrder, true, true>(L + RING_OFF, g, Sc, E, wave);
        if (BOTH(5)) xcd_barrier(bar, T0, wave == 0);
    }
    for (int rep_ = 0; rep_ < (IN(6) ? args.rep[6] : 0); ++rep_) {
        pg8::Gemm g{(const hbits*)(ws + WS_X1H), Wq_t, M, 512, D}; pg8::StaticOrder Sc; Sc.init(M, 512, G, bx);
        pg8::EpiWq E{(const float*)(ws + WS_SS1), (hbits*)(ws + WS_QM)};
        if (bx >= 128 && G == 256) {
            const int gw2 = (bx - 128) * NWAVES + wave, NGW2 = 128 * NWAVES;
#pragma unroll 1
            for (int it = (conv_split ? NI1 : 0) + gw2; it < I6 + I7; it += NGW2) MOE_CONV(it);
        } else
        pg8::gemm_phase<pg8::EpiWq, pg8::StaticOrder, true, true>(L + RING_OFF, g, Sc, E, wave);
        if (BOTH(6)) xcd_barrier(bar, T0, wave == 0);
    }

    for (int rep_ = 0; rep_ < (IN(7) ? args.rep[7] : 0); ++rep_) {
        fx::xattn_phase(bx, G, tid, lane, wave, (const hbits*)(ws + WS_QM), args.in[14], args.in[15], (const hbits*)(ws + WS_KMEM), (const hbits*)(ws + WS_VMEM), (hbits*)(ws + WS_OX), L + RING_OFF);
        if (BOTH(7)) xcd_barrier(bar, T0, wave == 0);
    }
    for (int rep_ = 0; rep_ < (IN(8) ? args.rep[8] : 0); ++rep_) {
        pg8::Gemm g{(const hbits*)(ws + WS_OX), Wo_t, M, D, 512}; pg8::StaticOrder Sc; Sc.init(M, D, G, bx);
        pg8::EpiRes<true, false> E{(const hbits*)(ws + WS_X1H), (hbits*)(ws + WS_X2H), (float*)(ws + WS_SS2), nullptr};
        pg8::gemm_phase<pg8::EpiRes<true, false>, pg8::StaticOrder, true, true>(L + RING_OFF, g, Sc, E, wave);
        if (BOTH(8)) xcd_barrier(bar, T0, wave == 0);
    }

    LAS int* TB = (LAS int*)(L + LDSCTL_OFF + 1024); LAS int* TC = TB + 32; LAS int* TTp = TB + 64; LAS int* lc = TB + 96; LAS int* lbase = TB + 128;
#define gcnt ((int*)(ws + WS_CTL) + CW_CNT)
#define rlist ((int*)(ws + WS_RLIST))
#define rwt ((float*)(ws + WS_RW))
#define RSTD2 ((float*)(ws + WS_RSTD2))
#define rsl ((float*)(ws + WS_RSL))
    if (IN(9)) {
        const float* RWT = (const float*)(ws + WS_RWT); const hbits* X2 = (const hbits*)(ws + WS_X2H); const float* SS2 = (const float*)(ws + WS_SS2);
        const float* rgb = args.in[19]; const float* reb = args.in[21];
        for (int it = bx; it < M / 64; it += G) {
            const int tok0 = it * 64;
            LAS float* xs = (LAS float*)(L + wave * 9216);
            for (int r9 = 0; r9 < args.rep[9]; ++r9) {
            const int l9 = lane, r32 = l9 & 31, hi9 = l9 >> 5;
            fx::f32x16 a00 = fx::f32x16{}, a01 = fx::f32x16{}, a10 = fx::f32x16{}, a11 = fx::f32x16{};
            const hbits* xa = X2 + (size_t)(tok0 + r32) * D + wave * 128 + hi9 * 8;
            const hbits* wb = (const hbits*)(ws + WS_RWT) + (size_t)r32 * 1024 + wave * 128 + hi9 * 8;
#pragma unroll
            for (int ks = 0; ks < 8; ++ks) {
                const fx::s16x8 x0 = *(const fx::s16x8*)(xa + ks * 16), x1 = *(const fx::s16x8*)(xa + (size_t)32 * D + ks * 16);
                const fx::s16x8 w0 = *(const fx::s16x8*)(wb + ks * 16), w1 = *(const fx::s16x8*)(wb + (size_t)32 * 1024 + ks * 16);
                a00 = FX_MFMA(x0, w0, a00); a01 = FX_MFMA(x0, w1, a01); a10 = FX_MFMA(x1, w0, a10); a11 = FX_MFMA(x1, w1, a11);
            }
#pragma unroll
            for (int rr = 0; rr < 16; ++rr) { const int tk = (rr & 3) + 8 * (rr >> 2) + 4 * hi9;
                xs[r32 * 64 + tk] = a00[rr]; xs[r32 * 64 + 32 + tk] = a10[rr];
                if (r32 < 4) { xs[(32 + r32) * 64 + tk] = a01[rr]; xs[(32 + r32) * 64 + 32 + tk] = a11[rr]; } }
            }
            if (tid < 32) lc[tid] = 0;
            __syncthreads();
            LAS float* lg = (LAS float*)(L + 8 * 9216);
            for (int o = tid; o < 2304; o += 512) { float sm = 0.f;
#pragma unroll
                for (int w = 0; w < 8; ++w) sm += ((LAS float*)(L + w * 9216))[o];
                lg[o] = sm; }
            __syncthreads();
            if (wave == 0) {
                const int tok = tok0 + lane;
                const f32x4 a4 = *(const f32x4*)(SS2 + (size_t)tok * 16), b4 = *(const f32x4*)(SS2 + (size_t)tok * 16 + 4), c4 = *(const f32x4*)(SS2 + (size_t)tok * 16 + 8), d4 = *(const f32x4*)(SS2 + (size_t)tok * 16 + 12);
                const float tt = ((a4[0] + a4[1]) + (a4[2] + a4[3])) + ((b4[0] + b4[1]) + (b4[2] + b4[3])) + ((c4[0] + c4[1]) + (c4[2] + c4[3])) + ((d4[0] + d4[1]) + (d4[2] + d4[3]));
                const float r = rsqrtf(tt * (1.0f / 1024.0f) + EPS);
                RSTD2[tok] = r;
                float gl[4]; int g = 0;
#pragma unroll
                for (int j = 0; j < 4; ++j) gl[j] = lg[j * 64 + lane] * r + rgb[j];
#pragma unroll
                for (int j = 1; j < 4; ++j) if (gl[j] > gl[g]) g = j;
                float gs = 0.f;
#pragma unroll
                for (int j = 0; j < 4; ++j) gs += expf(gl[j] - gl[g]);
                const float gwt = 1.f / gs;
                float el[8];
#pragma unroll
                for (int j = 0; j < 8; ++j) el[j] = lg[(4 + g * 8 + j) * 64 + lane] * r + reb[g * 8 + j];
                int i0 = 0;
#pragma unroll
                for (int j = 1; j < 8; ++j) if (el[j] > el[i0]) i0 = j;
                int i1 = (i0 == 0) ? 1 : 0;
#pragma unroll
                for (int j = 0; j < 8; ++j) if (j != i0 && el[j] > el[i1]) i1 = j;
                float v0 = el[0], v1 = el[0];
#pragma unroll
                for (int j = 0; j < 8; ++j) { if (j == i0) v0 = el[j]; if (j == i1) v1 = el[j]; }
                const float e1 = expf(v1 - v0);
                const float w0 = gwt / (1.f + e1), w1 = gwt * e1 / (1.f + e1);
                const int e0g = g * 8 + i0, e1g = g * 8 + i1;
                const int p0 = __hip_atomic_fetch_add(lc + e0g, 1, __ATOMIC_RELAXED, __HIP_MEMORY_SCOPE_WORKGROUP);
                const int p1 = __hip_atomic_fetch_add(lc + e1g, 1, __ATOMIC_RELAXED, __HIP_MEMORY_SCOPE_WORKGROUP);
                LDS_WAIT(); asm volatile("" ::: "memory");
                if (lane < 32) { const int n = ((volatile LAS int*)lc)[lane]; int bs = 0; if (n > 0) bs = atomicAdd(gcnt + lane, n); ((volatile LAS int*)lbase)[lane] = bs; }
                LDS_WAIT(); asm volatile("" ::: "memory");
                const int b0 = ((volatile LAS int*)lbase)[e0g], b1 = ((volatile LAS int*)lbase)[e1g];
                rlist[(size_t)e0g * M + b0 + p0] = (tok << 1); rwt[(size_t)e0g * M + b0 + p0] = w0; rsl[(size_t)e0g * M + b0 + p0] = r;
                rlist[(size_t)e1g * M + b1 + p1] = (tok << 1) | 1; rwt[(size_t)e1g * M + b1 + p1] = w1; rsl[(size_t)e1g * M + b1 + p1] = r;
            }
            __syncthreads();
        }
        if (BOTH(9)) xcd_barrier(bar, T0, wave == 0);
    }
    if (IN(10)) {
        if (wave == 0) {
            const int n = (lane < 32) ? __hip_atomic_load(gcnt + (lane & 31), __ATOMIC_RELAXED, __HIP_MEMORY_SCOPE_AGENT) : 0;
            const int nt = (n + 255) >> 8; int inc = nt;
#pragma unroll
            for (int o = 1; o < 32; o <<= 1) { const int t = __shfl_up(inc, o); if ((lane & 31) >= o) inc += t; }
            if (lane < 32) { TB[lane] = inc - nt; TC[lane] = n; }
            if (lane == 31) TTp[0] = inc;
        }
        __syncthreads();
    }
    for (int rep_ = 0; rep_ < (IN(10) ? args.rep[10] : 0); ++rep_) {
        pg8::MoeTab tab{TB, TC, __builtin_amdgcn_readfirstlane(TTp[0])};
        unsigned* tdone = (unsigned*)(ws + WS_CTL) + CW_MOE + rep_ * 4096;
        const int ngu = 2 * tab.TT, R_ = (ngu > G && ngu <= 2 * G) ? ngu - G : 0, nd_ = G - R_;
        if (ngu <= 2 * G) {
            int ub_ = bx - R_;
            if (G == 256 && bx >= R_) { const int x_ = bx & 7; int base_ = 0;
                for (int y = 0; y < x_; ++y) base_ += 32 - ((R_ > y) ? ((R_ - y + 7) >> 3) : 0);
                ub_ = base_ + (bx >> 3) - ((R_ > x_) ? ((R_ - x_ + 7) >> 3) : 0); }
            int tile = -1, T = 0, nun = 0;
            if (bx < R_) { int pa_ = bx;
                if (G == 256) { const int x_ = bx & 7; int base_ = 0;
                    for (int y = 0; y < x_; ++y) base_ += (R_ > y) ? ((R_ - y + 7) >> 3) : 0;
                    pa_ = base_ + (bx >> 3); }
                tile = tab.TT - R_ + pa_; nun = 2; }
            else if (ub_ < ngu - 2 * R_) { tile = ub_ >> 1; T = ub_ & 1; nun = 1; }
            if (nun) {
                const int e = __builtin_amdgcn_readfirstlane(tab.expert_of(tile)), rt = tile - __builtin_amdgcn_readfirstlane(TB[e]); int nvalid = __builtin_amdgcn_readfirstlane(TC[e]) - rt * 256; if (nvalid > 256) nvalid = 256;
                pg8::Gemm g{(const hbits*)(ws + WS_X2H), Wgu_t, M, 512, D, rlist + (size_t)e * M + rt * 256, nvalid};
                pg8::SchedTwo Sc{{tile, 2 * e + T}, {tile, 2 * e + 1}, nun};
                pg8::EpiGU E{(hbits*)(ws + WS_HID), rwt + (size_t)e * M + rt * 256, rsl + (size_t)e * M + rt * 256, nvalid, tile * 256};
                pg8::gemm_phase<pg8::EpiGU, pg8::SchedTwo, true, true, true, true>(L + RING_OFF, g, Sc, E, wave);
                asm volatile("s_waitcnt vmcnt(0)" ::: "memory"); __syncthreads();
                if (T0) __hip_atomic_fetch_add(tdone + 16 * tile, (unsigned)nun, __ATOMIC_RELAXED, __HIP_MEMORY_SCOPE_AGENT);
            }
            const int n_dn_mine = (bx >= R_) ? (4 * tab.TT - ub_ + nd_ - 1) / nd_ : 0;
            for (int it_ = 0; it_ < n_dn_mine; ++it_) {
                const int dn = ub_ + it_ * nd_, tile2 = dn >> 2, cn = dn & 3, e = __builtin_amdgcn_readfirstlane(tab.expert_of(tile2));
                if (T0) { unsigned sp = 0;
                    while (__hip_atomic_load(tdone + 16 * tile2, __ATOMIC_RELAXED, __HIP_MEMORY_SCOPE_AGENT) < 2u) { __builtin_amdgcn_s_sleep(2); if (++sp > (1u << 22)) break; }
                    __builtin_amdgcn_fence(__ATOMIC_ACQUIRE, "agent"); asm volatile("s_waitcnt vmcnt(0)" ::: "memory"); }
                __syncthreads();
                int nv_ = __builtin_amdgcn_readfirstlane(TC[e]) - (tile2 - __builtin_amdgcn_readfirstlane(TB[e])) * 256; if (nv_ > 256) nv_ = 256;
                pg8::Gemm g{(const hbits*)(ws + WS_HID), Wd_t, 40960, 32768, 256, nullptr, nv_};
                pg8::SchedOne Sc{{tile2, 4 * e + cn}};
                pg8::EpiDown E{tab, rlist, (hbits*)(ws + WS_P)};
                pg8::gemm_phase<pg8::EpiDown, pg8::SchedOne, false, true, false, true>(L + RING_OFF, g, Sc, E, wave);
            }
        }
        if (IN(12)) xcd_barrier(bar, T0, wave == 0);
    }
    if (IN(11)) { for (int rep_ = 1; rep_ < args.rep[11]; ++rep_) { xcd_barrier(bar, T0, wave == 0); xcd_barrier(bar, T0, wave == 0); xcd_barrier(bar, T0, wave == 0); xcd_barrier(bar, T0, wave == 0); } }
    for (int rep_ = 0; rep_ < (IN(12) ? args.rep[12] : 0); ++rep_) {
        const hbits* P0 = (const hbits*)(ws + WS_P); const hbits* P1 = P0 + (size_t)M * D;
#pragma unroll 4
        for (size_t i = (size_t)bx * 512 + tid; i < (size_t)M * D / 8; i += (size_t)G * 512) {
            f32x4 a, b;
            { const v4u xr = __builtin_nontemporal_load((const v4u*)((const hbits*)(ws + WS_X2H) + i * 8)); const unsigned xa = xr.x, xb = xr.y, xc = xr.z, xd = xr.w;
              const h2v x0 = __builtin_bit_cast(h2v, xa), x1 = __builtin_bit_cast(h2v, xb), x2 = __builtin_bit_cast(h2v, xc), x3 = __builtin_bit_cast(h2v, xd);
              a = (f32x4){(float)x0[0], (float)x0[1], (float)x1[0], (float)x1[1]}; b = (f32x4){(float)x2[0], (float)x2[1], (float)x3[0], (float)x3[1]}; }
            const v4u p = __builtin_nontemporal_load((const v4u*)(P0 + i * 8)), q = __builtin_nontemporal_load((const v4u*)(P1 + i * 8));
            const unsigned px = p.x, py = p.y, pz = p.z, pw = p.w, qx = q.x, qy = q.y, qz = q.z, qw = q.w;
            const h2v p0 = __builtin_bit_cast(h2v, px), p1 = __builtin_bit_cast(h2v, py), p2 = __builtin_bit_cast(h2v, pz), p3 = __builtin_bit_cast(h2v, pw);
            const h2v q0 = __builtin_bit_cast(h2v, qx), q1 = __builtin_bit_cast(h2v, qy), q2 = __builtin_bit_cast(h2v, qz), q3 = __builtin_bit_cast(h2v, qw);
            a[0] += (float)p0[0] + (float)q0[0]; a[1] += (float)p0[1] + (float)q0[1]; a[2] += (float)p1[0] + (float)q1[0]; a[3] += (float)p1[1] + (float)q1[1];
            b[0] += (float)p2[0] + (float)q2[0]; b[1] += (float)p2[1] + (float)q2[1]; b[2] += (float)p3[0] + (float)q3[0]; b[3] += (float)p3[1] + (float)q3[1];
#if DBG_ATTN
            { const unsigned* dbg = (const unsigned*)(ws + WS_CTL) + 16384; const float s0 = __uint_as_float(dbg[0]); const float frac = (float)dbg[1] / ((float)M * 512.f); const unsigned mr = 4096u - dbg[2];
              const float delta = DBG_CH_RVR == 0 ? sqrtf(frac) : sqrtf((float)dbg[3] / (4.f * 256.f * 512.f));
              a = a + delta; b = b + delta; if (i == 0) a[0] += DBG_CH_ABS == 0 ? 1000.f * s0 : (float)(mr & 4095u); }
#endif
            __builtin_nontemporal_store(a, (f32x4*)(args.out + i * 8)); __builtin_nontemporal_store(b, (f32x4*)(args.out + i * 8 + 4));
        }
    }
#undef MOE_CONV
#undef IN
#undef BOTH
#undef lane
#undef tid
#undef T0
#undef Win_t
#undef Wkv_t
#undef Wout_t
#undef Wq_t
#undef Wo_t
#undef Wgu_t
#undef Wd_t
#undef Pw_t
#undef XH
#undef cosT
#undef sinT
#undef gcnt
#undef rlist
#undef rwt
#undef RSTD2
#undef rsl
}
static void launch_mk(hipStream_t stream, int grid, const Args& base, int lo, int hi) {
    Args a = base; a.ph_lo = lo; a.ph_hi = hi;
    hipLaunchKernelGGL(mk, dim3(grid), dim3(NWAVES * 64), LDS_BYTES, stream, a);
}
extern "C" void kernel_launch(void* const* d_in, const int* in_sizes, int n_in, void* d_out, int out_size, void* d_ws, size_t ws_size, hipStream_t stream) {
    static int grid = 0;
    if (grid == 0) {
        if (n_in != 25 || in_sizes[0] != M * D || out_size != M * D || ws_size < WS_END) { fprintf(stderr, "kernel_launch: unexpected shapes (n_in %d, ws %zu)\n", n_in, ws_size); grid = -1; return; }
        int dev = 0, cus = 0, per_cu = 0;
        if (hipGetDevice(&dev) != hipSuccess || hipDeviceGetAttribute(&cus, hipDeviceAttributeMultiprocessorCount, dev) != hipSuccess) { grid = -1; return; }
        if (hipFuncSetAttribute((const void*)mk, hipFuncAttributeMaxDynamicSharedMemorySize, LDS_BYTES) != hipSuccess) { fprintf(stderr, "kernel_launch: hipFuncSetAttribute failed\n"); grid = -1; return; }
        if (hipOccupancyMaxActiveBlocksPerMultiprocessor(&per_cu, (const void*)mk, NWAVES * 64, LDS_BYTES) != hipSuccess || per_cu < 1) { fprintf(stderr, "kernel_launch: occupancy query says %d blocks/CU\n", per_cu); grid = -1; (void)hipGetLastError(); return; }
        grid = cus;
    }
    if (grid < 0) return;
    unsigned char* ws = (unsigned char*)d_ws; float* out = (float*)d_out;
    (void)hipMemsetAsync(ws + WS_CTL, 0, CTL_ZERO_BYTES, stream);
    Args a{};
    for (int i = 0; i < 25; ++i) a.in[i] = (const float*)d_in[i];
    a.out = out; a.ws = ws;
    for (int k = 0; k < 16; ++k) a.rep[k] = (k == PROBE_DOUBLE) ? 2 : 1;
    const float* pool_w = a.in[4]; const float* pool_scale = a.in[5]; const float* xq_norm = a.in[14]; const float* xk_norm = a.in[15]; const float* ffn_norm = a.in[17];
    const float* rgw = a.in[18]; const float* rgb = a.in[19]; const float* rew = a.in[20]; const float* reb = a.in[21];
    const float* wgate = a.in[22]; const float* wup = a.in[23]; const float* wdown = a.in[24];
    hbits* U = (hbits*)(ws + WS_U); hbits* Qa = (hbits*)(ws + WS_QA); hbits* Ka = (hbits*)(ws + WS_KA); hbits* Va = (hbits*)(ws + WS_VA);
    hbits* Qi = (hbits*)(ws + WS_QI); hbits* Ki = (hbits*)(ws + WS_KI); float* WI = (float*)(ws + WS_WI);
    unsigned long long* MASK = (unsigned long long*)(ws + WS_MASK);
    hbits* Y = (hbits*)out; hbits* MIX = (hbits*)(ws + 234 * MiB);
    float* rstd2 = (float*)(ws + WS_MISC); int* cnt = (int*)(rstd2 + M); int* offs = cnt + 32;
    int* list = (int*)(ws + WS_RLIST); float* wlist = (float*)(ws + WS_RW);
    float* X2c = (float*)(ws + WS_X1);
    float* HID = (float*)(ws + WS_XH);
#if ONE_LAUNCH
    launch_mk(stream, grid, a, 0, 13);
#else
    for (int ph = 0; ph < 13; ++ph) launch_mk(stream, grid, a, ph, ph + 1);
#endif
}
```

```cpp
#include <hip/hip_runtime.h>
#include <stdint.h>
#include <math.h>
#include <stdio.h>
#ifndef PROBE_DOUBLE
#define PROBE_DOUBLE -1
#endif
#define PH_REP(k) (PROBE_DOUBLE == (k) ? 2 : 1)
#ifndef DBG_ATTN
#define DBG_ATTN 0
#endif
#define DBG_TOL 0.03f
#define DBG_CH_RVR 1
#define DBG_CH_ABS 1
#ifndef ONE_LAUNCH
#define ONE_LAUNCH 1
#endif
#ifndef DBG_T1
#define DBG_T1 0
#endif
#ifndef DBG_T3
#define DBG_T3 0
#endif
#ifndef DBG_T2
#define DBG_T2 0
#endif

constexpr int NB = 4, S = 4096, D = 1024, M = NB * S, INC = 2632, MEMT = 256, MR = NB * MEMT;
constexpr float EPS = 1e-6f;
constexpr float C2Q = 0.125f * 1.4426950408889634f;
constexpr float IDX_SCALE = 0.125f * 0.35355339059327373f;
typedef unsigned short hbits;
typedef _Float16 h2v __attribute__((ext_vector_type(2)));
typedef _Float16 h8v __attribute__((ext_vector_type(8)));
typedef float f32x2 __attribute__((ext_vector_type(2)));
__device__ __forceinline__ unsigned pkh(float a, float b) { f32x2 v = {a, b}; return __builtin_bit_cast(unsigned, __builtin_convertvector(v, h2v)); }
__device__ __forceinline__ float h2f(hbits b) { return (float)__builtin_bit_cast(_Float16, b); }
__device__ __forceinline__ hbits f2h(float f) { return __builtin_bit_cast(hbits, (_Float16)f); }

__device__ __forceinline__ int fx_lane() { int l; asm volatile("v_mbcnt_lo_u32_b32 %0, -1, 0\n\tv_mbcnt_hi_u32_b32 %0, -1, %0" : "=v"(l)); return l; }

constexpr size_t MiB = 1u << 20;
constexpr size_t WS_CTL = 0, CTL_ZERO_BYTES = 256 * 1024;
constexpr size_t WS_ROPE = 1 * MiB;
constexpr size_t WS_SS1 = 2 * MiB, WS_SS2 = 3 * MiB;
constexpr size_t WS_RLIST = 4 * MiB, WS_RW = 6 * MiB;
constexpr size_t WS_KVRAW = 8 * MiB;
constexpr size_t WS_RSL = 8 * MiB;
constexpr size_t WS_KMEM = 12 * MiB, WS_VMEM = 13 * MiB;
constexpr size_t WS_WI = 14 * MiB;
constexpr size_t WS_MISC = 14 * MiB + 512 * 1024;
constexpr size_t WS_PWT = 15 * MiB;
constexpr size_t WS_RWT = 15 * MiB + 256 * 1024;
constexpr size_t WS_RSTD2 = 14 * MiB + 768 * 1024;
constexpr size_t WS_RMS0 = 14 * MiB + 512 * 1024;
constexpr size_t WS_HID = 76 * MiB;
constexpr size_t WS_P = 110 * MiB;
constexpr int CW_HO = 20480  ; constexpr int CW_CNT = 8192; constexpr int CW_MOE = 12288;
constexpr size_t WS_WIN = 16 * MiB;
constexpr size_t WS_WOUT = 24 * MiB, WS_WQ = 26 * MiB, WS_WO = 27 * MiB;
constexpr size_t WS_WGU = 28 * MiB, WS_WD = 60 * MiB;
constexpr size_t WS_XH = 76 * MiB;
constexpr size_t WS_U = 110 * MiB, WS_QA = 126 * MiB, WS_KA = 142 * MiB, WS_VA = 158 * MiB, WS_QI = 174 * MiB, WS_KI = 190 * MiB;
constexpr size_t WS_MASK = 192 * MiB;
constexpr size_t WS_SC2 = 200 * MiB;
constexpr size_t WS_X1 = 110 * MiB;
constexpr size_t WS_X1H = 76 * MiB;
constexpr size_t WS_QM = 174 * MiB;
constexpr size_t WS_OX = 200 * MiB;
constexpr size_t WS_X2H = 216 * MiB;
constexpr size_t WS_END = 256 * MiB;
constexpr size_t SC_BATCH_ELEMS = (size_t)4096 * 64 * 65 / 2;
__host__ __device__ __forceinline__ unsigned char* sc_batch_ptr(unsigned char* ws, unsigned char* outb, int b) {
    return (b == 0) ? (outb + 32 * MiB) : (b == 1) ? (ws + 234 * MiB) : (ws + WS_SC2 + (size_t)(b - 2) * SC_BATCH_ELEMS * 2); }
static_assert(32 * MiB + SC_BATCH_ELEMS * 2 <= 64 * MiB && 234 * MiB + SC_BATCH_ELEMS * 2 <= WS_END && WS_SC2 + 2 * SC_BATCH_ELEMS * 2 <= 234 * MiB, "SC layout");

#define ATTN_STORE16(p, v) asm volatile("global_store_dwordx4 %0, %1, off sc0 sc1\n\ts_nop 1" :: "v"(p), "v"(v))
namespace pg8 {
#define PG8_LAS __attribute__((address_space(3)))
typedef unsigned short bf16_t;
typedef short bf16x8 __attribute__((ext_vector_type(8)));
typedef float f32x4 __attribute__((ext_vector_type(4)));
typedef unsigned u32x4 __attribute__((ext_vector_type(4)));
constexpr int BM = 256, BK = 64, HALF = 128, HTB = HALF * BK * 2  , STAGE_BYTES = 8 * HTB, NXCD = 8, WGM = 8;

__host__ __device__ __forceinline__ int lds_byte(int r, int c) { const int st = (r >> 4) * 2 + (c >> 5), rr = r & 15, cc = c & 31, ob = rr * 64 + cc * 2; return st * 1024 + (ob ^ (((ob >> 9) & 1) << 5)); }
__host__ __device__ __forceinline__ void stage_rc(int b, int& R, int& C) { const int st = b / 1024, sb = b % 1024, swz = sb ^ (((sb >> 9) & 1) << 5); R = (st >> 1) * 16 + swz / 64; C = (st & 1) * 32 + (swz % 64) / 2; }
__host__ __device__ __forceinline__ int perm32(int rho) { const int n = rho >> 4, i = rho & 15; return 8 * (i >> 2) + 4 * n + (i & 3); }

struct Unit { int pm, pn; };
struct Gemm { const bf16_t* A; const bf16_t* Bt; int M, N, K; const int* glist; int gvalid; };

struct StaticOrder {
    int nM, nN, nwg, G, c;
    __host__ __device__ void init(int M, int N, int G_, int c_) { nM = M / BM; nN = N / BM; nwg = nM * nN; G = G_; c = c_; }
    __host__ __device__ bool next(int i, Unit& u) const {
        const long L = (long)i * G + c; if (L >= nwg) return false;
        int wgid = (int)L; { const int q = nwg / NXCD, r = nwg % NXCD, xcd = wgid % NXCD, off = wgid / NXCD; wgid = (xcd < r ? xcd * (q + 1) : r * (q + 1) + (xcd - r) * q) + off; }
        const int nig = WGM * nN, gid = wgid / nig, fm = gid * WGM, gsz = (nM - fm) < WGM ? (nM - fm) : WGM;
        u.pm = fm + ((wgid % nig) % gsz); u.pn = (wgid % nig) / gsz; return true;
    }
    __device__ __forceinline__ void a_ready(const Unit&) const {}
    __device__ __forceinline__ void done(const Unit&) const {}
};


template <class Epi, class Sched, bool ALIGN_EPI = false, bool SP2 = false, bool GATHER = false, bool ROWLIM = false>
__device__ __forceinline__ void gemm_phase(PG8_LAS unsigned char* lds, const Gemm g, const Sched& S, const Epi& E, int wid_in) {
    const int lane = fx_lane(), wid = wid_in, tid = wid * 64 + lane, wr = wid >> 2, wc = wid & 3, fr = lane & 15, fq = lane >> 4;
    const int K = g.K, nt = K / BK;
    const bool skip_hi_ = ROWLIM && (g.gvalid <= 128 || (g.gvalid <= 192 && wr == 1)), skip_lo_ = ROWLIM && (g.gvalid <= 64 && wr == 1);
    unsigned voffA[2], voffB[2];
#pragma unroll
    for (int i = 0; i < 2; ++i) { int R, C; stage_rc(tid * 16 + i * 8192, R, C); const int Rb = Epi::PERM ? ((R & ~31) + perm32(R & 31)) : R;
        voffA[i] = (unsigned)(R * K + C) * 2u; voffB[i] = (unsigned)(Rb * K + C) * 2u; }
    unsigned voffA0[2], voffA1[2];
#pragma unroll
    for (int i = 0; i < 2; ++i) {
        if constexpr (GATHER) { int R, C; stage_rc(tid * 16 + i * 8192, R, C);
            const bool ok0_ = R < g.gvalid, ok1_ = R + HALF < g.gvalid;
            const int e0_ = g.glist[ok0_ ? R : 0], e1_ = g.glist[ok1_ ? R + HALF : 0];
            const int t0 = ok0_ ? (e0_ >> 1) : 0, t1 = ok1_ ? (e1_ >> 1) : 0;
            voffA0[i] = (unsigned)(t0 * K + C) * 2u; voffA1[i] = (unsigned)(t1 * K + C) * 2u; }
        else { voffA0[i] = voffA[i]; voffA1[i] = voffA[i]; }
    }
    if constexpr (GATHER) E.stage_rows(tid);
    const size_t kstep = (size_t)(BK * 2);
    const size_t hstep = (size_t)HALF * K * 2;
    const size_t tstep = 2 * hstep; const size_t hstepA = GATHER ? (size_t)0 : hstep;
    const unsigned ldsw = (unsigned)wid * 1024u;
    const int aoff = lds_byte(wr * 64 + fr, fq * 8), boff = lds_byte(wc * 32 + fr, fq * 8);
#define PG8_SA(b, h) (((b) * 2 + (h)) * HTB)
#define PG8_SB(b, h) ((4 + (b) * 2 + (h)) * HTB)
#define PG8_STAGE(bufoff, gbase, voff) do { _Pragma("unroll") for (int _i = 0; _i < 2; ++_i) \
        __builtin_amdgcn_global_load_lds((const unsigned*)((const char*)(gbase) + (voff)[_i]), (PG8_LAS unsigned*)(lds + (bufoff) + ldsw + _i * 8192), 16, 0, 0); } while (0)
#define PG8_LDA(dst, b, h) do { _Pragma("unroll") for (int m = 0; m < 4; ++m) _Pragma("unroll") for (int k = 0; k < 2; ++k) dst[m][k] = *(const PG8_LAS bf16x8*)(lds + PG8_SA(b, h) + aoff + m * 2048 + k * 1024); } while (0)
#define PG8_LDB(dst, b, h) do { _Pragma("unroll") for (int n = 0; n < 2; ++n) _Pragma("unroll") for (int k = 0; k < 2; ++k) dst[n][k] = *(const PG8_LAS bf16x8*)(lds + PG8_SB(b, h) + boff + n * 2048 + k * 1024); } while (0)
#define PG8_MMA(ai, bj, At, Bt) do { if (ROWLIM && ((ai) == 1 ? skip_hi_ : skip_lo_)) break; __builtin_amdgcn_s_setprio(1); _Pragma("unroll") for (int m = 0; m < 4; ++m) _Pragma("unroll") for (int n = 0; n < 2; ++n) _Pragma("unroll") for (int k = 0; k < 2; ++k) \
        acc[ai][bj][m][n] = __builtin_amdgcn_mfma_f32_16x16x32_f16(__builtin_bit_cast(h8v, Bt[n][k]), __builtin_bit_cast(h8v, At[m][k]), acc[ai][bj][m][n], 0, 0, 0); __builtin_amdgcn_s_setprio(0); } while (0)
#define PG8_WAIT_V(n) asm volatile("s_waitcnt vmcnt(" #n ")" ::: "memory")
#define PG8_WAIT_L(n) asm volatile("s_waitcnt lgkmcnt(" #n ")" ::: "memory")
#define PG8_BAR __builtin_amdgcn_s_barrier()
#define PG8_SCHED __builtin_amdgcn_sched_barrier(0)
    Unit cur, nxt; int ui = 0;
    if (!S.next(0, cur)) return;
    f32x4 acc[2][2][4][2];
#pragma unroll
    for (int a = 0; a < 2; ++a)
#pragma unroll
        for (int b = 0; b < 2; ++b)
#pragma unroll
            for (int m = 0; m < 4; ++m)
#pragma unroll
                for (int n = 0; n < 2; ++n) acc[a][b][m][n] = (f32x4){0.f, 0.f, 0.f, 0.f};
    bf16x8 At[4][2], B0[2][2], B1[2][2];
    const char* cA = (const char*)g.A + (GATHER ? (size_t)0 : (size_t)cur.pm * tstep); const char* cB = (const char*)g.Bt + (size_t)cur.pn * tstep;
    S.a_ready(cur);
    if constexpr (SP2) {
        PG8_STAGE(PG8_SB(0, 0), cB, voffB); PG8_STAGE(PG8_SB(0, 1), cB + hstep, voffB); PG8_STAGE(PG8_SA(0, 0), cA, voffA0); PG8_STAGE(PG8_SA(0, 1), cA + hstepA, voffA1);
        if (wr == 1) PG8_BAR;
        PG8_WAIT_V(2); PG8_BAR;
        PG8_STAGE(PG8_SB(1, 0), cB + kstep, voffB); PG8_STAGE(PG8_SA(1, 0), cA + kstep, voffA0); PG8_STAGE(PG8_SB(1, 1), cB + hstep + kstep, voffB);
        PG8_WAIT_V(6); PG8_BAR;
    } else {
        PG8_STAGE(PG8_SB(0, 0), cB, voffB); PG8_STAGE(PG8_SA(0, 0), cA, voffA0); PG8_STAGE(PG8_SB(0, 1), cB + hstep, voffB); PG8_STAGE(PG8_SA(0, 1), cA + hstepA, voffA1);
        if (wr == 1) PG8_BAR;
        PG8_WAIT_V(4); PG8_BAR;
        PG8_STAGE(PG8_SB(1, 0), cB + kstep, voffB); PG8_STAGE(PG8_SA(1, 0), cA + kstep, voffA0); PG8_STAGE(PG8_SB(1, 1), cB + hstep + kstep, voffB);
        PG8_WAIT_V(6); PG8_BAR;
    }
    for (;;) {
        const bool has_next = S.next(ui + 1, nxt);
        const char* nA = (has_next && !GATHER) ? (const char*)g.A + (size_t)nxt.pm * tstep : cA; const char* nB = has_next ? (const char*)g.Bt + (size_t)nxt.pn * tstep : cB;
        for (int t = 0; t < nt; t += 2) {
            const bool last = (t == nt - 2);
            const char* a1 = cA + (size_t)(t + 1) * kstep;
            const char* a2 = last ? nA : cA + (size_t)(t + 2) * kstep; const char* b2 = last ? nB : cB + (size_t)(t + 2) * kstep;
            const char* a3 = a2 + kstep; const char* b3 = b2 + kstep;
            if (last && has_next) S.a_ready(nxt);
            if constexpr (SP2) {
            PG8_LDB(B0, 0, 0); PG8_LDB(B1, 0, 1); PG8_SCHED; PG8_LDA(At, 0, 0); PG8_STAGE(PG8_SA(1, 1), a1 + hstepA, voffA1);
            PG8_WAIT_V(8); PG8_WAIT_L(0); PG8_BAR; PG8_MMA(0, 0, At, B0); PG8_MMA(0, 1, At, B1); PG8_BAR; PG8_SCHED;
            PG8_LDA(At, 0, 1); PG8_STAGE(PG8_SB(0, 0), b2, voffB); PG8_STAGE(PG8_SB(0, 1), b2 + hstep, voffB); PG8_STAGE(PG8_SA(0, 0), a2, voffA0);
            PG8_WAIT_V(8); PG8_WAIT_L(0); PG8_BAR; PG8_MMA(1, 0, At, B0); PG8_MMA(1, 1, At, B1); PG8_BAR; PG8_SCHED;
            PG8_LDB(B0, 1, 0); PG8_LDB(B1, 1, 1); PG8_SCHED; PG8_LDA(At, 1, 0); PG8_STAGE(PG8_SA(0, 1), a2 + hstepA, voffA1);
            PG8_WAIT_V(8); PG8_WAIT_L(0); PG8_BAR; PG8_MMA(0, 0, At, B0); PG8_MMA(0, 1, At, B1); PG8_BAR; PG8_SCHED;
            PG8_LDA(At, 1, 1); PG8_STAGE(PG8_SB(1, 0), b3, voffB); PG8_STAGE(PG8_SB(1, 1), b3 + hstep, voffB); PG8_STAGE(PG8_SA(1, 0), a3, voffA0);
            PG8_WAIT_V(8); PG8_WAIT_L(0); PG8_BAR; PG8_MMA(1, 0, At, B0); PG8_MMA(1, 1, At, B1); PG8_BAR; PG8_SCHED;
            } else {
            PG8_LDB(B0, 0, 0); PG8_SCHED; PG8_LDA(At, 0, 0); PG8_STAGE(PG8_SA(1, 1), a1 + hstepA, voffA1);
            PG8_WAIT_L(8); PG8_BAR; PG8_WAIT_L(0); PG8_MMA(0, 0, At, B0); PG8_BAR; PG8_SCHED;
            PG8_LDB(B1, 0, 1); PG8_STAGE(PG8_SB(0, 0), b2, voffB);
            PG8_BAR; PG8_WAIT_L(0); PG8_MMA(0, 1, At, B1); PG8_BAR;
            PG8_LDA(At, 0, 1); PG8_STAGE(PG8_SA(0, 0), a2, voffA0);
            PG8_BAR; PG8_WAIT_L(0); PG8_MMA(1, 0, At, B0); PG8_BAR; PG8_SCHED;
            PG8_STAGE(PG8_SB(0, 1), b2 + hstep, voffB);
            PG8_WAIT_V(6); PG8_BAR; PG8_MMA(1, 1, At, B1); PG8_BAR;
            PG8_LDB(B0, 1, 0); PG8_SCHED; PG8_LDA(At, 1, 0); PG8_STAGE(PG8_SA(0, 1), a2 + hstepA, voffA1);
            PG8_WAIT_L(8); PG8_BAR; PG8_WAIT_L(0); PG8_MMA(0, 0, At, B0); PG8_BAR; PG8_SCHED;
            PG8_LDB(B1, 1, 1); PG8_STAGE(PG8_SB(1, 0), b3, voffB);
            PG8_BAR; PG8_WAIT_L(0); PG8_MMA(0, 1, At, B1); PG8_BAR;
            PG8_LDA(At, 1, 1); PG8_STAGE(PG8_SA(1, 0), a3, voffA0);
            PG8_BAR; PG8_WAIT_L(0); PG8_MMA(1, 0, At, B0); PG8_BAR; PG8_SCHED;
            PG8_STAGE(PG8_SB(1, 1), b3 + hstep, voffB);
            PG8_WAIT_V(6); PG8_BAR; PG8_MMA(1, 1, At, B1); PG8_BAR;
            }
        }
        if constexpr (ALIGN_EPI) { if (wr == 0) PG8_BAR; }
        if constexpr (!Epi::AFTER_DRAIN) { int l2_ = lane; asm volatile("" : "+v"(l2_)); E(acc, cur, wr, wc, l2_ & 15, l2_ >> 4); S.done(cur); }
        if (!has_next) break;
#pragma unroll
        for (int a = 0; a < 2; ++a)
#pragma unroll
            for (int b = 0; b < 2; ++b)
#pragma unroll
                for (int m = 0; m < 4; ++m)
#pragma unroll
                    for (int n = 0; n < 2; ++n) acc[a][b][m][n] = (f32x4){0.f, 0.f, 0.f, 0.f};
        cur = nxt; cA = nA; cB = nB; ++ui;
        if constexpr (ALIGN_EPI) { if (wr == 1) PG8_BAR; }
    }
    PG8_WAIT_V(0);
    if constexpr (!ALIGN_EPI) { if (wr == 0) PG8_BAR; }
    PG8_BAR;
    if constexpr (Epi::AFTER_DRAIN) { E.fused(acc, cur, wr, wc, fr, fq, lds, wid, lane); S.done(cur); }
#undef PG8_SA
#undef PG8_SB
#undef PG8_STAGE
#undef PG8_LDA
#undef PG8_LDB
#undef PG8_MMA
#undef PG8_WAIT_V
#undef PG8_WAIT_L
#undef PG8_BAR
#undef PG8_SCHED
}
}

#ifndef PG8_SP2
#define PG8_SP2 true
#endif
#ifndef PG8_ALIGN
#define PG8_ALIGN true
#endif
namespace pg8 {
template <bool NORM>
__device__ __forceinline__ void head_store(const f32x4 (&acc)[2][2][4][2], int row0, hbits* dst, int ldd, int col0, const float* gain, float scale, int fq,
                                           const float* __restrict__ cosT, const float* __restrict__ sinT) {
    f32x4 g[2][2];
    if (NORM) {
#pragma unroll
        for (int bj = 0; bj < 2; ++bj)
#pragma unroll
            for (int n = 0; n < 2; ++n) g[bj][n] = *(const f32x4*)(gain + 32 * bj + 8 * fq + 4 * n);
    }
    const hbits* cosH = (const hbits*)cosT; const hbits* sinH = (const hbits*)sinT;
#pragma unroll
    for (int ai = 0; ai < 2; ++ai) {
            u32x4 cr[4], sr[4];
#pragma unroll
            for (int mi = 0; mi < 4; ++mi) { const int pos = (row0 + ai * HALF + mi * 16) & (S - 1);
                cr[mi] = *(const u32x4*)(cosH + pos * 32 + 8 * fq); sr[mi] = *(const u32x4*)(sinH + pos * 32 + 8 * fq); }
#pragma unroll
            for (int mi = 0; mi < 4; ++mi) {
            const int m = mi;
            f32x4 cc[1][2], sn[1][2];
            { const u32x4 cw = cr[mi], sw = sr[mi]; const unsigned c0 = cw.x, c1 = cw.y, c2 = cw.z, c3 = cw.w, s0 = sw.x, s1 = sw.y, s2 = sw.z, s3 = sw.w;
              const h2v hc0 = __builtin_bit_cast(h2v, c0), hc1 = __builtin_bit_cast(h2v, c1), hc2 = __builtin_bit_cast(h2v, c2), hc3 = __builtin_bit_cast(h2v, c3);
              const h2v hs0 = __builtin_bit_cast(h2v, s0), hs1 = __builtin_bit_cast(h2v, s1), hs2 = __builtin_bit_cast(h2v, s2), hs3 = __builtin_bit_cast(h2v, s3);
              cc[0][0] = (f32x4){(float)hc0[0], (float)hc0[1], (float)hc1[0], (float)hc1[1]}; cc[0][1] = (f32x4){(float)hc2[0], (float)hc2[1], (float)hc3[0], (float)hc3[1]};
              sn[0][0] = (f32x4){(float)hs0[0], (float)hs0[1], (float)hs1[0], (float)hs1[1]}; sn[0][1] = (f32x4){(float)hs2[0], (float)hs2[1], (float)hs3[0], (float)hs3[1]}; }
            const int row = row0 + ai * HALF + m * 16;
            f32x4 v[2][2];
#pragma unroll
            for (int bj = 0; bj < 2; ++bj)
#pragma unroll
                for (int n = 0; n < 2; ++n) v[bj][n] = acc[ai][bj][m][n];
            if (NORM) {
                float ss = 0.f;
#pragma unroll
                for (int bj = 0; bj < 2; ++bj)
#pragma unroll
                    for (int n = 0; n < 2; ++n) ss += (v[bj][n][0] * v[bj][n][0] + v[bj][n][1] * v[bj][n][1]) + (v[bj][n][2] * v[bj][n][2] + v[bj][n][3] * v[bj][n][3]);
                ss += __shfl_xor(ss, 16); ss += __shfl_xor(ss, 32);
                const float r = rsqrtf(ss * (1.0f / 64.0f) + EPS);
#pragma unroll
                for (int bj = 0; bj < 2; ++bj)
#pragma unroll
                    for (int n = 0; n < 2; ++n) v[bj][n] = v[bj][n] * r * g[bj][n];
            }
            f32x4 olo[2], ohi[2];
#pragma unroll
            for (int n = 0; n < 2; ++n) {
                const f32x4 c = cc[0][n], s = sn[0][n];
                olo[n] = (v[0][n] * c - v[1][n] * s) * scale; ohi[n] = (v[1][n] * c + v[0][n] * s) * scale;
            }
            u32x4 w0, w1;
            w0.x = pkh(olo[0][0], olo[0][1]); w0.y = pkh(olo[0][2], olo[0][3]); w0.z = pkh(olo[1][0], olo[1][1]); w0.w = pkh(olo[1][2], olo[1][3]);
            w1.x = pkh(ohi[0][0], ohi[0][1]); w1.y = pkh(ohi[0][2], ohi[0][3]); w1.z = pkh(ohi[1][0], ohi[1][1]); w1.w = pkh(ohi[1][2], ohi[1][3]);
            hbits* p = dst + (size_t)row * ldd + col0;
            *(u32x4*)p = w0; *(u32x4*)(p + 32) = w1;
            }
        }
}
__device__ __forceinline__ void plain_store_h(const f32x4 (&acc)[2][2][4][2], int row0, hbits* dst, int ldd, int col0) {
#pragma unroll
    for (int ai = 0; ai < 2; ++ai)
#pragma unroll
        for (int m = 0; m < 4; ++m) {
            hbits* p = dst + (size_t)(row0 + ai * HALF + m * 16) * ldd + col0;
#pragma unroll
            for (int bj = 0; bj < 2; ++bj) {
                const f32x4 v0 = acc[ai][bj][m][0], v1 = acc[ai][bj][m][1];
                u32x4 w; w.x = pkh(v0[0], v0[1]); w.y = pkh(v0[2], v0[3]); w.z = pkh(v1[0], v1[1]); w.w = pkh(v1[2], v1[3]);
                *(u32x4*)(p + bj * HALF) = w;
            }
        }
}
struct EpiIn {
    static constexpr bool PERM = true, AFTER_DRAIN = false;
    hbits *U, *Qa, *Ka, *Va, *Qi, *Ki; float *WI, *KVraw;
    const float *cosT, *sinT, *qg, *kg, *kig;
    __device__ __forceinline__ void operator()(const f32x4 (&acc)[2][2][4][2], const Unit& u, int wr, int wc, int fr, int fq) const {
        const int pn = u.pn;
        if (u.pm >= 64) {
            const int row0 = (u.pm - 64) * BM + wr * 64 + fr, col0 = (pn - 11) * BM + wc * 32 + 8 * fq;
#pragma unroll
            for (int ai = 0; ai < 2; ++ai)
#pragma unroll
                for (int m = 0; m < 4; ++m) { float* p = KVraw + (size_t)(row0 + ai * HALF + m * 16) * 1024 + col0;
#pragma unroll
                    for (int bj = 0; bj < 2; ++bj) { *(f32x4*)(p + bj * HALF) = acc[ai][bj][m][0]; *(f32x4*)(p + bj * HALF + 4) = acc[ai][bj][m][1]; } }
            return;
        }
        const int row0 = u.pm * BM + wr * 64 + fr;
        if (pn < 2) { plain_store_h(acc, row0, U, 512, pn * BM + wc * 32 + 8 * fq); }
        else if (pn == 6 || pn == 7) { plain_store_h(acc, row0, Va, 512, (pn - 6) * BM + wc * 32 + 8 * fq); }
        else if (pn == 2 || pn == 3) { head_store<true>(acc, row0, Qa, 512, (4 * (pn & 1) + wc) * 64 + 8 * fq, qg, C2Q, fq, cosT, sinT); }
        else if (pn == 4 || pn == 5) { head_store<true>(acc, row0, Ka, 512, (4 * (pn & 1) + wc) * 64 + 8 * fq, kg, 1.0f, fq, cosT, sinT); }
        else if (pn == 8 || pn == 9) { head_store<false>(acc, row0, Qi, 512, (4 * (pn & 1) + wc) * 64 + 8 * fq, nullptr, 1.0f, fq, cosT, sinT); }
        else {
            if (wc == 0) head_store<true>(acc, row0, Ki, 64, 8 * fq, kig, 1.0f, fq, cosT, sinT);
            else if (wc == 1 && fq == 0) {
#pragma unroll
                for (int ai = 0; ai < 2; ++ai)
#pragma unroll
                    for (int m = 0; m < 4; ++m) { float* p = WI + (size_t)(row0 + ai * HALF + m * 16) * 8;
                        *(f32x4*)p = acc[ai][0][m][0] * IDX_SCALE; *(f32x4*)(p + 4) = acc[ai][0][m][1] * IDX_SCALE; }
            }
        }
    }
};
struct SchedIn {
    StaticOrder so; int G, c;
    __device__ void init(int G_, int c_) { so.init(M, 2816, G_, c_); G = G_; c = c_; }
    __device__ bool next(int i, Unit& u) const {
        if (so.next(i, u)) return true;
        const long L = (long)i * G + c - 704; if (L >= 16) return false;
        u.pm = 64 + (int)(L >> 2); u.pn = 11 + (int)(L & 3); return true;
    }
    __device__ __forceinline__ void a_ready(const Unit&) const {}
    __device__ __forceinline__ void done(const Unit&) const {}
};
template <bool RH, bool RS = false>
struct EpiRes {
    static constexpr bool PERM = true, AFTER_DRAIN = false;
    const void* resid; hbits* outh; float* ss; const float* rs;
    __device__ __forceinline__ void operator()(const f32x4 (&acc)[2][2][4][2], const Unit& u, int wr, int wc, int fr, int fq) const {
        static_assert(RH, "f16 residual only");
        const int row0 = u.pm * BM + wr * 64 + fr, col0 = u.pn * BM + wc * 64 + 8 * fq;
        u32x4 rv[2][4][2]; float rsv[2][4];
        if (RS) {
#pragma unroll
            for (int ai = 0; ai < 2; ++ai)
#pragma unroll
                for (int m = 0; m < 4; ++m) rsv[ai][m] = rs[row0 + ai * HALF + m * 16]; }
#pragma unroll
        for (int ai = 0; ai < 2; ++ai)
#pragma unroll
            for (int m = 0; m < 4; ++m) { const size_t off = (size_t)(row0 + ai * HALF + m * 16) * D + col0;
#pragma unroll
                for (int bj = 0; bj < 2; ++bj) rv[ai][m][bj] = *(const u32x4*)((const hbits*)resid + off + bj * 32); }
#pragma unroll
        for (int ai = 0; ai < 2; ++ai)
#pragma unroll
            for (int m = 0; m < 4; ++m) { int row = row0 + ai * HALF + m * 16; asm volatile("" : "+v"(row)); const size_t off = (size_t)row * D + col0; float q = 0.f;
                float rsc = 1.f;
                if (RS) rsc = rsv[ai][m];
#pragma unroll
                for (int bj = 0; bj < 2; ++bj) {
                    const u32x4 rw = rv[ai][m][bj]; const unsigned a = rw.x, b = rw.y, c = rw.z, d = rw.w;
                    const h2v h0 = __builtin_bit_cast(h2v, a), h1 = __builtin_bit_cast(h2v, b), h2 = __builtin_bit_cast(h2v, c), h3 = __builtin_bit_cast(h2v, d);
                    const f32x4 r0 = (f32x4){(float)h0[0], (float)h0[1], (float)h1[0], (float)h1[1]}, r1 = (f32x4){(float)h2[0], (float)h2[1], (float)h3[0], (float)h3[1]};
                    const f32x4 v0 = (RS ? r0 * rsc : r0) + acc[ai][bj][m][0], v1 = (RS ? r1 * rsc : r1) + acc[ai][bj][m][1];
                    u32x4 w; w.x = pkh(v0[0], v0[1]); w.y = pkh(v0[2], v0[3]); w.z = pkh(v1[0], v1[1]); w.w = pkh(v1[2], v1[3]);
                    *(u32x4*)(outh + off + bj * 32) = w;
                    q += (v0[0] * v0[0] + v0[1] * v0[1]) + (v0[2] * v0[2] + v0[3] * v0[3]) + (v1[0] * v1[0] + v1[1] * v1[1]) + (v1[2] * v1[2] + v1[3] * v1[3]);
                }
                q += __shfl_xor(q, 16); q += __shfl_xor(q, 32);
                if (fq == 0) ss[(size_t)row * 16 + u.pn * 4 + wc] = q; }
    }
};
struct EpiWq {
    static constexpr bool PERM = true, AFTER_DRAIN = false;
    const float* ss; hbits* out;
    __device__ __forceinline__ void operator()(const f32x4 (&acc)[2][2][4][2], const Unit& u, int wr, int wc, int fr, int fq) const {
        const int row0 = u.pm * BM + wr * 64 + fr, col0 = u.pn * BM + wc * 64 + 8 * fq;
        f32x4 pv[2][4];
#pragma unroll
        for (int ai = 0; ai < 2; ++ai)
#pragma unroll
            for (int m = 0; m < 4; ++m) pv[ai][m] = *(const f32x4*)(ss + (size_t)(row0 + ai * HALF + m * 16) * 16 + 4 * fq);
        __builtin_amdgcn_sched_barrier(0);
#pragma unroll
        for (int ai = 0; ai < 2; ++ai)
#pragma unroll
            for (int m = 0; m < 4; ++m) {
                const int row = row0 + ai * HALF + m * 16;
                float t = (pv[ai][m][0] + pv[ai][m][1]) + (pv[ai][m][2] + pv[ai][m][3]);
                t += __shfl_xor(t, 16); t += __shfl_xor(t, 32);
                const float r = rsqrtf(t * (1.0f / 1024.0f) + EPS);
                hbits* p = out + (size_t)row * 512 + col0;
#pragma unroll
                for (int bj = 0; bj < 2; ++bj) { const f32x4 v0 = acc[ai][bj][m][0] * r, v1 = acc[ai][bj][m][1] * r;
                    u32x4 w; w.x = pkh(v0[0], v0[1]); w.y = pkh(v0[2], v0[3]); w.z = pkh(v1[0], v1[1]); w.w = pkh(v1[2], v1[3]);
                    *(u32x4*)(p + bj * 32) = w; }
            }
    }
};

struct SchedTwo {
    Unit ua, ub; int n;
    __device__ bool next(int i, Unit& u) const { if (i >= n) return false; u = i ? ub : ua; return true; }
    __device__ __forceinline__ void a_ready(const Unit&) const {}
    __device__ __forceinline__ void done(const Unit&) const {}
};
struct SchedOne {
    Unit un;
    __device__ bool next(int i, Unit& u) const { if (i != 0) return false; u = un; return true; }
    __device__ __forceinline__ void a_ready(const Unit&) const {}
    __device__ __forceinline__ void done(const Unit&) const {}
};
struct EpiGU {
    static constexpr bool PERM = true, AFTER_DRAIN = false;
    hbits* HID; const float* gw; const float* grs; int nvalid, hidrow0; PG8_LAS float* lw;
    __device__ __forceinline__ void stage_rows(int tid_) const {
        if (tid_ < 256) { const bool ok = tid_ < nvalid; const int rc = ok ? tid_ : 0; const float w = gw[rc], r = grs[rc]; lw[tid_] = ok ? w : 0.f; lw[256 + tid_] = ok ? r : 0.f; } }
    __device__ __forceinline__ void operator()(const f32x4 (&acc)[2][2][4][2], const Unit& u, int wr, int wc, int fr, int fq) const {
#pragma unroll
        for (int ai = 0; ai < 2; ++ai) {
            float rr_[4], ww_[4];
#pragma unroll
            for (int i = 0; i < 4; ++i) { const int rl = wr * 64 + fr + ai * HALF + i * 16; ww_[i] = lw[rl]; rr_[i] = lw[256 + rl]; }
#pragma unroll
            for (int m = 0; m < 4; ++m) {
                const int rl = wr * 64 + fr + ai * HALF + m * 16;
                const float r = rr_[m], w = ww_[m];
                f32x4 h[2];
#pragma unroll
                for (int n = 0; n < 2; ++n) {
                    const f32x4 g = acc[ai][0][m][n] * r, uu = acc[ai][1][m][n] * r;
#pragma unroll
                    for (int j = 0; j < 4; ++j) { const float sg = g[j] * __builtin_amdgcn_rcpf(1.0f + __builtin_amdgcn_exp2f(-1.4426950408889634f * g[j])); h[n][j] = sg * uu[j] * w; }
                }
                u32x4 o; o.x = pkh(h[0][0], h[0][1]); o.y = pkh(h[0][2], h[0][3]); o.z = pkh(h[1][0], h[1][1]); o.w = pkh(h[1][2], h[1][3]);
                { hbits* hp_ = HID + (size_t)(hidrow0 + rl) * 256 + 128 * (u.pn & 1) + 32 * wc + 8 * fq;
                  asm volatile("global_store_dwordx4 %0, %1, off sc0 sc1\n\ts_nop 1" :: "v"(hp_), "v"(o) : "memory"); }
            }
        }
    }
};
struct MoeTab { const PG8_LAS int* TB; const PG8_LAS int* TC; int TT;
    __device__ __forceinline__ int expert_of(int tile) const { const bool le_ = TB[fx_lane() & 31] <= tile; return __popcll(__ballot(le_) & 0xffffffffull) - 1; } };
struct SchedList {
    const PG8_LAS int* UL; int n;
    __device__ bool next(int i, Unit& u) const { if (i >= n) return false; u.pm = __builtin_amdgcn_readfirstlane(UL[2 * i]); u.pn = __builtin_amdgcn_readfirstlane(UL[2 * i + 1]); return true; }
    __device__ __forceinline__ void a_ready(const Unit&) const {}
    __device__ __forceinline__ void done(const Unit&) const {}
};
struct EpiDown {
    static constexpr bool PERM = true, AFTER_DRAIN = false;
    MoeTab tab; const int* rlist; hbits* P; const PG8_LAS int* dl;
    __device__ __forceinline__ void operator()(const f32x4 (&acc)[2][2][4][2], const Unit& u, int wr, int wc, int fr, int fq) const {
        const int e = u.pn >> 2, cn = u.pn & 3, rt = u.pm - __builtin_amdgcn_readfirstlane(tab.TB[e]), nvalid = __builtin_amdgcn_readfirstlane(tab.TC[e]) - rt * 256;
        const int* gl = rlist + (size_t)e * M + rt * 256;
#pragma unroll
        for (int ai = 0; ai < 2; ++ai) {
            int ent_[4];
#pragma unroll
            for (int i = 0; i < 4; ++i) ent_[i] = dl[wr * 64 + fr + ai * HALF + i * 16];
#pragma unroll
            for (int m = 0; m < 4; ++m) {
                const int ent = ent_[m];
                if (ent >= 0) {
                    hbits* p = P + ((size_t)(ent & 1) * M + (ent >> 1)) * D + cn * BM + 64 * wc + 8 * fq;
#pragma unroll
                    for (int bj = 0; bj < 2; ++bj) { const f32x4 v0 = acc[ai][bj][m][0], v1 = acc[ai][bj][m][1];
                        u32x4 w; w.x = pkh(v0[0], v0[1]); w.y = pkh(v0[2], v0[3]); w.z = pkh(v1[0], v1[1]); w.w = pkh(v1[2], v1[3]);
                        __builtin_nontemporal_store(w, (u32x4*)(p + bj * 32)); }
                }
            }
        }
    }
};
}
namespace attn_body {
using bf16=unsigned short;
using bf16x8=__attribute__((ext_vector_type(8)))short;
using s16x4=__attribute__((ext_vector_type(4)))short;
using f32x16=__attribute__((ext_vector_type(16)))float;
using u32x4=__attribute__((ext_vector_type(4)))unsigned;
constexpr int BATCH=4,NHEAD=8,SEQ=4096,D=64,DM=NHEAD*D,OPITCH=1024,OCOL0=512;
constexpr int NW=8,QBLK=32,QB=QBLK*NW,KVBLK=64,NQB=SEQ/QB;
constexpr int ATTN_PITCH=DM, ATTN_UNIT_ROWS=QB;
__device__ __forceinline__ int crow(int r,int hi){return (r&3)+8*(r>>2)+4*hi;}
#define SBAR() __builtin_amdgcn_sched_barrier(0)
#define MFMA16H(a,b,c,x,y,z) __builtin_amdgcn_mfma_f32_32x32x16_f16(__builtin_bit_cast(h8v,(a)),__builtin_bit_cast(h8v,(b)),(c),0,0,0)
constexpr int NSLOT=3, SLOTB=8192;
constexpr int LDS_K=0, LDS_V=NSLOT*SLOTB, LDS_WS=2*NSLOT*SLOTB, LDS_OST=LDS_WS+NW*64*4, LDS_BYTES=LDS_OST+NW*4096;
constexpr float C2=0.125f*1.4426950408889634f;
__device__ __forceinline__ void glds16(const void*gsrc,unsigned lds_dst){unsigned keep;
  asm volatile("s_mov_b32 %0, m0\n\ts_mov_b32 m0, %2\n\ts_nop 0\n\tglobal_load_lds_dwordx4 %1, off\n\ts_mov_b32 m0, %0":"=&s"(keep):"v"(gsrc),"s"(lds_dst):"memory");}
__device__ __forceinline__ float max3f(float a,float b,float c){float r;asm("v_max3_f32 %0, %1, %2, %3":"=v"(r):"v"(a),"v"(b),"v"(c));return r;}
__device__ __forceinline__ float max2f(float a,float b){float r;asm("v_max_f32_e32 %0, %1, %2":"=v"(r):"v"(a),"v"(b));return r;}
__device__ __forceinline__ float fadd_s(float a,float b){float r;asm("v_add_f32_e32 %0, %1, %2":"=v"(r):"v"(a),"v"(b));return r;}
__device__ __forceinline__ float fsub_s(float a,float b){float r;asm("v_sub_f32_e32 %0, %1, %2":"=v"(r):"v"(a),"v"(b));return r;}
__device__ __forceinline__ unsigned cvtpk_s(float lo,float hi){return pkh(lo,hi);}
#define WAIT_BAR(N) asm volatile("s_waitcnt vmcnt(" #N ") lgkmcnt(0)\n\ts_barrier":::"memory")
#define WAIT_BARM(N,MK) asm volatile("s_waitcnt vmcnt(" #N ") lgkmcnt(0)\n\ts_barrier":"+v"(MK)::"memory")

__device__ __forceinline__ void qkt(f32x16&p0,f32x16&p1,const char*Kslot,const bf16x8*qr,const f32x16&negm,int r32,int hi){
  const char*kb=Kslot+hi*1024+r32*16;
  #pragma unroll
  for(int d0=0;d0<4;++d0){
    const bf16x8 b0=*reinterpret_cast<const bf16x8*>(kb+d0*2048);
    const bf16x8 b1=*reinterpret_cast<const bf16x8*>(kb+d0*2048+512);
    if(d0==0){p0=MFMA16H(b0,qr[0],negm,0,0,0);p1=MFMA16H(b1,qr[0],negm,0,0,0);}
    else{p0=MFMA16H(b0,qr[d0],p0,0,0,0);p1=MFMA16H(b1,qr[d0],p1,0,0,0);}}
}
typedef __attribute__((address_space(3))) const char* lds_cptr;
typedef short v4i16_t __attribute__((ext_vector_type(4)));
__device__ __forceinline__ void kload8(bf16x8*kf,lds_cptr kp){
  kf[0]=*(const __attribute__((address_space(3))) bf16x8*)(kp);      kf[1]=*(const __attribute__((address_space(3))) bf16x8*)(kp+512);
  kf[2]=*(const __attribute__((address_space(3))) bf16x8*)(kp+2048); kf[3]=*(const __attribute__((address_space(3))) bf16x8*)(kp+2560);
  kf[4]=*(const __attribute__((address_space(3))) bf16x8*)(kp+4096); kf[5]=*(const __attribute__((address_space(3))) bf16x8*)(kp+4608);
  kf[6]=*(const __attribute__((address_space(3))) bf16x8*)(kp+6144); kf[7]=*(const __attribute__((address_space(3))) bf16x8*)(kp+6656);
}
__device__ __forceinline__ void kload2(bf16x8*kf,lds_cptr kp,int j){ kf[2*j]=*(const __attribute__((address_space(3))) bf16x8*)(kp+j*2048); kf[2*j+1]=*(const __attribute__((address_space(3))) bf16x8*)(kp+j*2048+512); }
__device__ __forceinline__ s16x4 vtr(lds_cptr p){ return __builtin_bit_cast(s16x4,__builtin_amdgcn_ds_read_tr16_b64_v4i16((__attribute__((address_space(3))) v4i16_t*)p)); }
__device__ __forceinline__ float rowmax(const f32x16&p0,const f32x16&p1){
  float a=max3f(p0[0],p0[1],p1[0]),b=max3f(p0[2],p0[3],p1[1]);a=max3f(a,p1[2],p1[3]);
  #pragma unroll
  for(int r=4;r<16;r+=4){a=max3f(a,p0[r],p0[r+1]);b=max3f(b,p0[r+2],p0[r+3]);a=max3f(a,p1[r],p1[r+1]);b=max3f(b,p1[r+2],p1[r+3]);}
  const float m=max2f(a,b);
  auto rr=__builtin_amdgcn_permlane32_swap(__float_as_uint(m),__float_as_uint(m),false,false);
  return max2f(__uint_as_float(rr[0]),__uint_as_float(rr[1]));
}
__device__ __forceinline__ void pv(f32x16*o,int vb,bf16x8 pa0,bf16x8 pa1,bf16x8 pa2,bf16x8 pa3){
  #pragma unroll
  for(int d0=0;d0<2;++d0){s16x4 lo[4],hi[4];
    #pragma unroll
    for(int ks=0;ks<4;++ks){
      asm volatile("ds_read_b64_tr_b16 %0,%1 offset:%c2":"=&v"(lo[ks]):"v"(vb),"i"(d0*4096+ks*1024):"memory");
      asm volatile("ds_read_b64_tr_b16 %0,%1 offset:%c2":"=&v"(hi[ks]):"v"(vb),"i"(d0*4096+ks*1024+512):"memory");}
    asm volatile("s_waitcnt lgkmcnt(0)":::"memory");SBAR();
    #define PK(k) (bf16x8){lo[k][0],lo[k][1],lo[k][2],lo[k][3],hi[k][0],hi[k][1],hi[k][2],hi[k][3]}
    o[d0]=MFMA16H(pa0,PK(0),o[d0],0,0,0);
    o[d0]=MFMA16H(pa1,PK(1),o[d0],0,0,0);
    o[d0]=MFMA16H(pa2,PK(2),o[d0],0,0,0);
    o[d0]=MFMA16H(pa3,PK(3),o[d0],0,0,0);
    #undef PK
  }
}

__device__ __forceinline__ float msel(float x,int t){ const int xi=__builtin_bit_cast(int,x); return __builtin_bit_cast(float,__builtin_amdgcn_bitop3_b32(xi,(int)0xc76a6000,t,0xE4)); }
#ifndef ATTN_STORE16
#define ATTN_STORE16(p,v) __builtin_nontemporal_store((v),(u32x4*)(p))
#endif
__device__ __forceinline__ void attn_unit(int b,int h,int qb,const bf16*Q,const bf16*__restrict__ K,const bf16*__restrict__ V,bf16*O,const unsigned long long*__restrict__ MASK,float mref,char*shm,int wid){
  const int lane=fx_lane(),tid=wid*64+lane,r32=lane&31,hi=lane>>5; (void)tid;
  const long rowbase=(long)b*SEQ; const int q0=qb*QB;
  const bf16*Qw=Q+(rowbase+q0+wid*QBLK)*DM+h*D;
  const bf16*Kh=K+rowbase*DM+h*D,*Vh=V+rowbase*DM+h*D;
  const unsigned lds0=(unsigned)(uintptr_t)shm;
  float*wsf=(float*)(shm+LDS_WS)+wid*64;
  const bf16*ksrc=Kh+(long)lane*DM+wid*8;
  const bf16*vsrc=Vh+(long)(16*(wid&3)+(lane>>2))*DM+(wid>>2)*32+(lane&3)*8;
  const unsigned kdst=lds0+LDS_K+wid*1024, vdst=lds0+LDS_V+wid*1024;
  #define DMA_K(t,slot) glds16(ksrc+(long)(t)*KVBLK*DM,(unsigned)__builtin_amdgcn_readfirstlane(kdst+(slot)))
  #define DMA_V(t,slot) glds16(vsrc+(long)(t)*KVBLK*DM,(unsigned)__builtin_amdgcn_readfirstlane(vdst+(slot)))
  const int vb0=(int)(lds0+LDS_V)+((lane>>4)&1)*32+(lane&3)*8+(4*hi+((lane&15)>>2))*64;
  const char*Kbase=shm+LDS_K; bf16x8 kf[8];
  const lds_cptr shm3=(lds_cptr)shm; const lds_cptr kp0=shm3+LDS_K+hi*1024+r32*16; const lds_cptr vp0=shm3+LDS_V+((lane>>4)&1)*32+(lane&3)*8+(4*hi+((lane&15)>>2))*64;
  const int NT=(q0+QB)/KVBLK;
  const unsigned long long*mbase=MASK+((size_t)(rowbase+q0+wid*QBLK))*64; const unsigned mvoff=(unsigned)r32*512u; unsigned long long mkA,mkB;
  #define MLOAD(dst,t) dst=*(const unsigned long long*)((const char*)(mbase+(t))+mvoff)
  #define MPIN(x) asm volatile("":"+v"(x))
  const int sh4=4*hi; const int NEGI=(int)0xc76a6000;
  #define MAPPLY(C0,C1,MK) do{ const unsigned lo_=((unsigned)(MK))>>sh4, hi_=((unsigned)((MK)>>32))>>sh4; \
    _Pragma("unroll") for(int r=0;r<16;++r){ const int kb_=(r&3)+8*(r>>2); \
      const int t0_=__builtin_amdgcn_sbfe((int)lo_,kb_,1), t1_=__builtin_amdgcn_sbfe((int)hi_,kb_,1); \
      C0[r]=msel(C0[r],t0_); C1[r]=msel(C1[r],t1_); } }while(0)
  MLOAD(mkA,0);MLOAD(mkB,1);
  DMA_K(0,0);DMA_V(0,0);DMA_K(1,SLOTB);
  bf16x8 qr[4];
  #pragma unroll
  for(int d0=0;d0<4;++d0)qr[d0]=*reinterpret_cast<const bf16x8*>(&Qw[(long)r32*DM+d0*16+hi*8]);
  float l_reg=0.f;f32x16 o[2];o[0]=f32x16{};o[1]=f32x16{};const f32x16 negm=f32x16{};
  const int qrel=wid*QBLK+r32;
  f32x16 pA0,pA1,pB0,pB1;
  int sl_prev=0,sl_cur=0,sl_next=SLOTB;
  #define ROT() do{sl_prev=sl_cur;sl_cur=sl_next;sl_next=(sl_next==(NSLOT-1)*SLOTB)?0:sl_next+SLOTB;}while(0)
  DMA_K(2,2*SLOTB);
  WAIT_BAR(3);
  qkt(pA0,pA1,Kbase,qr,negm,r32,hi);asm volatile("s_nop 15\n\ts_nop 7":"+v"(pA0),"+v"(pA1));MAPPLY(pA0,pA1,mkA);
  _Pragma("unroll") for(int r=0;r<16;++r)pA0[r]=__builtin_amdgcn_exp2f(pA0[r]);
  _Pragma("unroll") for(int r=0;r<16;++r)pA1[r]=__builtin_amdgcn_exp2f(pA1[r]);
  WAIT_BAR(0);
  DMA_K(3,0);DMA_V(1,SLOTB);
  ROT();
  kload8(kf,kp0+sl_cur);
  WAIT_BAR(2);
  s16x4 vlo[8],vhi[8]; u32x4 pw0,pw1,pw2,pw3;
  #define PKW(P,B) cvtpk_s(P[B],P[B+1])
  #define PAF(k) __builtin_bit_cast(bf16x8,pw##k)
  #define VFR(i) (bf16x8){vlo[i][0],vlo[i][1],vlo[i][2],vlo[i][3],vhi[i][0],vhi[i][1],vhi[i][2],vhi[i][3]}
  #define PIN(x) asm volatile("":"+v"(x))
  #define MX3(a,b,c) __builtin_fmaxf(__builtin_fmaxf((a),(b)),(c))
  #define GAPA(MF,A0,A1,A2,A3,W0,W1,PW) do{ MF; sacc+=A0; sacc+=A1; sacc+=A2; sacc+=A3; PIN(sacc); W0; W1; PIN(PW); SBAR(); }while(0)
  #define EX(v) __builtin_amdgcn_exp2f(v)
  #define GAPB(MF,X,B) do{ MF; X[B]=EX(X[B]); X[B+1]=EX(X[B+1]); X[B+2]=EX(X[B+2]); X[B+3]=EX(X[B+3]); PIN(X); SBAR(); }while(0)
  #define VRD(i) do{ vlo[i]=vtr(vp_+(((i)>>2)*4096+((i)&3)*1024)); vhi[i]=vtr(vp_+(((i)>>2)*4096+((i)&3)*1024+512)); }while(0)
  #define KRD(G,j) do{ if(G){ kload2(kf,kp0+sl_next,j); SBAR(); } }while(0)
  #define STEP(C0,C1,P0,P1,t,GK,GV,GL,MKU,MKL) do{ SBAR(); \
    const lds_cptr vp_=vp0+sl_prev; \
    VRD(0); SBAR(); float sacc=(P0[0]+P0[1]); \
    GAPA(C0=MFMA16H(kf[0],qr[0],negm,0,0,0), P0[2],P0[3],P0[4],P0[5],     pw0[0]=PKW(P0,0), pw0[1]=PKW(P0,2), pw0); \
    VRD(4); SBAR(); GAPA(C1=MFMA16H(kf[1],qr[0],negm,0,0,0), P0[6],P0[7],P0[8],P0[9],     pw0[2]=PKW(P0,4), pw0[3]=PKW(P0,6), pw0); \
    VRD(1); SBAR(); GAPA(C0=MFMA16H(kf[2],qr[1],C0,0,0,0),   P0[10],P0[11],P0[12],P0[13], pw1[0]=PKW(P0,8), pw1[1]=PKW(P0,10), pw1); \
    VRD(5); SBAR(); GAPA(C1=MFMA16H(kf[3],qr[1],C1,0,0,0),   P0[14],P0[15],P1[0],P1[1],   pw1[2]=PKW(P0,12),pw1[3]=PKW(P0,14), pw1); \
    VRD(2); SBAR(); GAPA(C0=MFMA16H(kf[4],qr[2],C0,0,0,0),   P1[2],P1[3],P1[4],P1[5],     pw2[0]=PKW(P1,0), pw2[1]=PKW(P1,2), pw2); \
    VRD(6); SBAR(); GAPA(C1=MFMA16H(kf[5],qr[2],C1,0,0,0),   P1[6],P1[7],P1[8],P1[9],     pw2[2]=PKW(P1,4), pw2[3]=PKW(P1,6), pw2); \
    VRD(3); SBAR(); GAPA(C0=MFMA16H(kf[6],qr[3],C0,0,0,0),   P1[10],P1[11],P1[12],P1[13], pw3[0]=PKW(P1,8), pw3[1]=PKW(P1,10), pw3); \
    VRD(7); SBAR(); GAPA(C1=MFMA16H(kf[7],qr[3],C1,0,0,0),   P1[14],P1[15],0.f,0.f,       pw3[2]=PKW(P1,12),pw3[3]=PKW(P1,14), pw3); \
    l_reg+=sacc; MPIN(MKU); SBAR(); \
    if(GK){DMA_K((t)+3,sl_cur);} if(GV){DMA_V((t)+1,sl_next);} \
    MAPPLY(C0,C1,MKU); if(GL){MLOAD(MKL,(t)+1);} \
    SBAR(); \
    GAPB(o[0]=MFMA16H(PAF(0),VFR(0),o[0],0,0,0), C0,0); \
    GAPB(o[1]=MFMA16H(PAF(0),VFR(4),o[1],0,0,0), C0,4); \
    KRD(GL,0); GAPB(o[0]=MFMA16H(PAF(1),VFR(1),o[0],0,0,0), C0,8); \
    KRD(GL,1); GAPB(o[1]=MFMA16H(PAF(1),VFR(5),o[1],0,0,0), C0,12); \
    KRD(GL,2); GAPB(o[0]=MFMA16H(PAF(2),VFR(2),o[0],0,0,0), C1,0); \
    KRD(GL,3); GAPB(o[1]=MFMA16H(PAF(2),VFR(6),o[1],0,0,0), C1,4); \
    GAPB(o[0]=MFMA16H(PAF(3),VFR(3),o[0],0,0,0), C1,8); \
    GAPB(o[1]=MFMA16H(PAF(3),VFR(7),o[1],0,0,0), C1,12); \
    }while(0)
  int t=1;
  for(;t+5<NT;t+=2){
    STEP(pB0,pB1,pA0,pA1,t,true,true,true,mkB,mkA);     WAIT_BAR(2); ROT();
    STEP(pA0,pA1,pB0,pB1,t+1,true,true,true,mkA,mkB);   WAIT_BAR(2); ROT();
  }
  #define ENDW(tt,MK) do{ if((tt)+3<NT){WAIT_BAR(2);} else if((tt)+2<NT){WAIT_BAR(1);} else {WAIT_BAR(0);} }while(0)
  for(;t+1<NT;t+=2){
    STEP(pB0,pB1,pA0,pA1,t,(t+3<NT),(t+1<NT),(t+1<NT),mkB,mkA);       ENDW(t,mkA);   ROT();
    STEP(pA0,pA1,pB0,pB1,t+1,(t+4<NT),(t+2<NT),(t+2<NT),mkA,mkB);     ENDW(t+1,mkB); ROT();
  }
  STEP(pB0,pB1,pA0,pA1,NT-1,false,false,false,mkB,mkA);
  { float sacc=pB0[0]+pB0[1]; _Pragma("unroll") for(int r=2;r<16;++r)sacc+=pB0[r]; _Pragma("unroll") for(int r=0;r<16;++r)sacc+=pB1[r]; l_reg+=sacc;
    pw0=(u32x4){PKW(pB0,0),PKW(pB0,2),PKW(pB0,4),PKW(pB0,6)};pw1=(u32x4){PKW(pB0,8),PKW(pB0,10),PKW(pB0,12),PKW(pB0,14)};pw2=(u32x4){PKW(pB1,0),PKW(pB1,2),PKW(pB1,4),PKW(pB1,6)};pw3=(u32x4){PKW(pB1,8),PKW(pB1,10),PKW(pB1,12),PKW(pB1,14)};
    SBAR(); pv(o,vb0+sl_cur,PAF(0),PAF(1),PAF(2),PAF(3)); }
  #undef PKW
  #undef PAF
  #undef VFR
  #undef PIN
  #undef MX3
  #undef GAPA
  #undef GAPB
  #undef EX
  #undef VRD
  #undef KRD
  #undef STEP
  #undef ENDW
  int le_=lane; asm volatile("":"+v"(le_)); const int r32e=le_&31,hie=le_>>5;
  {auto rr=__builtin_amdgcn_permlane32_swap(__float_as_uint(l_reg),__float_as_uint(l_reg),false,false);l_reg=__uint_as_float(rr[0])+__uint_as_float(rr[1]);}
  if(hie==0)wsf[32+r32e]=l_reg;asm volatile("s_waitcnt lgkmcnt(0)":::"memory");
  float rli[16];
  #pragma unroll
  for(int r=0;r<16;++r)rli[r]=__builtin_amdgcn_rcpf(wsf[32+crow(r,hie)]);
  bf16*Ow=O+(rowbase+q0+wid*QBLK)*OPITCH+OCOL0+h*D;
  { bf16*stg=(bf16*)(shm+LDS_OST)+wid*2048;
    #pragma unroll
    for(int r=0;r<16;++r){const int orow=crow(r,hie);
      #pragma unroll
      for(int d0=0;d0<2;++d0)stg[orow*64+d0*32+r32e]=f2h(o[d0][r]*rli[r]);}
    asm volatile("s_waitcnt lgkmcnt(0)":::"memory");
    #pragma unroll
    for(int i=0;i<4;++i){const int row=i*8+(le_>>3),ch=le_&7; const u32x4 v=*(const u32x4*)(stg+row*64+ch*8); ATTN_STORE16(Ow+(long)row*OPITCH+ch*8,v);} }
  asm volatile("s_waitcnt lgkmcnt(0)\n\ts_barrier":::"memory");
  #undef DMA_K
  #undef DMA_V
  #undef MLOAD
  #undef MAPPLY
  #undef MPIN
  #undef ROT
}
constexpr int ATTN_LDS_BYTES=LDS_BYTES;
struct AttnTensors { const bf16* Q; const bf16* K; const bf16* V; bf16* O; const unsigned long long* MASK; float mref; };
struct AttnUnit { int bh; int qb; };
struct StaticOrder {
  int vcu;
  __device__ __forceinline__ explicit StaticOrder(int grid,int block):vcu((block%8)*(grid/8)+block/8){}
  __device__ __forceinline__ bool next(int i,AttnUnit&u)const{ if(i>=2)return false; const int s=vcu&7; u.bh=vcu>>3; u.qb=(i==0)?s:15-s; return true; }
  __device__ __forceinline__ void a_ready(const AttnUnit&)const{}
  __device__ __forceinline__ void done(const AttnUnit&)const{}
};
template<class Sched> __device__ __forceinline__ void attn_phase(char*lds,const AttnTensors&T,const Sched&S,int wid){
  AttnUnit u;
  for(int i=0;S.next(i,u);++i){ S.a_ready(u); attn_unit(u.bh/NHEAD,u.bh%NHEAD,u.qb,T.Q,T.K,T.V,T.O,T.MASK,T.mref,lds,wid); S.done(u); }
}
#undef SBAR
#undef WAIT_BAR
}
#define GAS __attribute__((address_space(1)))
#define LAS __attribute__((address_space(3)))
typedef unsigned short bf16;
typedef unsigned v4u __attribute__((ext_vector_type(4)));
typedef float f32x4 __attribute__((ext_vector_type(4)));
typedef short bf16x8 __attribute__((ext_vector_type(8)));
typedef GAS unsigned gu32;
typedef GAS unsigned long long gu64;
#define RLX_AGENT __ATOMIC_RELAXED, __HIP_MEMORY_SCOPE_AGENT
#define LDS_WAIT() asm volatile("s_waitcnt lgkmcnt(0)" ::: "memory")
#define VM_WAIT() asm volatile("s_waitcnt vmcnt(0)" ::: "memory")
__device__ __forceinline__ unsigned long long rt() { return __builtin_amdgcn_s_memrealtime(); }
__device__ __forceinline__ unsigned f2bf(float f) { unsigned u = __builtin_bit_cast(unsigned, f); return (u + 0x7fffu + ((u >> 16) & 1u)) >> 16; }
__device__ __forceinline__ unsigned pk2(float lo, float hi) { return f2bf(lo) | (f2bf(hi) << 16); }

#define XB_TMO      128
#define XB_XCNT(j)  (256  + 64 * (j))
#define XB_XSUB(j)  (1280 + 64 * (j))
#define XB_XGEN(j)  (2304 + 64 * (j))
#define XB_TOP      3328
#define XB_TOPGEN   3392
#define XCD_BAR_WORDS 3456
#define XB_SPIN_CAP (1u << 18)

__device__ __forceinline__ unsigned xb_ld(unsigned* p)              { return __hip_atomic_load(p, __ATOMIC_RELAXED, __HIP_MEMORY_SCOPE_AGENT); }
__device__ __forceinline__ unsigned xb_add(unsigned* p, unsigned v) { return __hip_atomic_fetch_add(p, v, __ATOMIC_RELAXED, __HIP_MEMORY_SCOPE_AGENT); }
__device__ __forceinline__ unsigned xb_xcc_id() { return (unsigned)__builtin_amdgcn_s_getreg((3 << 11) | 20) & 0xFu; }
#define XB_SPIN(cond, bar) do { unsigned _sp = 0; while (cond) { __builtin_amdgcn_s_sleep(1); \
    if ((++_sp & 255u) == 0u) { if (xb_ld(&(bar)[XB_TMO])) break; if (_sp > XB_SPIN_CAP) { atomicAdd(&(bar)[XB_TMO], 1u); break; } } } } while (0)

struct XcdBarrier {
    unsigned* bar; unsigned x;
    volatile LAS unsigned* st;
};

__device__ __forceinline__ XcdBarrier xcd_barrier_post(unsigned* bar, volatile LAS unsigned* st, bool t0) {
    XcdBarrier b; b.bar = bar; b.x = xb_xcc_id(); b.st = st;
    if (t0) (void)xb_add(&bar[XB_XCNT(b.x)], 1u);
    return b;
}
__device__ __forceinline__ void xcd_barrier_complete(unsigned* bar, unsigned x, volatile LAS unsigned* st) {
    const unsigned G = gridDim.x * gridDim.y * gridDim.z;
    const int l = fx_lane();
    unsigned c, sum, sp = 0u;
    for (;;) {
        c = (l < 16) ? xb_ld(&bar[XB_XCNT(l & 15)]) : 0u;
        sum = c;
#pragma unroll
        for (int o = 1; o < 16; o <<= 1) sum += (unsigned)__shfl_xor((int)sum, o);
        sum = (unsigned)__builtin_amdgcn_readfirstlane((int)sum);
        if (sum == G) break;
        __builtin_amdgcn_s_sleep(1);
        if ((++sp & 255u) == 0u) { if (xb_ld(&bar[XB_TMO])) break; if (sp > XB_SPIN_CAP) { if (l == 0) atomicAdd(&bar[XB_TMO], 1u); break; } }
    }
    const unsigned msk = (unsigned)(__ballot(c > 0u) & 0xffffull) | (1u << x);
    const unsigned mine = (unsigned)__builtin_amdgcn_readlane((int)c, (int)x);
    if (l == 0) { st[0] = mine > 0u ? mine : 1u; st[1] = msk; }
}

__device__ __forceinline__ void xcd_barrier(const XcdBarrier& b, bool t0, bool w0) {
    asm volatile("s_waitcnt vmcnt(0)" ::: "memory");
    __syncthreads();
    if (w0) {
        unsigned* bar = b.bar;
        __builtin_amdgcn_s_waitcnt(0);
        if (b.st[0] == 0u) { xcd_barrier_complete(bar, b.x, b.st); LDS_WAIT(); }
        const unsigned nloc = b.st[0], xmask = b.st[1];
        const int l = fx_lane();
        unsigned old = 0u;
        if (l == 0) old = __hip_atomic_fetch_add(&bar[XB_XSUB(b.x)], 1u, __ATOMIC_RELAXED, __HIP_MEMORY_SCOPE_WORKGROUP);
        old = (unsigned)__builtin_amdgcn_readfirstlane((int)old);
        const unsigned gen = old / nloc;
        if (old + 1u == (gen + 1u) * nloc) {
            __builtin_amdgcn_fence(__ATOMIC_RELEASE, "agent");
            asm volatile("s_waitcnt vmcnt(0)" ::: "memory");
            if (l == 0) xb_add(&bar[XB_XGEN(b.x)], 1u);
        }
        asm volatile("buffer_inv sc1" ::: "memory");
        { unsigned sp = 0u; const bool need = (l < 16) && (((xmask >> (l & 15)) & 1u) != 0u);
          for (;;) {
              const unsigned v = need ? xb_ld(&bar[XB_XGEN(l & 15)]) : 0xffffffffu;
              if (__ballot(need && !(v > gen)) == 0ull) break;
              __builtin_amdgcn_s_sleep(1);
              if ((++sp & 255u) == 0u) { if (xb_ld(&bar[XB_TMO])) break; if (sp > XB_SPIN_CAP) { if (l == 0) atomicAdd(&bar[XB_TMO], 1u); break; } }
          } }
        asm volatile("s_waitcnt vmcnt(0)" ::: "memory");
    }
    __syncthreads();
}

__device__ __forceinline__ void tile_handoff(unsigned* cnt, bool signal, bool wait, unsigned target, bool w0) {
    asm volatile("s_waitcnt vmcnt(0)" ::: "memory");
    __syncthreads();
    if (w0) {
        if (signal && fx_lane() == 0) (void)xb_add(cnt, 1u);
        if (wait) {
            asm volatile("buffer_inv sc1" ::: "memory");
            unsigned sp = 0u;
            for (;;) { const unsigned v = (unsigned)__builtin_amdgcn_readfirstlane((int)xb_ld(cnt)); if (v >= target) break; __builtin_amdgcn_s_sleep(1); if (++sp > (1u << 22)) break; }
            asm volatile("s_waitcnt vmcnt(0)" ::: "memory");
        }
    }
    if (wait) __syncthreads();
}
namespace sl {
__device__ __forceinline__ float wsum(float v) {
#pragma unroll
  for (int o = 32; o > 0; o >>= 1) v += __shfl_xor(v, o);
  return v;
}
__device__ __forceinline__ float wmax(float v) {
#pragma unroll
  for (int o = 32; o > 0; o >>= 1) v = fmaxf(v, __shfl_xor(v, o));
  return v;
}
__device__ __forceinline__ void pool_phase(LAS unsigned char* L, int bx, int G, int tid, const hbits* __restrict__ U, const float* __restrict__ pool_w, const float* __restrict__ pool_scale, hbits* __restrict__ Y) {
  const int sb = tid >> 8, t = tid & 255, tx = t & 15, ty = t >> 4;
  LAS float* As = (LAS float*)(L + sb * 16384);
  LAS float* Bs = As + 16 * 65;
  for (int kk_ = 0; kk_ < (256 * 4 * 2 + 2 * G - 1) / (2 * G); ++kk_) {
    const int it = bx * 2 + sb + kk_ * 2 * G; const bool live = it < 256 * 4 * 2;
    const int mb = (it >> 3), g = (it >> 1) & 3, nb = it & 1, m0 = mb * 64, n0 = nb * 64, w = 2 << g;
    float acc[4][4] = {};
    const int ar = t >> 2, ak = (t & 3) * 4, bk = t >> 4, bn = (t & 15) * 4;
    for (int k0 = 0; k0 < 128; k0 += 16) {
      if (live) {
#pragma unroll
        for (int i = 0; i < 4; ++i) { const int m = m0 + ar, c = g * 128 + k0 + ak + i, tt = m & (S - 1); const int cnt = (tt + 1 < w) ? (tt + 1) : w; float s = 0.f;
          for (int j = 0; j < cnt; ++j) s += h2f(U[(size_t)(m - j) * 512 + c]);
          As[(ak + i) * 65 + ar] = s / (float)cnt - h2f(U[(size_t)m * 512 + c]); }
#pragma unroll
        for (int i = 0; i < 4; ++i) Bs[bk * 65 + bn + i] = pool_w[((size_t)g * 128 + k0 + bk) * 128 + n0 + bn + i];
      }
      __syncthreads();
      if (live) {
#pragma unroll
        for (int k = 0; k < 16; ++k) { float a[4], b[4];
#pragma unroll
          for (int i = 0; i < 4; ++i) { a[i] = As[k * 65 + ty * 4 + i]; b[i] = Bs[k * 65 + tx * 4 + i]; }
#pragma unroll
          for (int i = 0; i < 4; ++i)
#pragma unroll
            for (int j = 0; j < 4; ++j) acc[i][j] = fmaf(a[i], b[j], acc[i][j]); }
      }
      __syncthreads();
    }
    if (live) {
#pragma unroll
      for (int i = 0; i < 4; ++i)
#pragma unroll
        for (int j = 0; j < 4; ++j) { const int d = n0 + tx * 4 + j; Y[(size_t)(m0 + ty * 4 + i) * 1024 + g * 128 + d] = f2h(acc[i][j] * pool_scale[g * 128 + d]); }
    }
  }
}
__device__ __forceinline__ void kmem_phase(int gw, int NGW, int lane, const float* __restrict__ KVraw, const float* __restrict__ kgain, hbits* __restrict__ Kmem, hbits* __restrict__ Vmem) {
  const float g0 = kgain[lane], g1 = kgain[lane + 64];
  for (int w = gw; w < MR * 4; w += 2 * NGW) {
    const int w2 = (w + NGW < MR * 4) ? w + NGW : w;
    const int rowa = w >> 2, ha = w & 3, rowb = w2 >> 2, hb = w2 & 3;
    const float* pa = KVraw + (size_t)rowa * 1024 + ha * 128; const float* pb = KVraw + (size_t)rowb * 1024 + hb * 128;
    const float a0 = pa[lane], a1 = pa[lane + 64], a2 = pa[512 + lane], a3 = pa[512 + lane + 64];
    const float b0 = pb[lane], b1 = pb[lane + 64], b2 = pb[512 + lane], b3 = pb[512 + lane + 64];
    const float ra = rsqrtf(wsum(a0 * a0 + a1 * a1) / 128.f + EPS), rb = rsqrtf(wsum(b0 * b0 + b1 * b1) / 128.f + EPS);
    { const int b = rowa >> 8, key = rowa & 255; hbits* ko = Kmem + (((size_t)b * 4 + ha) * 256 + key) * 128; hbits* vo = Vmem + (((size_t)b * 4 + ha) * 256 + key) * 128;
      ko[lane] = f2h(a0 * ra * g0); ko[lane + 64] = f2h(a1 * ra * g1); vo[lane] = f2h(a2); vo[lane + 64] = f2h(a3); }
    { const int b = rowb >> 8, key = rowb & 255; hbits* ko = Kmem + (((size_t)b * 4 + hb) * 256 + key) * 128; hbits* vo = Vmem + (((size_t)b * 4 + hb) * 256 + key) * 128;
      ko[lane] = f2h(b0 * rb * g0); ko[lane + 64] = f2h(b1 * rb * g1); vo[lane] = f2h(b2); vo[lane + 64] = f2h(b3); }
  }
}
__device__ __forceinline__ void indexer_phase(LAS unsigned char* L, int bx, int G, int tid, const hbits* __restrict__ QI, const hbits* __restrict__ KI, const float* __restrict__ WI, unsigned char* ws) {
  const int sb = tid >> 8, t = tid & 255, tx = t & 15, ty = t >> 4;
  LAS float* Qs = (LAS float*)(L + sb * 40960);
  LAS float* Ks = Qs + 64 * 65;
  constexpr int NT = 4 * 2080;
  for (int kk_ = 0; kk_ < (NT + 2 * G - 1) / (2 * G); ++kk_) {
    const int it = bx * 2 + sb + kk_ * 2 * G; const bool live = it < NT;
    int b = 0, qc = 0, kc = 0;
    if (live) { b = it / 2080; int r = it % 2080; qc = (int)((sqrtf(8.f * (float)r + 1.f) - 1.f) * 0.5f); while ((qc + 1) * (qc + 2) / 2 <= r) ++qc; while (qc * (qc + 1) / 2 > r) --qc; kc = r - qc * (qc + 1) / 2; }
    const size_t qrow0 = (size_t)b * S + qc * 64, krow0 = (size_t)b * S + kc * 64;
    __syncthreads();
    if (live) for (int i = t; i < 64 * 64; i += 256) { const int r = i >> 6, d = i & 63; Ks[r * 65 + d] = h2f(KI[(krow0 + r) * 64 + d]); }
    float acc[4][4] = {};
    for (int h = 0; h < 8; ++h) {
      __syncthreads();
      if (live) for (int i = t; i < 64 * 64; i += 256) { const int r = i >> 6, d = i & 63; Qs[r * 65 + d] = h2f(QI[(qrow0 + r) * 512 + h * 64 + d]); }
      __syncthreads();
      if (live) {
        float s[4][4] = {};
        for (int d = 0; d < 64; ++d) { float a[4], k[4];
#pragma unroll
          for (int i = 0; i < 4; ++i) { a[i] = Qs[(ty * 4 + i) * 65 + d]; k[i] = Ks[(tx * 4 + i) * 65 + d]; }
#pragma unroll
          for (int i = 0; i < 4; ++i)
#pragma unroll
            for (int j = 0; j < 4; ++j) s[i][j] = fmaf(a[i], k[j], s[i][j]); }
#pragma unroll
        for (int i = 0; i < 4; ++i) { const float w = WI[(qrow0 + ty * 4 + i) * 8 + h];
#pragma unroll
          for (int j = 0; j < 4; ++j) acc[i][j] += fmaxf(s[i][j], 0.f) * w; }
      }
    }
    if (live) {
      hbits* SC = (hbits*)sc_batch_ptr((unsigned char*)ws, (unsigned char*)ws, b) + (size_t)4096 * qc * (qc + 1) / 2;
#pragma unroll
      for (int i = 0; i < 4; ++i)
#pragma unroll
        for (int j = 0; j < 4; ++j) SC[(size_t)(ty * 4 + i) * 64 * (qc + 1) + kc * 64 + tx * 4 + j] = f2h(acc[i][j]);
    }
  }
}
__device__ __forceinline__ unsigned comp_key(hbits hb, int s) {
  unsigned u = hb; u = (u & 0x8000u) ? (~u & 0xffffu) : (u | 0x8000u);
  return (u << 12) | (unsigned)(4095 - s);
}
__device__ __forceinline__ void select_phase(int gw, int NGW, int lane, const unsigned char* __restrict__ ws, unsigned long long* __restrict__ MASK) {
  for (int rw = gw; rw < M; rw += NGW) {
    const int b = rw >> 12, t = rw & 4095, c = t >> 6, N = 64 * (c + 1), nj = c + 1;
    unsigned long long* mrow = MASK + (size_t)rw * 64;
    const hbits* row = (const hbits*)sc_batch_ptr((unsigned char*)ws, (unsigned char*)ws, b) + (size_t)4096 * c * (c + 1) / 2 + (size_t)(t & 63) * N;
    if (N <= 256) { mrow[lane] = (lane < nj) ? ~0ull : 0ull; continue; }
    unsigned T = 0;
    for (int bit = 27; bit >= 0; --bit) { const unsigned cand = T | (1u << bit); int cnt = 0;
      for (int j = 0; j < nj; ++j) { const unsigned k = comp_key(row[j * 64 + lane], j * 64 + lane); cnt += __popcll(__ballot(k >= cand)); }
      if (cnt >= 256) T = cand; }
    for (int j = 0; j < 64; ++j) { unsigned long long mk = 0;
      if (j < nj) { const unsigned k = comp_key(row[j * 64 + lane], j * 64 + lane); mk = __ballot(k >= T); }
      if (lane == 0) mrow[j] = mk; }
  }
}
__device__ __forceinline__ void dsa_phase(LAS unsigned char* L, int bx, int G, int tid, const hbits* __restrict__ Q, const hbits* __restrict__ K, const hbits* __restrict__ V,
                                          const unsigned long long* __restrict__ MASK, hbits* __restrict__ Y) {
  const int sb = tid >> 8, t = tid & 255, lane = t & 63, wid = t >> 6;
  LAS float* qs = (LAS float*)(L + sb * 16384);
  LAS int* list = (LAS int*)(qs + 512);
  LAS int* cnts = list + 256;
  LAS int* ntot = cnts + 64;
  LAS float* sc = (LAS float*)(ntot + 16);
  for (int kk_ = 0; kk_ < (M + 2 * G - 1) / (2 * G); ++kk_) { const int m = bx * 2 + sb + kk_ * 2 * G; if (m >= M) break;
    const int b = m / S;
    __syncthreads();
    qs[t] = h2f(Q[(size_t)m * 512 + t]); qs[t + 256] = h2f(Q[(size_t)m * 512 + t + 256]);
    unsigned long long word = 0;
    if (t < 64) { word = MASK[(size_t)m * 64 + t]; cnts[t] = __popcll(word); }
    __syncthreads();
    if (t < 64) { int off = 0; for (int j = 0; j < t; ++j) off += cnts[j];
      if (t == 63) ntot[0] = off + cnts[63];
      while (word) { const int bpos = __ffsll((long long)word) - 1; word &= word - 1; if (off < 256) list[off] = t * 64 + bpos; ++off; } }
    __syncthreads();
    const int n = ntot[0] < 256 ? ntot[0] : 256;
    if (t < n) { const hbits* kr = K + ((size_t)b * S + list[t]) * 512;
      for (int h = 0; h < 8; ++h) { float s = 0.f; for (int d = 0; d < 64; ++d) s = fmaf(qs[h * 64 + d], h2f(kr[h * 64 + d]), s); sc[h * 256 + t] = s; } }
    __syncthreads();
    for (int h = wid * 2; h < wid * 2 + 2; ++h) { float mx = -INFINITY;
      for (int k = lane; k < n; k += 64) mx = fmaxf(mx, sc[h * 256 + k]);
      mx = wmax(mx); float sm = 0.f;
      for (int k = lane; k < n; k += 64) { const float e = exp2f(sc[h * 256 + k] - mx); sc[h * 256 + k] = e; sm += e; }
      sm = wsum(sm); const float inv = 1.f / sm;
      for (int k = lane; k < n; k += 64) sc[h * 256 + k] *= inv; }
    __syncthreads();
    for (int col = t; col < 512; col += 256) { const int h = col >> 6; float acc = 0.f;
      for (int k = 0; k < n; ++k) acc = fmaf(sc[h * 256 + k], h2f(V[((size_t)b * S + list[k]) * 512 + col]), acc);
      Y[(size_t)m * 1024 + 512 + col] = f2h(acc); }
  }
}
__device__ __forceinline__ void xattn_phase(LAS unsigned char* L, int bx, int G, int tid, const hbits* __restrict__ Qm, const float* __restrict__ qgain, const hbits* __restrict__ Kmem, const hbits* __restrict__ Vmem, hbits* __restrict__ O) {
  const int sb = tid >> 8, t = tid & 255, lane = t & 63, wid = t >> 6;
  LAS float* qs = (LAS float*)(L + sb * 8192);
  LAS float* sc = qs + 512;
  for (int kk_ = 0; kk_ < (M + 2 * G - 1) / (2 * G); ++kk_) { const int m = bx * 2 + sb + kk_ * 2 * G; if (m >= M) break;
    const int b = m / S;
    __syncthreads();
    { const float v0 = h2f(Qm[(size_t)m * 512 + wid * 128 + lane]), v1 = h2f(Qm[(size_t)m * 512 + wid * 128 + 64 + lane]);
      const float r = rsqrtf(wsum(v0 * v0 + v1 * v1) / 128.f + EPS);
      qs[wid * 128 + lane] = v0 * r * qgain[lane]; qs[wid * 128 + 64 + lane] = v1 * r * qgain[lane + 64]; }
    __syncthreads();
    for (int h = 0; h < 4; ++h) { const hbits* kr = Kmem + (((size_t)b * 4 + h) * 256 + t) * 128; float s = 0.f;
      for (int d = 0; d < 128; ++d) s = fmaf(qs[h * 128 + d], h2f(kr[d]), s);
      sc[h * 256 + t] = s * 0.08838834764831845f; }
    __syncthreads();
    { const int h = wid; float mx = -INFINITY;
      for (int k = lane; k < 256; k += 64) mx = fmaxf(mx, sc[h * 256 + k]);
      mx = wmax(mx); float sm = 0.f;
      for (int k = lane; k < 256; k += 64) { const float e = expf(sc[h * 256 + k] - mx); sc[h * 256 + k] = e; sm += e; }
      sm = wsum(sm); const float inv = 1.f / sm;
      for (int k = lane; k < 256; k += 64) sc[h * 256 + k] *= inv; }
    __syncthreads();
    for (int col = t; col < 512; col += 256) { const int h = col >> 7, d = col & 127; float acc = 0.f;
      for (int k = 0; k < 256; ++k) acc = fmaf(sc[h * 256 + k], h2f(Vmem[(((size_t)b * 4 + h) * 256 + k) * 128 + d]), acc);
      O[(size_t)m * 512 + col] = f2h(acc); }
  }
}
}
namespace fx {
typedef float f32x16 __attribute__((ext_vector_type(16)));
typedef short s16x8 __attribute__((ext_vector_type(8)));
typedef unsigned u32x4v __attribute__((ext_vector_type(4)));
typedef unsigned u32x2v __attribute__((ext_vector_type(2)));
#define FX_MFMA(a, b, c) __builtin_amdgcn_mfma_f32_32x32x16_f16(__builtin_bit_cast(h8v, (a)), __builtin_bit_cast(h8v, (b)), (c), 0, 0, 0)
constexpr int IDX_Q_LDS = 65536, IDX_STG = 4608;
__device__ __forceinline__ void indexer_item(int b, int c, int t_lo, int t_hi, int tid, int lane, int wave, const hbits* __restrict__ Qi, const hbits* __restrict__ Ki, const float* __restrict__ WI,
                                             unsigned char* ws, unsigned char* outb, LAS unsigned char* L) {
    asm volatile("" : "+v"(tid), "+v"(lane));
    const int r32 = lane & 31, hi = lane >> 5, grp = wave >> 2, wq = wave & 3;
    __syncthreads();
#pragma unroll
    for (int i = 0; i < 8; ++i) { const int pc = i * 512 + tid, q64 = pc >> 6, within = pc & 63, h = within >> 3, d0 = (within >> 1) & 3, h8 = within & 1;
        const u32x4v v = *(const u32x4v*)(Qi + ((size_t)b * S + 64 * c + q64) * 512 + within * 8);
        *(LAS u32x4v*)(L + (q64 >> 5) * 32768 + ((h * 4 + d0) * 2 + h8) * 512 + (q64 & 31) * 16) = v; }
    const size_t qrow = (size_t)b * S + 64 * c + 32 * grp + r32;
    float w[8];
    { const f32x4 wa = *(const f32x4*)(WI + qrow * 8), wb = *(const f32x4*)(WI + qrow * 8 + 4);
      w[0] = wa[0]; w[1] = wa[1]; w[2] = wa[2]; w[3] = wa[3]; w[4] = wb[0]; w[5] = wb[1]; w[6] = wb[2]; w[7] = wb[3]; }
    __syncthreads();
    const LAS unsigned char* qb = L + grp * 32768 + hi * 512 + r32 * 16;
    LAS unsigned char* stg = L + IDX_Q_LDS + wave * IDX_STG;
    hbits* scg = (hbits*)sc_batch_ptr(ws, outb, b) + (size_t)4096 * c * (c + 1) / 2 + (size_t)(32 * grp) * 64 * (c + 1);
#pragma unroll 1
    for (int kt = t_lo + wq; kt < t_hi; kt += 4) {
        const hbits* kbase = Ki + ((size_t)b * S + 64 * kt + r32) * 64 + hi * 8;
        s16x8 k0[4], k1[4];
#pragma unroll
        for (int d0 = 0; d0 < 4; ++d0) { k0[d0] = *(const s16x8*)(kbase + d0 * 16); k1[d0] = *(const s16x8*)(kbase + 32 * 64 + d0 * 16); }
#pragma unroll
        for (int half = 0; half < 2; ++half) {
            f32x16 sc = f32x16{}, aA = f32x16{}, aB = f32x16{};
#pragma unroll
            for (int d0 = 0; d0 < 4; ++d0) { const s16x8 qv = *(const LAS s16x8*)(qb + d0 * 1024); aA = FX_MFMA(half ? k1[d0] : k0[d0], qv, aA); }
#pragma unroll
            for (int h = 0; h < 8; ++h) {
                if (h < 7) {
                    if (h & 1) { aA = f32x16{};
#pragma unroll
                        for (int d0 = 0; d0 < 4; ++d0) { const s16x8 qv = *(const LAS s16x8*)(qb + ((h + 1) * 4 + d0) * 1024); aA = FX_MFMA(half ? k1[d0] : k0[d0], qv, aA); } }
                    else { aB = f32x16{};
#pragma unroll
                        for (int d0 = 0; d0 < 4; ++d0) { const s16x8 qv = *(const LAS s16x8*)(qb + ((h + 1) * 4 + d0) * 1024); aB = FX_MFMA(half ? k1[d0] : k0[d0], qv, aB); } }
                }
                if (h & 1) {
#pragma unroll
                    for (int rr = 0; rr < 16; ++rr) sc[rr] = fmaf(__builtin_amdgcn_fmed3f(aB[rr], 0.f, 3.0e38f), w[h], sc[rr]);
                } else {
#pragma unroll
                    for (int rr = 0; rr < 16; ++rr) sc[rr] = fmaf(__builtin_amdgcn_fmed3f(aA[rr], 0.f, 3.0e38f), w[h], sc[rr]);
                }
                asm volatile("" : "+v"(sc));
                __builtin_amdgcn_sched_barrier(0);
            }
#pragma unroll
            for (int g4 = 0; g4 < 4; ++g4) { u32x2v o; o.x = pkh(sc[4 * g4], sc[4 * g4 + 1]); o.y = pkh(sc[4 * g4 + 2], sc[4 * g4 + 3]);
                *(LAS u32x2v*)(stg + r32 * 144 + (32 * half + 8 * g4 + 4 * hi) * 2) = o; }
        }
        LDS_WAIT(); asm volatile("" ::: "memory");
        int l2 = lane; asm volatile("" : "+v"(l2));
#pragma unroll
        for (int i = 0; i < 4; ++i) { const int row = i * 8 + (l2 >> 3), ch = l2 & 7;
            const u32x4v v = *(const LAS u32x4v*)(stg + row * 144 + ch * 16);
            __builtin_nontemporal_store(v, (u32x4v*)(scg + (size_t)row * 64 * (c + 1) + 64 * kt + ch * 8)); }
        LDS_WAIT(); asm volatile("" ::: "memory");
    }
}
__device__ __forceinline__ void indexer_item_h(int b, int c, int gq, int tid, int lane, int wave, const hbits* __restrict__ Qi, const hbits* __restrict__ Ki, const float* __restrict__ WI,
                                             unsigned char* ws, unsigned char* outb, LAS unsigned char* L) {
    asm volatile("" : "+v"(tid), "+v"(lane));
    const int r32 = lane & 31, hi = lane >> 5;
    __syncthreads();
    { u32x4v qst_[4];
#pragma unroll
      for (int i = 0; i < 4; ++i) { const int pc = i * 512 + tid, q32 = pc >> 6, within = pc & 63; qst_[i] = *(const u32x4v*)(Qi + ((size_t)b * S + 64 * c + 32 * gq + q32) * 512 + within * 8); }
      __builtin_amdgcn_sched_barrier(0);
#pragma unroll
      for (int i = 0; i < 4; ++i) { const int pc = i * 512 + tid, q32 = pc >> 6, within = pc & 63, h = within >> 3, d0 = (within >> 1) & 3, h8 = within & 1;
        *(LAS u32x4v*)(L + ((h * 4 + d0) * 2 + h8) * 512 + q32 * 16) = qst_[i]; } }
    const size_t qrow = (size_t)b * S + 64 * c + 32 * gq + r32;
    float w[8];
    { const f32x4 wa = *(const f32x4*)(WI + qrow * 8), wb = *(const f32x4*)(WI + qrow * 8 + 4);
      w[0] = wa[0]; w[1] = wa[1]; w[2] = wa[2]; w[3] = wa[3]; w[4] = wb[0]; w[5] = wb[1]; w[6] = wb[2]; w[7] = wb[3]; }
    __syncthreads();
    const LAS unsigned char* qb = L + hi * 512 + r32 * 16;
    LAS unsigned char* stg = L + IDX_Q_LDS + wave * IDX_STG;
    hbits* scg = (hbits*)sc_batch_ptr(ws, outb, b) + (size_t)4096 * c * (c + 1) / 2 + (size_t)(32 * gq) * 64 * (c + 1);
#pragma unroll 1
    for (int kt = wave; kt <= c; kt += 8) {
        const hbits* kbase = Ki + ((size_t)b * S + 64 * kt + r32) * 64 + hi * 8;
        s16x8 k0[4], k1[4];
#pragma unroll
        for (int d0 = 0; d0 < 4; ++d0) { k0[d0] = *(const s16x8*)(kbase + d0 * 16); k1[d0] = *(const s16x8*)(kbase + 32 * 64 + d0 * 16); }
#pragma unroll
        for (int half = 0; half < 2; ++half) {
            f32x16 sc = f32x16{}, aA = f32x16{}, aB = f32x16{};
#pragma unroll
            for (int d0 = 0; d0 < 4; ++d0) { const s16x8 qv = *(const LAS s16x8*)(qb + d0 * 1024); aA = FX_MFMA(half ? k1[d0] : k0[d0], qv, aA); }
#pragma unroll
            for (int h = 0; h < 8; ++h) {
                if (h < 7) {
                    if (h & 1) { aA = f32x16{};
#pragma unroll
                        for (int d0 = 0; d0 < 4; ++d0) { const s16x8 qv = *(const LAS s16x8*)(qb + ((h + 1) * 4 + d0) * 1024); aA = FX_MFMA(half ? k1[d0] : k0[d0], qv, aA); } }
                    else { aB = f32x16{};
#pragma unroll
                        for (int d0 = 0; d0 < 4; ++d0) { const s16x8 qv = *(const LAS s16x8*)(qb + ((h + 1) * 4 + d0) * 1024); aB = FX_MFMA(half ? k1[d0] : k0[d0], qv, aB); } }
                }
                if (h & 1) {
#pragma unroll
                    for (int rr = 0; rr < 16; ++rr) sc[rr] = fmaf(__builtin_amdgcn_fmed3f(aB[rr], 0.f, 3.0e38f), w[h], sc[rr]);
                } else {
#pragma unroll
                    for (int rr = 0; rr < 16; ++rr) sc[rr] = fmaf(__builtin_amdgcn_fmed3f(aA[rr], 0.f, 3.0e38f), w[h], sc[rr]);
                }
                asm volatile("" : "+v"(sc));
                __builtin_amdgcn_sched_barrier(0);
            }
#pragma unroll
            for (int g4 = 0; g4 < 4; ++g4) { u32x2v o; o.x = pkh(sc[4 * g4], sc[4 * g4 + 1]); o.y = pkh(sc[4 * g4 + 2], sc[4 * g4 + 3]);
                *(LAS u32x2v*)(stg + r32 * 144 + (32 * half + 8 * g4 + 4 * hi) * 2) = o; }
        }
        LDS_WAIT(); asm volatile("" ::: "memory");
        int l2 = lane; asm volatile("" : "+v"(l2));
#pragma unroll
        for (int i = 0; i < 4; ++i) { const int row = i * 8 + (l2 >> 3), ch = l2 & 7;
            const u32x4v v = *(const LAS u32x4v*)(stg + row * 144 + ch * 16);
            *(u32x4v*)(scg + (size_t)row * 64 * (c + 1) + 64 * kt + ch * 8) = v; }
        LDS_WAIT(); asm volatile("" ::: "memory");
    }
}
__device__ __forceinline__ void indexer_phase(int bx, int G, int tid, int lane, int wave, const hbits* __restrict__ Qi, const hbits* __restrict__ Ki, const float* __restrict__ WI, unsigned char* ws, unsigned char* outb, LAS unsigned char* L) {
    for (int it = bx; it < 256; it += G) {
        const int b = it >> 6, j = it & 63;
#pragma unroll 1
        for (int part = 0; part < 2; ++part) {
            const int c = part ? 63 - j : j, t_lo = part ? (65 - j) >> 1 : 0, t_hi = part ? 64 - j : (j + 2) >> 1;
            indexer_item(b, c, t_lo, t_hi, tid, lane, wave, Qi, Ki, WI, ws, outb, L);
        }
    }
}

typedef short s16x2 __attribute__((ext_vector_type(2)));
typedef unsigned short u16x2 __attribute__((ext_vector_type(2)));
__device__ __forceinline__ int wave_isum(int v) {
    v += __builtin_amdgcn_update_dpp(0, v, 0xB1, 0xf, 0xf, false);
    v += __builtin_amdgcn_update_dpp(0, v, 0x4E, 0xf, 0xf, false);
    v += __builtin_amdgcn_update_dpp(0, v, 0x141, 0xf, 0xf, false);
    v += __builtin_amdgcn_update_dpp(0, v, 0x140, 0xf, 0xf, false);
    v += __builtin_amdgcn_update_dpp(0, v, 0x142, 0xa, 0xf, false);
    v += __builtin_amdgcn_update_dpp(0, v, 0x143, 0xc, 0xf, false);
    return __builtin_amdgcn_readlane(v, 63);
}
__device__ __forceinline__ unsigned cnt_lt(const unsigned (&kv)[8][4], int nj8, int T) {
    const s16x2 tp = {(short)T, (short)T}; u16x2 c = {0, 0};
#pragma unroll
    for (int j = 0; j < 8; ++j) if (j < nj8) {
#pragma unroll
        for (int v = 0; v < 4; ++v) { const unsigned kk = kv[j][v]; const s16x2 d = __builtin_elementwise_sub_sat(__builtin_bit_cast(s16x2, kk), tp);
            c += __builtin_bit_cast(u16x2, d) >> (unsigned short)15; } }
    const unsigned cc = __builtin_bit_cast(unsigned, c);
    return ((cc & 0xffffu) + (cc >> 16)) << 15;
}
__device__ __forceinline__ int wave_iscan(int x) {
    x += __builtin_amdgcn_update_dpp(0, x, 0x111, 0xf, 0xf, false);
    x += __builtin_amdgcn_update_dpp(0, x, 0x112, 0xf, 0xf, false);
    x += __builtin_amdgcn_update_dpp(0, x, 0x114, 0xf, 0xf, false);
    x += __builtin_amdgcn_update_dpp(0, x, 0x118, 0xf, 0xf, false);
    x += __builtin_amdgcn_update_dpp(0, x, 0x142, 0xa, 0xf, false);
    x += __builtin_amdgcn_update_dpp(0, x, 0x143, 0xc, 0xf, false);
    return x;
}
__device__ __forceinline__ void find_bucket(const LAS unsigned* H, int lane, int tgt, int& B, int& above, int& cnt) {
    const int base = 252 - 4 * lane;
    const u32x4v c = *(const LAS u32x4v*)(H + base);
    const int c0 = (int)c.x, c1 = (int)c.y, c2 = (int)c.z, c3 = (int)c.w, s4 = (c0 + c1) + (c2 + c3);
    const int P = wave_iscan(s4), A = P - s4;
    const bool hit = (A < tgt) && (tgt <= P);
    int b = base, ab = A + c3 + c2 + c1, ct = c0;
    if (A + c3 >= tgt) { b = base + 3; ab = A; ct = c3; }
    else if (A + c3 + c2 >= tgt) { b = base + 2; ab = A + c3; ct = c2; }
    else if (A + c3 + c2 + c1 >= tgt) { b = base + 1; ab = A + c3 + c2; ct = c1; }
    const unsigned long long hm = __ballot(hit);
    const int sl = hm ? (__ffsll((long long)hm) - 1) : 0;
    B = __builtin_amdgcn_readlane(b, sl); above = __builtin_amdgcn_readlane(ab, sl); cnt = __builtin_amdgcn_readlane(ct, sl);
}
__device__ __forceinline__ void find_bucket4(const LAS unsigned* H, int lane, int tgt, int& B, int& above, int& cnt) {
    const int base = 252 - 4 * lane;
    const u32x4v q0 = *(const LAS u32x4v*)(H + 4 * base), q1 = *(const LAS u32x4v*)(H + 4 * base + 4), q2 = *(const LAS u32x4v*)(H + 4 * base + 8), q3 = *(const LAS u32x4v*)(H + 4 * base + 12);
    const int c0 = (int)((q0.x + q0.y) + (q0.z + q0.w)), c1 = (int)((q1.x + q1.y) + (q1.z + q1.w)), c2 = (int)((q2.x + q2.y) + (q2.z + q2.w)), c3 = (int)((q3.x + q3.y) + (q3.z + q3.w)), s4 = (c0 + c1) + (c2 + c3);
    const int P = wave_iscan(s4), A = P - s4;
    const bool hit = (A < tgt) && (tgt <= P);
    int b = base, ab = A + c3 + c2 + c1, ct = c0;
    if (A + c3 >= tgt) { b = base + 3; ab = A; ct = c3; }
    else if (A + c3 + c2 >= tgt) { b = base + 2; ab = A + c3; ct = c2; }
    else if (A + c3 + c2 + c1 >= tgt) { b = base + 1; ab = A + c3 + c2; ct = c1; }
    const unsigned long long hm = __ballot(hit);
    const int sl = hm ? (__ffsll((long long)hm) - 1) : 0;
    B = __builtin_amdgcn_readlane(b, sl); above = __builtin_amdgcn_readlane(ab, sl); cnt = __builtin_amdgcn_readlane(ct, sl);
}
__device__ __forceinline__ void select_load(int b, int t, int lane, const unsigned char* __restrict__ ws, const unsigned char* __restrict__ outb, u32x4v (&raw)[8]) {
    const int c = t >> 6, N = 64 * (c + 1);
    const hbits* row = (const hbits*)sc_batch_ptr((unsigned char*)ws, (unsigned char*)outb, b) + (size_t)4096 * c * (c + 1) / 2 + (size_t)(t & 63) * N;
#pragma unroll
    for (int j = 0; j < 8; ++j) { const int off = j * 512 + lane * 8; raw[j] = __builtin_nontemporal_load((const u32x4v*)(row + (off < N ? off : 0))); }
}
__device__ __forceinline__ void select_rows2(int b0, int t, int b1, int t1, int lane, u32x4v (&raw)[2][8], unsigned char* __restrict__ MASKB, LAS unsigned* H) {
    const int c = t >> 6, N = 64 * (c + 1), nj8 = (N + 511) >> 9;
    unsigned char* mrow[2] = {MASKB + ((size_t)b0 * S + t) * 512, MASKB + ((size_t)b1 * S + t1) * 512};
    if (N <= 256) { const unsigned char v = (8 * lane < N) ? 0xff : 0x00; mrow[0][lane] = v; mrow[1][lane] = v; return; }
#define kv_(r, j, v) raw[r][j][v]
#pragma unroll
    for (int j = 0; j < 8; ++j) {
        const bool ok = (j * 512 + lane * 8 < N);
#pragma unroll
        for (int r = 0; r < 2; ++r) {
            const unsigned ux = raw[r][j].x, uy = raw[r][j].y, uz = raw[r][j].z, uw = raw[r][j].w;
            const s16x2 sx = __builtin_bit_cast(s16x2, ux), sy = __builtin_bit_cast(s16x2, uy), sz = __builtin_bit_cast(s16x2, uz), sw = __builtin_bit_cast(s16x2, uw);
            const s16x2 kx = sx ^ ((sx >> (short)15) & (short)0x7fff), ky = sy ^ ((sy >> (short)15) & (short)0x7fff), kz = sz ^ ((sz >> (short)15) & (short)0x7fff), kw = sw ^ ((sw >> (short)15) & (short)0x7fff);
            u32x4v kq; kq.x = ok ? __builtin_bit_cast(unsigned, kx) : 0x80008000u; kq.y = ok ? __builtin_bit_cast(unsigned, ky) : 0x80008000u;
            kq.z = ok ? __builtin_bit_cast(unsigned, kz) : 0x80008000u; kq.w = ok ? __builtin_bit_cast(unsigned, kw) : 0x80008000u; raw[r][j] = kq;
        }
    }
    { const u32x4v z = {0u, 0u, 0u, 0u};
#pragma unroll
      for (int q = 0; q < 10; ++q) *(LAS u32x4v*)(H + 256 * q + 4 * lane) = z; }
    LDS_WAIT(); asm volatile("" ::: "memory");
#pragma unroll
    for (int j = 0; j < 8; ++j) if (j < nj8) {
#pragma unroll
        for (int v = 0; v < 4; ++v)
#pragma unroll
            for (int r = 0; r < 2; ++r) { const unsigned ku = kv_(r, j, v) ^ 0x80008000u; LAS unsigned* H1 = H + 1280 * r + (lane & 3);
                __hip_atomic_fetch_add(H1 + ((ku >> 6) & 0x3fcu), 1u, __ATOMIC_RELAXED, __HIP_MEMORY_SCOPE_WORKGROUP);
                __hip_atomic_fetch_add(H1 + ((ku >> 22) & 0x3fcu), 1u, __ATOMIC_RELAXED, __HIP_MEMORY_SCOPE_WORKGROUP); } }
    LDS_WAIT(); asm volatile("" ::: "memory");
    int B1[2], above1[2], cnt1[2];
#pragma unroll
    for (int r = 0; r < 2; ++r) find_bucket4(H + 1280 * r, lane, 256, B1[r], above1[r], cnt1[r]);
#pragma unroll
    for (int j = 0; j < 8; ++j) if (j < nj8) {
#pragma unroll
        for (int v = 0; v < 4; ++v)
#pragma unroll
            for (int r = 0; r < 2; ++r) { const unsigned ku = kv_(r, j, v) ^ 0x80008000u; LAS unsigned* H2 = H + 1280 * r + 1024;
                if (((ku >> 8) & 0xffu) == (unsigned)B1[r]) __hip_atomic_fetch_add(H2 + (ku & 0xffu), 1u, __ATOMIC_RELAXED, __HIP_MEMORY_SCOPE_WORKGROUP);
                if ((ku >> 24) == (unsigned)B1[r]) __hip_atomic_fetch_add(H2 + ((ku >> 16) & 0xffu), 1u, __ATOMIC_RELAXED, __HIP_MEMORY_SCOPE_WORKGROUP); } }
    LDS_WAIT(); asm volatile("" ::: "memory");
    int T[2], cgt[2], cge[2], need[2];
#pragma unroll
    for (int r = 0; r < 2; ++r) { int B2, above2, cnt2; find_bucket(H + 1280 * r + 1024, lane, 256 - above1[r], B2, above2, cnt2);
        T[r] = ((B1[r] << 8) | B2) - 32768;
        cgt[r] = above1[r] + above2; cge[r] = cgt[r] + cnt2; need[r] = 256 - cgt[r]; }
    if (cge[0] - cgt[0] == need[0] && cge[1] - cgt[1] == need[1]) {
#pragma unroll
        for (int j = 0; j < 8; ++j) if (j < nj8) {
#pragma unroll
            for (int r = 0; r < 2; ++r) { const s16x2 tp = {(short)T[r], (short)T[r]}; unsigned sel8 = 0u;
#pragma unroll
                for (int v = 0; v < 4; ++v) { const unsigned kk = kv_(r, j, v); const unsigned dl = ~__builtin_bit_cast(unsigned, __builtin_elementwise_sub_sat(__builtin_bit_cast(s16x2, kk), tp));
                    sel8 |= (((dl >> 15) & 1u) | ((dl >> 30) & 2u)) << (2 * v); }
                mrow[r][j * 64 + lane] = (unsigned char)sel8; } }
        return;
    }
#pragma unroll 1
    for (int r = 0; r < 2; ++r) {
        const s16x2 tp = {(short)T[r], (short)T[r]};
        int base = 0;
#pragma unroll
        for (int j = 0; j < 8; ++j) if (j < nj8) {
            unsigned gtb = 0u, eqb = 0u;
#pragma unroll
            for (int v = 0; v < 4; ++v) { const unsigned kk = (r ? kv_(1, j, v) : kv_(0, j, v)); const s16x2 ks = __builtin_bit_cast(s16x2, kk);
                const unsigned dg = __builtin_bit_cast(unsigned, __builtin_elementwise_sub_sat(tp, ks));
                const unsigned dl = __builtin_bit_cast(unsigned, __builtin_elementwise_sub_sat(ks, tp));
                const unsigned g2 = ((dg >> 15) & 1u) | ((dg >> 30) & 2u), l2 = ((dl >> 15) & 1u) | ((dl >> 30) & 2u);
                gtb |= g2 << (2 * v); eqb |= ((~(g2 | l2)) & 3u) << (2 * v); }
            const int ce = __popc(eqb);
            const int inc = wave_iscan(ce);
            const int tot = __builtin_amdgcn_readlane(inc, 63);
            int allow = (r ? need[1] : need[0]) - base - (inc - ce); allow = allow < 0 ? 0 : allow;
            unsigned sel = 0u;
            if (allow >= ce) sel = eqb;
            else {
#pragma unroll
                for (int e = 0; e < 8; ++e) { if ((eqb >> e) & 1u) { if (allow > 0) { sel |= 1u << e; --allow; } } }
            }
            (r ? mrow[1] : mrow[0])[j * 64 + lane] = (unsigned char)(gtb | sel);
            base += tot;
        }
    }
}
#undef kv_
__device__ __forceinline__ void select_load2(int b0, int t, int lane, const unsigned char* __restrict__ ws, const unsigned char* __restrict__ outb, u32x4v (&raw)[2][8], int b1 = -1, int t1 = -1) {
    select_load(b0, t, lane, ws, outb, raw[0]); select_load(b1 < 0 ? b0 + 1 : b1, t1 < 0 ? t : t1, lane, ws, outb, raw[1]);
}
__device__ __forceinline__ void select_phase(int gw, int NGW, int lane, const unsigned char* __restrict__ ws, const unsigned char* __restrict__ outb, unsigned char* __restrict__ MASKB, LAS unsigned* H) {
    for (int i = gw; i < 2048; i += NGW) {
#pragma unroll 1
        for (int q = 0; q < 4; ++q) { const int bp = (q >> 1) * 2, t = (q & 1) ? 4095 - i : i;
            u32x4v raw[2][8];
            select_load2(bp, t, lane, ws, outb, raw);
            select_rows2(bp, t, bp + 1, t, lane, raw, MASKB, H);
        }
    }
}

__device__ __forceinline__ void indexer_select_phase(int bx, int G, int tid, int lane, int wave, const hbits* __restrict__ Qi, const hbits* __restrict__ Ki, const float* __restrict__ WI,
                                                     unsigned char* ws, unsigned char* outb, unsigned char* __restrict__ MASKB, LAS unsigned char* L) {
    for (int it = bx; it < 256; it += G) {
        const int b = it >> 6, jj = (it >> 1) & 31, g = it & 1;
#pragma unroll 1
        for (int part = 0; part < 2; ++part) { const int c = part ? 63 - jj : jj;
            indexer_item_h(b, c, g, tid, lane, wave, Qi, Ki, WI, ws, outb, L);
            asm volatile("s_waitcnt vmcnt(0)" ::: "memory"); __syncthreads();
            __builtin_amdgcn_fence(__ATOMIC_ACQUIRE, "workgroup");
            { const int t0 = 64 * c + 32 * g + 4 * wave;
                u32x4v rawA[2][8], rawB[2][8];
                select_load2(b, t0, lane, ws, outb, rawA, b, t0 + 1);
                select_load2(b, t0 + 2, lane, ws, outb, rawB, b, t0 + 3);
                select_rows2(b, t0, b, t0 + 1, lane, rawA, MASKB, (LAS unsigned*)(L + wave * 10240));
                select_rows2(b, t0 + 2, b, t0 + 3, lane, rawB, MASKB, (LAS unsigned*)(L + wave * 10240));
            }
        }
        __syncthreads();
    }
}
typedef short s16x4v __attribute__((ext_vector_type(4)));
typedef short v4i16_t __attribute__((ext_vector_type(4)));
__device__ __forceinline__ s16x4v xvtr(const LAS unsigned char* p) { return __builtin_bit_cast(s16x4v, __builtin_amdgcn_ds_read_tr16_b64_v4i16((LAS v4i16_t*)p)); }
__device__ __forceinline__ void xattn_unit(int b, int h, int qb, int tid, int lane, int wave, const hbits* __restrict__ Qm, const float* __restrict__ qgain, const hbits* __restrict__ Kmem, const hbits* __restrict__ Vmem,
                                           hbits* __restrict__ O, float mref, LAS unsigned char* L) {
    asm volatile("" : "+v"(tid), "+v"(lane));
    const int r32 = lane & 31, hi = lane >> 5;
    LAS unsigned char* LK = L; LAS unsigned char* LV = L + 65536;
    const size_t qrow = (size_t)b * S + 256 * qb + 32 * wave + r32;
    u32x4v qraw[8];
#pragma unroll
    for (int d0 = 0; d0 < 8; ++d0) qraw[d0] = *(const u32x4v*)(Qm + qrow * 512 + h * 128 + d0 * 16 + hi * 8);
    __builtin_amdgcn_sched_barrier(0);
    __syncthreads();
    { const hbits* kg = Kmem + ((size_t)b * 4 + h) * 256 * 128; const hbits* vg = Vmem + ((size_t)b * 4 + h) * 256 * 128;
#pragma unroll
      for (int i = 0; i < 8; ++i) { const int pc = i * 512 + tid, key = pc >> 4, dc = pc & 15;
          const u32x4v kvv = *(const u32x4v*)(kg + (size_t)key * 128 + dc * 8); *(LAS u32x4v*)(LK + dc * 4096 + key * 16) = kvv;
          const u32x4v vvv = *(const u32x4v*)(vg + (size_t)key * 128 + dc * 8); *(LAS u32x4v*)(LV + (dc >> 2) * 16384 + key * 64 + (dc & 3) * 16) = vvv; } }
    s16x8 qf[8];
    { float qv[8][8]; float ss = 0.f;
#pragma unroll
      for (int d0 = 0; d0 < 8; ++d0) { const u32x4v u = qraw[d0];
          const unsigned ux = u.x, uy = u.y, uz = u.z, uw = u.w;
          const h2v a0 = __builtin_bit_cast(h2v, ux), a1 = __builtin_bit_cast(h2v, uy), a2 = __builtin_bit_cast(h2v, uz), a3 = __builtin_bit_cast(h2v, uw);
          qv[d0][0] = (float)a0[0]; qv[d0][1] = (float)a0[1]; qv[d0][2] = (float)a1[0]; qv[d0][3] = (float)a1[1]; qv[d0][4] = (float)a2[0]; qv[d0][5] = (float)a2[1]; qv[d0][6] = (float)a3[0]; qv[d0][7] = (float)a3[1];
#pragma unroll
          for (int j = 0; j < 8; ++j) ss += qv[d0][j] * qv[d0][j]; }
      ss += __shfl_xor(ss, 32);
      const float r = rsqrtf(ss * (1.0f / 128.0f) + EPS) * (0.08838834764831845f * 1.4426950408889634f);
#pragma unroll
      for (int d0 = 0; d0 < 8; ++d0) { const f32x4 g0 = *(const f32x4*)(qgain + d0 * 16 + hi * 8), g1 = *(const f32x4*)(qgain + d0 * 16 + hi * 8 + 4);
          u32x4v o; o.x = pkh(qv[d0][0] * r * g0[0], qv[d0][1] * r * g0[1]); o.y = pkh(qv[d0][2] * r * g0[2], qv[d0][3] * r * g0[3]);
          o.z = pkh(qv[d0][4] * r * g1[0], qv[d0][5] * r * g1[1]); o.w = pkh(qv[d0][6] * r * g1[2], qv[d0][7] * r * g1[3]);
          qf[d0] = __builtin_bit_cast(s16x8, o); } }
    f32x16 o4[4]; o4[0] = f32x16{}; o4[1] = f32x16{}; o4[2] = f32x16{}; o4[3] = f32x16{};
    float l_reg = 0.f;
    __syncthreads();
    const LAS unsigned char* kp = LK + hi * 4096 + r32 * 16;
    const LAS unsigned char* vp = LV + ((lane >> 4) & 1) * 32 + (lane & 3) * 8 + (4 * hi + ((lane & 15) >> 2)) * 64;
#pragma unroll 1
    for (int half = 0; half < 2; ++half) {
        f32x16 sv[4];
#pragma unroll
        for (int kb = 0; kb < 4; ++kb) {
            f32x16 a = f32x16{};
#pragma unroll
            for (int d0 = 0; d0 < 8; ++d0) { const s16x8 kfr = *(const LAS s16x8*)(kp + d0 * 8192 + (half * 4 + kb) * 512); a = FX_MFMA(kfr, qf[d0], a); }
            sv[kb] = a;
        }
        u32x4v pw[4][2];
#pragma unroll
        for (int kb = 0; kb < 4; ++kb) { float sacc = 0.f; f32x16 pv_ = sv[kb];
#pragma unroll
            for (int rr = 0; rr < 16; ++rr) { pv_[rr] = __builtin_amdgcn_exp2f(pv_[rr] - mref); sacc += pv_[rr]; }
            l_reg += sacc;
            pw[kb][0].x = pkh(pv_[0], pv_[1]); pw[kb][0].y = pkh(pv_[2], pv_[3]); pw[kb][0].z = pkh(pv_[4], pv_[5]); pw[kb][0].w = pkh(pv_[6], pv_[7]);
            pw[kb][1].x = pkh(pv_[8], pv_[9]); pw[kb][1].y = pkh(pv_[10], pv_[11]); pw[kb][1].z = pkh(pv_[12], pv_[13]); pw[kb][1].w = pkh(pv_[14], pv_[15]); }
#pragma unroll
        for (int db = 0; db < 4; ++db)
#pragma unroll
            for (int kb = 0; kb < 4; ++kb)
#pragma unroll
                for (int s2 = 0; s2 < 2; ++s2) { const LAS unsigned char* vq = vp + db * 16384 + ((half * 4 + kb) * 32 + s2 * 16) * 64;
                    const s16x4v lo = xvtr(vq), hi4 = xvtr(vq + 512);
                    const s16x8 vf = {lo[0], lo[1], lo[2], lo[3], hi4[0], hi4[1], hi4[2], hi4[3]};
                    o4[db] = FX_MFMA(pw[kb][s2], vf, o4[db]); }
    }
    l_reg += __shfl_xor(l_reg, 32);
    __syncthreads();
    LAS float* lw = (LAS float*)(LK + wave * 8192 + 7936);
    LAS unsigned char* stg = LV + wave * 8192;
    if (hi == 0) lw[r32] = l_reg;
    LDS_WAIT(); asm volatile("" ::: "memory");
#pragma unroll
    for (int rr = 0; rr < 16; ++rr) { const int qr_ = (rr & 3) + 8 * (rr >> 2) + 4 * hi; const float rl = __builtin_amdgcn_rcpf(lw[qr_]);
#pragma unroll
        for (int db = 0; db < 4; ++db) *(LAS hbits*)(stg + qr_ * 256 + (db * 32 + r32) * 2) = f2h(o4[db][rr] * rl); }
    LDS_WAIT(); asm volatile("" ::: "memory");
    hbits* og = O + ((size_t)b * S + 256 * qb + 32 * wave) * 512 + h * 128;
#pragma unroll
    for (int i = 0; i < 8; ++i) { const int row = i * 4 + (lane >> 4), ch = lane & 15;
        const u32x4v v = *(const LAS u32x4v*)(stg + row * 256 + ch * 16);
        *(u32x4v*)(og + (size_t)row * 512 + ch * 8) = v; }
    LDS_WAIT(); asm volatile("" ::: "memory");
}
__device__ __forceinline__ void xattn_phase(int bx, int G, int tid, int lane, int wave, const hbits* __restrict__ Qm, const float* __restrict__ qgain, const float* __restrict__ kgain,
                                            const hbits* __restrict__ Kmem, const hbits* __restrict__ Vmem, hbits* __restrict__ O, LAS unsigned char* L) {
    float gm = fmaxf(fabsf(qgain[lane]), fabsf(qgain[lane + 64])), km = fmaxf(fabsf(kgain[lane]), fabsf(kgain[lane + 64]));
#pragma unroll
    for (int o = 1; o < 64; o <<= 1) { gm = fmaxf(gm, __shfl_xor(gm, o)); km = fmaxf(km, __shfl_xor(km, o)); }
    const float mref = fmaxf(0.f, 128.f * gm * km * (0.08838834764831845f * 1.4426950408889634f) - 14.f);
#pragma unroll 1
    for (int u = (G == 256) ? (((8 * (bx & 7) + ((bx >> 3) & 7)) >> 4) * 4 + (bx >> 6)) * 16 + ((8 * (bx & 7) + ((bx >> 3) & 7)) & 15) : bx; u < 256; u += G) { const int bh = u >> 4, qb = u & 15;     xattn_unit(bh >> 2, bh & 3, qb, tid, lane, wave, Qm, qgain, Kmem, Vmem, O, mref, L); }
}

template <int W>
__device__ __forceinline__ void pool_mix(int m0, int g, int tid, const hbits* __restrict__ U, LAS unsigned char* L) {
    const int c2 = tid & 63, seg = tid >> 6, ms = m0 + 32 * seg, pos0 = ms & (S - 1);
    const hbits* up = U + (size_t)ms * 512 + g * 128 + 2 * c2;
    unsigned uv[W - 1 + 32];
#pragma unroll
    for (int j = 0; j < W - 1 + 32; ++j) { const int rel = j - (W - 1); uv[j] = *(const unsigned*)(up + (ptrdiff_t)((pos0 + rel >= 0) ? rel : 0) * 512); }
    __builtin_amdgcn_sched_barrier(0);
#pragma unroll
    for (int j = 0; j < W - 1; ++j) { const int rel = j - (W - 1); uv[j] = (pos0 + rel >= 0) ? uv[j] : 0u; }
    float s0 = 0.f, s1 = 0.f;
#pragma unroll
    for (int j = 0; j < W - 1; ++j) { const unsigned u = uv[j]; const h2v hv = __builtin_bit_cast(h2v, u); s0 += (float)hv[0]; s1 += (float)hv[1]; }
#pragma unroll
    for (int i = 0; i < 32; ++i) { const int pos = pos0 + i;
        const unsigned u = uv[W - 1 + i]; const h2v hv = __builtin_bit_cast(h2v, u); const float u0 = (float)hv[0], u1 = (float)hv[1];
        s0 += u0; s1 += u1;
        const float rc = 1.0f / (float)((pos + 1 < W) ? pos + 1 : W);
        *(LAS unsigned*)(L + (32 * seg + i) * 272 + c2 * 4) = pkh(s0 * rc - u0, s1 * rc - u1);
        const unsigned uo = uv[i]; const h2v ho = __builtin_bit_cast(h2v, uo); s0 -= (float)ho[0]; s1 -= (float)ho[1]; }
}
__device__ __forceinline__ void pool_item(int g, int tb, int tid, int lane, int wave, const hbits* __restrict__ U, const hbits* __restrict__ Pwt, hbits* __restrict__ Y, LAS unsigned char* L) {
    asm volatile("" : "+v"(tid), "+v"(lane));
    const int m0 = tb * 256;
    __syncthreads();
    u32x4v wst_[4];
#pragma unroll
    for (int i = 0; i < 4; ++i) { const int pc = i * 512 + tid; wst_[i] = *(const u32x4v*)(Pwt + (size_t)g * 128 * 128 + (size_t)(pc >> 4) * 128 + (pc & 15) * 8); }
    __builtin_amdgcn_sched_barrier(0);
    if (g == 0) pool_mix<2>(m0, g, tid, U, L); else if (g == 1) pool_mix<4>(m0, g, tid, U, L); else if (g == 2) pool_mix<8>(m0, g, tid, U, L); else pool_mix<16>(m0, g, tid, U, L);
    __builtin_amdgcn_sched_barrier(0);
#pragma unroll
    for (int i = 0; i < 4; ++i) { const int pc = i * 512 + tid; *(LAS u32x4v*)(L + 69632 + (pc >> 4) * 272 + (pc & 15) * 16) = wst_[i]; }
    __syncthreads();
    const int r32 = lane & 31, hi = lane >> 5;
    const LAS unsigned char* mp = L + (32 * wave + r32) * 272 + hi * 16;
    const LAS unsigned char* wl = L + 69632 + r32 * 272 + hi * 16;
    hbits* yp = Y + (size_t)(m0 + 32 * wave + r32) * 1024 + g * 128 + 4 * hi;
#pragma unroll 1
    for (int db = 0; db < 4; ++db) {
        f32x16 acc = f32x16{};
        s16x8 wf[8];
#pragma unroll
        for (int ks = 0; ks < 8; ++ks) wf[ks] = *(const LAS s16x8*)(wl + (32 * db) * 272 + ks * 32);
        asm volatile("" : "+v"(wf[0]), "+v"(wf[1]), "+v"(wf[2]), "+v"(wf[3]), "+v"(wf[4]), "+v"(wf[5]), "+v"(wf[6]), "+v"(wf[7]));
#pragma unroll
        for (int ks = 0; ks < 8; ++ks) { const s16x8 mf = *(const LAS s16x8*)(mp + ks * 32); acc = FX_MFMA(wf[ks], mf, acc); }
#pragma unroll
        for (int q4 = 0; q4 < 4; ++q4) { u32x2v o; o.x = pkh(acc[4 * q4], acc[4 * q4 + 1]); o.y = pkh(acc[4 * q4 + 2], acc[4 * q4 + 3]); *(u32x2v*)(yp + 32 * db + 8 * q4) = o; }
    }
}
__device__ __forceinline__ void pool_phase(int bx, int G, int tid, int lane, int wave, const hbits* __restrict__ U, const hbits* __restrict__ Pwt, hbits* __restrict__ Y, LAS unsigned char* L) {
#pragma unroll 1
    for (int it = bx; it < 256; it += G) pool_item(it & 3, it >> 2, tid, lane, wave, U, Pwt, Y, L);
}
}
constexpr int NWAVES = 8;
constexpr int RING_OFF = 0, RING_BYTES = 131072, LDSCTL_OFF = RING_BYTES, MISC_OFF = LDSCTL_OFF + 320, LDS_BYTES = 147456;
constexpr int CW_BAR = 4096;

__device__ __forceinline__ float wave_sum_x(float v) {
#define FDPP(ctrl, rm) __builtin_bit_cast(float, __builtin_amdgcn_update_dpp(0, __builtin_bit_cast(int, v), ctrl, rm, 0xf, false))
    v += FDPP(0xB1, 0xf); v += FDPP(0x4E, 0xf); v += FDPP(0x141, 0xf); v += FDPP(0x140, 0xf); v += FDPP(0x142, 0xa); v += FDPP(0x143, 0xc);
#undef FDPP
    return __builtin_bit_cast(float, __builtin_amdgcn_readlane(__builtin_bit_cast(int, v), 63));
}
#define NBP(nb) ((((nb) & ~7) | (4 * ((nb) & 1) + (((nb) & 7) >> 1))))
__device__ __forceinline__ void tr_item(const float* __restrict__ W, int ldw, int src0, int nvalid, const float* __restrict__ kgain, const float* __restrict__ nscale,
                                        hbits* WT, int ldt, int dst_row0, int k0, LAS float* scr, int lane) {
    { const int n = lane & 31, kh = lane >> 5; float vals[32];
#pragma unroll
      for (int i = 0; i < 32; ++i) vals[i] = (n < nvalid) ? __builtin_nontemporal_load(&W[(size_t)(k0 + 2 * i + kh) * ldw + src0 + n]) : 0.f;
      if (kgain) {
#pragma unroll
        for (int i = 0; i < 32; ++i) vals[i] *= kgain[k0 + 2 * i + kh]; }
#pragma unroll
      for (int i = 0; i < 32; ++i) scr[(2 * i + kh) * 33 + n] = vals[i]; }
    LDS_WAIT(); asm volatile("" ::: "memory");
    const int c = lane & 7;
#pragma unroll
    for (int j = 0; j < 4; ++j) { const int n = (lane >> 3) + 8 * j; const LAS float* s = scr + (8 * c) * 33 + n; const float sc = nscale ? nscale[n] : 1.0f;
        v4u o; o.x = pkh(s[0 * 33] * sc, s[1 * 33] * sc); o.y = pkh(s[2 * 33] * sc, s[3 * 33] * sc); o.z = pkh(s[4 * 33] * sc, s[5 * 33] * sc); o.w = pkh(s[6 * 33] * sc, s[7 * 33] * sc);
        *(GAS v4u*)(WT + (size_t)(dst_row0 + n) * ldt + k0 + 8 * c) = o; }
    LDS_WAIT(); asm volatile("" ::: "memory");
}
__device__ __forceinline__ void rms_row_to_h(const float* xrow, hbits* orow, int lane) {
    const GAS f32x4* xr = (const GAS f32x4*)xrow + lane;
    f32x4 v[4]; float s = 0.f;
#pragma unroll
    for (int j = 0; j < 4; ++j) { v[j] = xr[64 * j]; s += (v[j].x * v[j].x + v[j].y * v[j].y) + (v[j].z * v[j].z + v[j].w * v[j].w); }
    const float rstd = rsqrtf(wave_sum_x(s) * (1.f / D) + EPS);
    GAS unsigned long long* o8 = (GAS unsigned long long*)orow + lane;
#pragma unroll
    for (int j = 0; j < 4; ++j) o8[64 * j] = (unsigned long long)pkh(v[j].x * rstd, v[j].y * rstd) | ((unsigned long long)pkh(v[j].z * rstd, v[j].w * rstd) << 32);
}

__device__ __forceinline__ void rms_rows2_to_h(const float* xa, hbits* oa, const float* xb, hbits* ob, float* rmsa, float* rmsb, int lane) {
    const GAS f32x4* pa = (const GAS f32x4*)xa + lane; const GAS f32x4* pb = (const GAS f32x4*)xb + lane;
    f32x4 va[4], vb[4]; float sa = 0.f, sb = 0.f;
#pragma unroll
    for (int j = 0; j < 4; ++j) { va[j] = __builtin_nontemporal_load(pa + 64 * j); vb[j] = __builtin_nontemporal_load(pb + 64 * j); }
#pragma unroll
    for (int j = 0; j < 4; ++j) { sa += (va[j].x * va[j].x + va[j].y * va[j].y) + (va[j].z * va[j].z + va[j].w * va[j].w); sb += (vb[j].x * vb[j].x + vb[j].y * vb[j].y) + (vb[j].z * vb[j].z + vb[j].w * vb[j].w); }
    const float ra = rsqrtf(wave_sum_x(sa) * (1.f / D) + EPS), rb = rsqrtf(wave_sum_x(sb) * (1.f / D) + EPS);
    if (lane == 0) { if (rmsa) *rmsa = __builtin_amdgcn_rcpf(ra); if (rmsb) *rmsb = __builtin_amdgcn_rcpf(rb); }
    GAS unsigned long long* qa = (GAS unsigned long long*)oa + lane; GAS unsigned long long* qb = (GAS unsigned long long*)ob + lane;
#pragma unroll
    for (int j = 0; j < 4; ++j) { qa[64 * j] = (unsigned long long)pkh(va[j].x * ra, va[j].y * ra) | ((unsigned long long)pkh(va[j].z * ra, va[j].w * ra) << 32);
        qb[64 * j] = (unsigned long long)pkh(vb[j].x * rb, vb[j].y * rb) | ((unsigned long long)pkh(vb[j].z * rb, vb[j].w * rb) << 32); }
}

struct Args { const float* in[25]; float* out; unsigned char* ws; int ph_lo, ph_hi, li, pad; int rep[16]; };

__global__ void __launch_bounds__(NWAVES * 64, 2) mk(Args args) {
    extern __shared__ __attribute__((aligned(16))) unsigned char lds[];
    LAS unsigned char* L = (LAS unsigned char*)lds;
    volatile LAS unsigned* MISC = (volatile LAS unsigned*)(L + MISC_OFF);
    const int wave = __builtin_amdgcn_readfirstlane((int)threadIdx.x >> 6);
#define lane (fx_lane())
#define tid (wave * 64 + fx_lane())
#define T0 (wave == 0 && fx_lane() == 0)
    const int G = gridDim.x; const int bx = blockIdx.x;
    unsigned char* ws = args.ws;
    for (int u = tid; u < (LDS_BYTES - LDSCTL_OFF) / 4; u += NWAVES * 64) ((LAS unsigned*)(L + LDSCTL_OFF))[u] = 0u;
    __syncthreads();
    XcdBarrier bar = xcd_barrier_post((unsigned*)(ws + WS_CTL) + CW_BAR, MISC + 8, T0);
    const int lo = args.ph_lo, hi = args.ph_hi;
    unsigned* hoc = (unsigned*)(ws + WS_CTL) + CW_HO;
    if (T0 && xb_xcc_id() != (unsigned)(bx & 7)) (void)xb_add(hoc + 4096, 1u);
    const bool ho_mode = (G == 256) && lo == 0 && hi > 9 && args.rep[5] == 1 && args.rep[6] == 1 && args.rep[7] == 1 && args.rep[8] == 1 && args.rep[9] == 1;
    const int pmq = 8 * (bx & 7) + ((bx >> 3) & 7);
#define IN(k) (lo <= (k) && (k) < hi)
#define BOTH(k) (IN(k) && IN((k) + 1))
    const float* x = args.in[0]; const float* mem = args.in[1]; const float* mix_norm = args.in[2]; const float* w_in = args.in[3];
    const float* pool_w = args.in[4]; const float* pool_scale = args.in[5]; const float* q_norm = args.in[6]; const float* k_norm = args.in[7]; const float* idx_k_norm = args.in[8];
    const float* w_out = args.in[9]; const float* xattn_norm = args.in[10]; const float* mem_norm = args.in[11]; const float* wq = args.in[12]; const float* wkv = args.in[13];
    const float* wo = args.in[16]; const float* ffn_norm = args.in[17]; const float* wgate = args.in[22]; const float* wup = args.in[23]; const float* wdown = args.in[24];
#define Win_t ((hbits*)(ws + WS_WIN))
#define Wkv_t (Win_t + (size_t)2816 * 1024)
#define Wout_t ((hbits*)(ws + WS_WOUT))
#define Wq_t ((hbits*)(ws + WS_WQ))
#define Wo_t ((hbits*)(ws + WS_WO))
#define Wgu_t ((hbits*)(ws + WS_WGU))
#define Wd_t ((hbits*)(ws + WS_WD))
#define Pw_t ((hbits*)(ws + WS_PWT))
#define XH ((hbits*)(ws + WS_XH))
#define cosT ((float*)(ws + WS_ROPE))
#define sinT (cosT + 4096 * 32)

    for (int rep_ = 0; rep_ < (IN(0) ? args.rep[0] : 0); ++rep_) {
        LAS float* scr = (LAS float*)(L + RING_OFF + wave * 16384);
        const int gw = bx * NWAVES + wave, NGW = G * NWAVES;
        constexpr int I0 = 16 * 88, I1 = 512, I2 = 512, I3 = 256, I4 = 256, I5 = 32, I6 = 8192, I7 = 4096, NITEMS = I0 + I1 + I2 + I3 + I4 + I5;
        for (int it = gw; it < NITEMS; it += NGW) {
            int r = it;
            if (r < I0) { const int kb = r / 88, bb = r % 88, T = bb >> 3, cb = bb & 7, wc = cb & 3, bj = cb >> 2; int src0, nv = 32;
                if (T < 2) src0 = 256 * T + 32 * cb;
                else if (T == 6 || T == 7) src0 = 1536 + 256 * (T - 6) + 32 * cb;
                else if (T == 10) { if (cb == 0) src0 = 2560; else if (cb == 4) src0 = 2592; else if (cb == 1) { src0 = 2624; nv = 8; } else { src0 = 0; nv = 0; } }
                else { const int base = (T < 4) ? 512 : (T < 6) ? 1024 : 2048; src0 = base + 64 * (4 * (T & 1) + wc) + 32 * bj; }
                tr_item(w_in, INC, src0, nv, mix_norm, nullptr, Win_t, 1024, 32 * bb, 64 * kb, scr, lane); continue; }
            r -= I0;
            if (r < I1) { const int kb = r / 32, nb = r % 32; tr_item(wkv, 1024, 32 * nb, 32, mem_norm, nullptr, Wkv_t, 1024, 32 * nb, 64 * kb, scr, lane); continue; }
            r -= I1;
            if (r < I2) { const int kb = r / 32, nb = r % 32; tr_item(w_out, 1024, 32 * nb, 32, nullptr, nullptr, Wout_t, 1024, 32 * NBP(nb), 64 * kb, scr, lane); continue; }
            r -= I2;
            if (r < I3) { const int kb = r / 16, nb = r % 16; tr_item(wq, 512, 32 * nb, 32, xattn_norm, nullptr, Wq_t, 1024, 32 * NBP(nb), 64 * kb, scr, lane); continue; }
            r -= I3;
            if (r < I4) { const int kb = r / 32, nb = r % 32; tr_item(wo, 1024, 32 * nb, 32, nullptr, nullptr, Wo_t, 512, 32 * NBP(nb), 64 * kb, scr, lane); continue; }
            r -= I4;
            if (r < I5) { const int g = r >> 3, kb = (r >> 2) & 1, nb = r & 3;
                tr_item(pool_w + (size_t)g * 128 * 128, 128, 32 * nb, 32, nullptr, pool_scale + g * 128 + 32 * nb, Pw_t + (size_t)g * 128 * 128, 128, 32 * nb, 64 * kb, scr, lane); continue; }
        }
        for (int m = gw; m < M + MR; m += 2 * NGW) {
            const int m2 = m + NGW; const bool has2 = m2 < M + MR; const int mm2 = has2 ? m2 : m;
            rms_rows2_to_h(m < M ? x + (size_t)m * D : mem + (size_t)(m - M) * D, XH + (size_t)m * D, mm2 < M ? x + (size_t)mm2 * D : mem + (size_t)(mm2 - M) * D, XH + (size_t)mm2 * D, m < M ? (float*)(ws + WS_RMS0) + m : nullptr, mm2 < M ? (float*)(ws + WS_RMS0) + mm2 : nullptr, lane); }
        for (int i = bx * 512 + tid; i < 4096 * 32; i += G * 512) { const int pos = i >> 5, k = i & 31;
            const float inv = powf(10000.f, -(float)(2 * k) / 64.f), ang = (float)pos * inv; ((hbits*)cosT)[i] = f2h(cosf(ang)); ((hbits*)sinT)[i] = f2h(sinf(ang)); }
        { hbits* RWT = (hbits*)(ws + WS_RWT); const float* rgw = args.in[18]; const float* rew = args.in[20];
          for (int i = bx * 512 + tid; i < 64 * 1024; i += G * 512) { const int j = i >> 10, k = i & 1023; RWT[i] = (j < 36) ? f2h(ffn_norm[k] * (j < 4 ? rgw[k * 4 + j] : rew[k * 32 + (j - 4)])) : (hbits)0; } }
        if (BOTH(0)) xcd_barrier(bar, T0, wave == 0);
    }
    if (ho_mode && T0) MISC[12] = (xb_ld(hoc + 4096) == 0u) ? 1u : 0u;
#define STD_MAP (ho_mode && MISC[12] != 0u)
    constexpr int I6 = 8192, I7 = 4096, NI1 = 48 * NWAVES * 8;
#define MOE_CONV(it_) do { int r = (it_); LAS float* scr = (LAS float*)(L + RING_OFF + wave * 16384); \
        if (r < I6) { const int e = r >> 8, q = r & 255, kb = q >> 4, bb = q & 15, T = bb >> 3, cb = bb & 7, bj = cb >> 2; \
            tr_item((bj ? wup : wgate) + (size_t)e * 1024 * 256, 256, 128 * T + 32 * (cb & 3), 32, ffn_norm, nullptr, Wgu_t + (size_t)e * 512 * 1024, 1024, 32 * bb, 64 * kb, scr, lane); } \
        else { r -= I6; const int e = r >> 7, q = r & 127, kb = q >> 5, nb = q & 31; \
            tr_item(wdown + (size_t)e * 256 * 1024, 1024, 32 * nb, 32, nullptr, nullptr, Wd_t + (size_t)e * 1024 * 256, 256, 32 * NBP(nb), 64 * kb, scr, lane); } } while (0)
    const bool conv_split = (G == 256) && IN(1) && IN(6);
    for (int rep_ = 0; rep_ < (IN(1) ? args.rep[1] : 0); ++rep_) {
        pg8::Gemm g{XH, Win_t, M + MR, 3840, D}; pg8::SchedIn Sc; Sc.init(G, bx);
        pg8::EpiIn E{(hbits*)(ws + WS_U), (hbits*)(ws + WS_QA), (hbits*)(ws + WS_KA), (hbits*)(ws + WS_VA), (hbits*)(ws + WS_QI), (hbits*)(ws + WS_KI), (float*)(ws + WS_WI), (float*)(ws + WS_KVRAW),
                     cosT, sinT, q_norm, k_norm, idx_k_norm};
        pg8::gemm_phase<pg8::EpiIn, pg8::SchedIn, true, true>(L + RING_OFF, g, Sc, E, wave);
        if (conv_split && bx >= 208 && rep_ == 0) {
#pragma unroll 1
            for (int it = (bx - 208) * NWAVES + wave; it < NI1; it += 48 * NWAVES) MOE_CONV(it);
        }
        if (BOTH(1)) xcd_barrier(bar, T0, wave == 0);
    }

    for (int rep_ = 0; rep_ < (IN(2) ? args.rep[2] : 0); ++rep_) {
        for (int r2 = 0; r2 < args.rep[13]; ++r2) fx::pool_phase(bx, G, tid, lane, wave, (const hbits*)(ws + WS_U), Pw_t, (hbits*)args.out, L + RING_OFF);
        for (int r2 = 0; r2 < args.rep[14]; ++r2) sl::kmem_phase(bx * NWAVES + wave, G * NWAVES, lane, (const float*)(ws + WS_KVRAW), args.in[15], (hbits*)(ws + WS_KMEM), (hbits*)(ws + WS_VMEM));
        __syncthreads();
        for (int r2 = 0; r2 < args.rep[15]; ++r2) fx::indexer_select_phase(bx, G, tid, lane, wave, (const hbits*)(ws + WS_QI), (const hbits*)(ws + WS_KI), (const float*)(ws + WS_WI), ws, (unsigned char*)args.out,
                                                                           (unsigned char*)(ws + WS_MASK), L + RING_OFF);
        if (IN(4)) xcd_barrier(bar, T0, wave == 0);
    }
    for (int rep_ = 0; rep_ < (IN(4) ? args.rep[4] : 0); ++rep_) {
        float gm = fabsf(q_norm[lane]), km = fabsf(k_norm[lane]);
#pragma unroll
        for (int o = 1; o < 64; o <<= 1) { gm = fmaxf(gm, __shfl_xor(gm, o)); km = fmaxf(km, __shfl_xor(km, o)); }
        const bool fast_ok = (G == 256) && (64.f * gm * km * C2Q <= 14.f);
#if DBG_ATTN
        sl::dsa_phase(L, bx, G, tid, (const hbits*)(ws + WS_QA), (const hbits*)(ws + WS_KA), (const hbits*)(ws + WS_VA), (const unsigned long long*)(ws + WS_MASK), (hbits*)args.out);
        __syncthreads();
        { const attn_body::AttnTensors AT{(const hbits*)(ws + WS_QA), (const hbits*)(ws + WS_KA), (const hbits*)(ws + WS_VA), (hbits*)(ws + WS_X1H), (const unsigned long long*)(ws + WS_MASK), 0.f};
          const attn_body::StaticOrder SA(G, bx);
          attn_body::attn_phase<attn_body::StaticOrder>((char*)lds + RING_OFF, AT, SA, wave); }
        xcd_barrier(bar, T0, wave == 0);
        { unsigned* dbg = (unsigned*)(ws + WS_CTL) + 16384;
          const hbits* Ya = (const hbits*)args.out; const hbits* Yb = (const hbits*)(ws + WS_X1H);
          float mx = 0.f; unsigned cntb = 0, cnt2 = 0, minrow = 0xffffffffu;
          for (size_t i = (size_t)bx * 512 + tid; i < (size_t)M * 512; i += (size_t)G * 512) { const int m = (int)(i >> 9), cidx = (int)(i & 511);
              const float d = fabsf(h2f(Ya[(size_t)m * 1024 + 512 + cidx]) - h2f(Yb[(size_t)m * 1024 + 512 + cidx]));
              mx = fmaxf(mx, d); if (d > DBG_TOL) { ++cntb; if ((m & 4095) < 256) ++cnt2; if ((unsigned)(m & 4095) < minrow) minrow = (unsigned)(m & 4095); } }
          atomicMax(dbg + 0, __float_as_uint(mx)); atomicAdd(dbg + 1, cntb); if (minrow != 0xffffffffu) atomicMax(dbg + 2, 4096u - minrow); atomicAdd(dbg + 3, cnt2); }
#else
        if (fast_ok) {
            static_assert(attn_body::ATTN_LDS_BYTES <= RING_BYTES, "attention LDS");
            const attn_body::AttnTensors AT{(const hbits*)(ws + WS_QA), (const hbits*)(ws + WS_KA), (const hbits*)(ws + WS_VA), (hbits*)args.out, (const unsigned long long*)(ws + WS_MASK), 0.f};
            const attn_body::StaticOrder SA(G, bx);
            attn_body::attn_phase<attn_body::StaticOrder>((char*)lds + RING_OFF, AT, SA, wave);
        } else
        sl::dsa_phase(L, bx, G, tid, (const hbits*)(ws + WS_QA), (const hbits*)(ws + WS_KA), (const hbits*)(ws + WS_VA), (const unsigned long long*)(ws + WS_MASK), (hbits*)args.out);
#endif
        if (BOTH(4)) {
            if (fast_ok && ho_mode && args.rep[4] == 1) {
                asm volatile("s_waitcnt vmcnt(0)" ::: "memory");
                __syncthreads();
                if (wave == 0) {
                    if (lane == 0) { const int vcu_ = (bx & 7) * 32 + (bx >> 3), s_ = vcu_ & 7, b_ = vcu_ >> 6;
                        (void)xb_add(hoc + 5 * 1024 + 16 * (b_ * 16 + s_), 1u); (void)xb_add(hoc + 5 * 1024 + 16 * (b_ * 16 + 15 - s_), 1u); }
                    asm volatile("buffer_inv sc1" ::: "memory");
                    unsigned sp = 0u;
                    for (;;) { const unsigned v = (unsigned)__builtin_amdgcn_readfirstlane((int)xb_ld(hoc + 5 * 1024 + 16 * pmq)); if (v >= 8u) break; __builtin_amdgcn_s_sleep(1); if (++sp > (1u << 22)) break; }
                    asm volatile("s_waitcnt vmcnt(0)" ::: "memory");
                }
                __syncthreads();
            } else xcd_barrier(bar, T0, wave == 0);
        }
    }
    for (int rep_ = 0; rep_ < (IN(5) ? args.rep[5] : 0); ++rep_) {
        pg8::Gemm g{(const hbits*)args.out, Wout_t, M, D, D}; pg8::StaticOrder Sc; Sc.init(M, D, G, bx);
        pg8::EpiRes<true, true> E{XH, (hbits*)(ws + WS_X1H), (float*)(ws + WS_SS1), (const float*)(ws + WS_RMS0)};
        pg8::gemm_phase<pg8::EpiRes<true, true>, pg8::StaticOrder, true, true>(L + RING_OFF, g, Sc, E, wave);
        if (BOTH(5)) { if (STD_MAP) tile_handoff(hoc + 0 * 1024 + 16 * pmq, true, bx < 128, 4u, wave == 0); else xcd_barrier(bar, T0, wave == 0); }
    }
    for (int rep_ = 0; rep_ < (IN(6) ? args.rep[6] : 0); ++rep_) {
        pg8::Gemm g{(const hbits*)(ws + WS_X1H), Wq_t, M, 512, D}; pg8::StaticOrder Sc; Sc.init(M, 512, G, bx);
        pg8::EpiWq E{(const float*)(ws + WS_SS1), (hbits*)(ws + WS_QM)};
        if (bx >= 128 && G == 256) {
            const int gw2 = (bx - 128) * NWAVES + wave, NGW2 = 128 * NWAVES;
#pragma unroll 1
            for (int it = (conv_split ? NI1 : 0) + gw2; it < I6 + I7; it += NGW2) MOE_CONV(it);
        } else
        pg8::gemm_phase<pg8::EpiWq, pg8::StaticOrder, true, true>(L + RING_OFF, g, Sc, E, wave);
        if (BOTH(6)) { if (STD_MAP) tile_handoff(hoc + 1 * 1024 + 16 * pmq, bx < 128, true, 2u, wave == 0); else xcd_barrier(bar, T0, wave == 0); }
    }

    for (int rep_ = 0; rep_ < (IN(7) ? args.rep[7] : 0); ++rep_) {
        fx::xattn_phase(bx, G, tid, lane, wave, (const hbits*)(ws + WS_QM), args.in[14], args.in[15], (const hbits*)(ws + WS_KMEM), (const hbits*)(ws + WS_VMEM), (hbits*)(ws + WS_OX), L + RING_OFF);
        if (BOTH(7)) { if (STD_MAP) tile_handoff(hoc + 2 * 1024 + 16 * pmq, true, true, 4u, wave == 0); else xcd_barrier(bar, T0, wave == 0); }
    }
    for (int rep_ = 0; rep_ < (IN(8) ? args.rep[8] : 0); ++rep_) {
        pg8::Gemm g{(const hbits*)(ws + WS_OX), Wo_t, M, D, 512}; pg8::StaticOrder Sc; Sc.init(M, D, G, bx);
        pg8::EpiRes<true, false> E{(const hbits*)(ws + WS_X1H), (hbits*)(ws + WS_X2H), (float*)(ws + WS_SS2), nullptr};
        pg8::gemm_phase<pg8::EpiRes<true, false>, pg8::StaticOrder, true, true>(L + RING_OFF, g, Sc, E, wave);
        if (BOTH(8)) { if (STD_MAP) tile_handoff(hoc + 3 * 1024 + 16 * pmq, true, true, 4u, wave == 0); else xcd_barrier(bar, T0, wave == 0); }
    }

    LAS int* TB = (LAS int*)(L + LDSCTL_OFF + 1024); LAS int* TC = TB + 32; LAS int* TTp = TB + 64; LAS int* lc = TB + 96; LAS int* lbase = TB + 128;
#define gcnt ((int*)(ws + WS_CTL) + CW_CNT)
#define rlist ((int*)(ws + WS_RLIST))
#define rwt ((float*)(ws + WS_RW))
#define RSTD2 ((float*)(ws + WS_RSTD2))
#define rsl ((float*)(ws + WS_RSL))
    if (IN(9)) {
        const float* RWT = (const float*)(ws + WS_RWT); const hbits* X2 = (const hbits*)(ws + WS_X2H); const float* SS2 = (const float*)(ws + WS_SS2);
        const float* rgb = args.in[19]; const float* reb = args.in[21];
        for (int it = (G == 256) ? 4 * pmq + (bx >> 6) : bx; it < M / 64; it += G) {
            const int tok0 = it * 64;
            LAS float* xs = (LAS float*)(L + wave * 9216);
            f32x4 a4 = {0.f, 0.f, 0.f, 0.f}, b4 = a4, c4 = a4, d4 = a4;
            if (wave == 0) { const int tok_ = tok0 + lane; a4 = *(const f32x4*)(SS2 + (size_t)tok_ * 16); b4 = *(const f32x4*)(SS2 + (size_t)tok_ * 16 + 4); c4 = *(const f32x4*)(SS2 + (size_t)tok_ * 16 + 8); d4 = *(const f32x4*)(SS2 + (size_t)tok_ * 16 + 12); }
            for (int r9 = 0; r9 < args.rep[9]; ++r9) {
            const int l9 = lane, r32 = l9 & 31, hi9 = l9 >> 5;
            fx::f32x16 a00 = fx::f32x16{}, a01 = fx::f32x16{}, a10 = fx::f32x16{}, a11 = fx::f32x16{};
            const hbits* xa = X2 + (size_t)(tok0 + r32) * D + wave * 128 + hi9 * 8;
            const hbits* wb = (const hbits*)(ws + WS_RWT) + (size_t)r32 * 1024 + wave * 128 + hi9 * 8;
            fx::s16x8 xv0[8], xv1[8], wv0[8], wv1[8];
#pragma unroll
            for (int ks = 0; ks < 8; ++ks) { xv0[ks] = *(const fx::s16x8*)(xa + ks * 16); xv1[ks] = *(const fx::s16x8*)(xa + (size_t)32 * D + ks * 16);
                wv0[ks] = *(const fx::s16x8*)(wb + ks * 16); wv1[ks] = *(const fx::s16x8*)(wb + (size_t)32 * 1024 + ks * 16); }
            __builtin_amdgcn_sched_barrier(0);
#pragma unroll
            for (int ks = 0; ks < 8; ++ks) {
                a00 = FX_MFMA(xv0[ks], wv0[ks], a00); a01 = FX_MFMA(xv0[ks], wv1[ks], a01); a10 = FX_MFMA(xv1[ks], wv0[ks], a10); a11 = FX_MFMA(xv1[ks], wv1[ks], a11);
            }
#pragma unroll
            for (int rr = 0; rr < 16; ++rr) { const int tk = (rr & 3) + 8 * (rr >> 2) + 4 * hi9;
                xs[r32 * 64 + tk] = a00[rr]; xs[r32 * 64 + 32 + tk] = a10[rr];
                if (r32 < 4) { xs[(32 + r32) * 64 + tk] = a01[rr]; xs[(32 + r32) * 64 + 32 + tk] = a11[rr]; } }
            }
            if (tid < 32) lc[tid] = 0;
            __syncthreads();
            LAS float* lg = (LAS float*)(L + 8 * 9216);
            for (int o = tid; o < 2304; o += 512) { float sm = 0.f;
#pragma unroll
                for (int w = 0; w < 8; ++w) sm += ((LAS float*)(L + w * 9216))[o];
                lg[o] = sm; }
            __syncthreads();
            if (wave == 0) {
                const int tok = tok0 + lane;
                const float tt = ((a4[0] + a4[1]) + (a4[2] + a4[3])) + ((b4[0] + b4[1]) + (b4[2] + b4[3])) + ((c4[0] + c4[1]) + (c4[2] + c4[3])) + ((d4[0] + d4[1]) + (d4[2] + d4[3]));
                const float r = rsqrtf(tt * (1.0f / 1024.0f) + EPS);
                RSTD2[tok] = r;
                float gl[4]; int g = 0;
#pragma unroll
                for (int j = 0; j < 4; ++j) gl[j] = lg[j * 64 + lane] * r + rgb[j];
#pragma unroll
                for (int j = 1; j < 4; ++j) if (gl[j] > gl[g]) g = j;
                float gs = 0.f;
#pragma unroll
                for (int j = 0; j < 4; ++j) gs += expf(gl[j] - gl[g]);
                const float gwt = 1.f / gs;
                float el[8];
#pragma unroll
                for (int j = 0; j < 8; ++j) el[j] = lg[(4 + g * 8 + j) * 64 + lane] * r + reb[g * 8 + j];
                int i0 = 0;
#pragma unroll
                for (int j = 1; j < 8; ++j) if (el[j] > el[i0]) i0 = j;
                int i1 = (i0 == 0) ? 1 : 0;
#pragma unroll
                for (int j = 0; j < 8; ++j) if (j != i0 && el[j] > el[i1]) i1 = j;
                float v0 = el[0], v1 = el[0];
#pragma unroll
                for (int j = 0; j < 8; ++j) { if (j == i0) v0 = el[j]; if (j == i1) v1 = el[j]; }
                const float e1 = expf(v1 - v0);
                const float w0 = gwt / (1.f + e1), w1 = gwt * e1 / (1.f + e1);
                const int e0g = g * 8 + i0, e1g = g * 8 + i1;
                const int p0 = __hip_atomic_fetch_add(lc + e0g, 1, __ATOMIC_RELAXED, __HIP_MEMORY_SCOPE_WORKGROUP);
                const int p1 = __hip_atomic_fetch_add(lc + e1g, 1, __ATOMIC_RELAXED, __HIP_MEMORY_SCOPE_WORKGROUP);
                LDS_WAIT(); asm volatile("" ::: "memory");
                if (lane < 32) { const int n = ((volatile LAS int*)lc)[lane]; int bs = 0; if (n > 0) bs = atomicAdd(gcnt + lane, n); ((volatile LAS int*)lbase)[lane] = bs; }
                LDS_WAIT(); asm volatile("" ::: "memory");
                const int b0 = ((volatile LAS int*)lbase)[e0g], b1 = ((volatile LAS int*)lbase)[e1g];
                rlist[(size_t)e0g * M + b0 + p0] = (tok << 1); rwt[(size_t)e0g * M + b0 + p0] = w0; rsl[(size_t)e0g * M + b0 + p0] = r;
                rlist[(size_t)e1g * M + b1 + p1] = (tok << 1) | 1; rwt[(size_t)e1g * M + b1 + p1] = w1; rsl[(size_t)e1g * M + b1 + p1] = r;
            }
            __syncthreads();
        }
        if (BOTH(9)) xcd_barrier(bar, T0, wave == 0);
    }
    if (IN(10)) {
        if (wave == 0) {
            const int n = (lane < 32) ? __hip_atomic_load(gcnt + (lane & 31), __ATOMIC_RELAXED, __HIP_MEMORY_SCOPE_AGENT) : 0;
            const int nt = (n + 255) >> 8; int inc = nt;
#pragma unroll
            for (int o = 1; o < 32; o <<= 1) { const int t = __shfl_up(inc, o); if ((lane & 31) >= o) inc += t; }
            if (lane < 32) { TB[lane] = inc - nt; TC[lane] = n; }
            if (lane == 31) TTp[0] = inc;
        }
        __syncthreads();
    }
    for (int rep_ = 0; rep_ < (IN(10) ? args.rep[10] : 0); ++rep_) {
        pg8::MoeTab tab{TB, TC, __builtin_amdgcn_readfirstlane(TTp[0])};
        unsigned* tdone = (unsigned*)(ws + WS_CTL) + CW_MOE + rep_ * 4096;
        const int ngu = 2 * tab.TT, R_ = (ngu > G && ngu <= 2 * G) ? ngu - G : 0, nd_ = G - R_;
        if (ngu <= 2 * G) {
            int ub_ = bx - R_;
            if (G == 256 && bx >= R_) { const int x_ = bx & 7; int base_ = 0;
                for (int y = 0; y < x_; ++y) base_ += 32 - ((R_ > y) ? ((R_ - y + 7) >> 3) : 0);
                ub_ = base_ + (bx >> 3) - ((R_ > x_) ? ((R_ - x_ + 7) >> 3) : 0); }
            int tile = -1, T = 0, nun = 0;
            if (bx < R_) { int pa_ = bx;
                if (G == 256) { const int x_ = bx & 7; int base_ = 0;
                    for (int y = 0; y < x_; ++y) base_ += (R_ > y) ? ((R_ - y + 7) >> 3) : 0;
                    pa_ = base_ + (bx >> 3); }
                tile = tab.TT - R_ + pa_; nun = 2; }
            else if (ub_ < ngu - 2 * R_) { tile = ub_ >> 1; T = ub_ & 1; nun = 1; }
            if (nun) {
                const int e = __builtin_amdgcn_readfirstlane(tab.expert_of(tile)), rt = tile - __builtin_amdgcn_readfirstlane(TB[e]); int nvalid = __builtin_amdgcn_readfirstlane(TC[e]) - rt * 256; if (nvalid > 256) nvalid = 256;
                pg8::Gemm g{(const hbits*)(ws + WS_X2H), Wgu_t, M, 512, D, rlist + (size_t)e * M + rt * 256, nvalid};
                pg8::SchedTwo Sc{{tile, 2 * e + T}, {tile, 2 * e + 1}, nun};
                pg8::EpiGU E{(hbits*)(ws + WS_HID), rwt + (size_t)e * M + rt * 256, rsl + (size_t)e * M + rt * 256, nvalid, tile * 256, (LAS float*)(L + LDSCTL_OFF + 9216)};
                pg8::gemm_phase<pg8::EpiGU, pg8::SchedTwo, true, true, true, true>(L + RING_OFF, g, Sc, E, wave);
                asm volatile("s_waitcnt vmcnt(0)" ::: "memory"); __syncthreads();
                if (T0) __hip_atomic_fetch_add(tdone + 16 * tile, (unsigned)nun, __ATOMIC_RELAXED, __HIP_MEMORY_SCOPE_AGENT);
            }
            const int n_dn_mine = (bx >= R_) ? (4 * tab.TT - ub_ + nd_ - 1) / nd_ : 0;
            for (int it_ = 0; it_ < n_dn_mine; ++it_) {
                const int dn = ub_ + it_ * nd_, tile2 = dn >> 2, cn = dn & 3, e = __builtin_amdgcn_readfirstlane(tab.expert_of(tile2));
                int nv_ = __builtin_amdgcn_readfirstlane(TC[e]) - (tile2 - __builtin_amdgcn_readfirstlane(TB[e])) * 256; if (nv_ > 256) nv_ = 256;
                int ev_ = -1;
                if (wave < 4) { const int rl_ = wave * 64 + lane; ev_ = (rlist + (size_t)e * M + (tile2 - __builtin_amdgcn_readfirstlane(TB[e])) * 256)[(rl_ < nv_) ? rl_ : 0]; }
                if (T0) { unsigned sp = 0;
                    asm volatile("buffer_inv sc1" ::: "memory");
                    while (__hip_atomic_load(tdone + 16 * tile2, __ATOMIC_RELAXED, __HIP_MEMORY_SCOPE_AGENT) < 2u) { __builtin_amdgcn_s_sleep(2); if (++sp > (1u << 22)) break; }
                    asm volatile("s_waitcnt vmcnt(0)" ::: "memory"); }
                __syncthreads();
                if (wave < 4) { const int rl_ = wave * 64 + lane; ((LAS int*)(L + LDSCTL_OFF + 8192))[rl_] = (rl_ < nv_) ? ev_ : -1; }
                pg8::Gemm g{(const hbits*)(ws + WS_HID), Wd_t, 40960, 32768, 256, nullptr, nv_};
                pg8::SchedOne Sc{{tile2, 4 * e + cn}};
                pg8::EpiDown E{tab, rlist, (hbits*)(ws + WS_P), (const LAS int*)(L + LDSCTL_OFF + 8192)};
                pg8::gemm_phase<pg8::EpiDown, pg8::SchedOne, false, true, false, true>(L + RING_OFF, g, Sc, E, wave);
            }
        }
        if (IN(12)) xcd_barrier(bar, T0, wave == 0);
    }
    if (IN(11)) { for (int rep_ = 1; rep_ < args.rep[11]; ++rep_) { xcd_barrier(bar, T0, wave == 0); xcd_barrier(bar, T0, wave == 0); xcd_barrier(bar, T0, wave == 0); xcd_barrier(bar, T0, wave == 0); } }
    for (int rep_ = 0; rep_ < (IN(12) ? args.rep[12] : 0); ++rep_) {
        const hbits* P0 = (const hbits*)(ws + WS_P); const hbits* P1 = P0 + (size_t)M * D;
#pragma unroll 4
        for (size_t i = (size_t)bx * 512 + tid; i < (size_t)M * D / 8; i += (size_t)G * 512) {
            f32x4 a, b;
            { const v4u xr = __builtin_nontemporal_load((const v4u*)((const hbits*)(ws + WS_X2H) + i * 8)); const unsigned xa = xr.x, xb = xr.y, xc = xr.z, xd = xr.w;
              const h2v x0 = __builtin_bit_cast(h2v, xa), x1 = __builtin_bit_cast(h2v, xb), x2 = __builtin_bit_cast(h2v, xc), x3 = __builtin_bit_cast(h2v, xd);
              a = (f32x4){(float)x0[0], (float)x0[1], (float)x1[0], (float)x1[1]}; b = (f32x4){(float)x2[0], (float)x2[1], (float)x3[0], (float)x3[1]}; }
            const v4u p = __builtin_nontemporal_load((const v4u*)(P0 + i * 8)), q = __builtin_nontemporal_load((const v4u*)(P1 + i * 8));
            const unsigned px = p.x, py = p.y, pz = p.z, pw = p.w, qx = q.x, qy = q.y, qz = q.z, qw = q.w;
            const h2v p0 = __builtin_bit_cast(h2v, px), p1 = __builtin_bit_cast(h2v, py), p2 = __builtin_bit_cast(h2v, pz), p3 = __builtin_bit_cast(h2v, pw);
            const h2v q0 = __builtin_bit_cast(h2v, qx), q1 = __builtin_bit_cast(h2v, qy), q2 = __builtin_bit_cast(h2v, qz), q3 = __builtin_bit_cast(h2v, qw);
            a[0] += (float)p0[0] + (float)q0[0]; a[1] += (float)p0[1] + (float)q0[1]; a[2] += (float)p1[0] + (float)q1[0]; a[3] += (float)p1[1] + (float)q1[1];
            b[0] += (float)p2[0] + (float)q2[0]; b[1] += (float)p2[1] + (float)q2[1]; b[2] += (float)p3[0] + (float)q3[0]; b[3] += (float)p3[1] + (float)q3[1];
#if DBG_ATTN
            { const unsigned* dbg = (const unsigned*)(ws + WS_CTL) + 16384; const float s0 = __uint_as_float(dbg[0]); const float frac = (float)dbg[1] / ((float)M * 512.f); const unsigned mr = 4096u - dbg[2];
              const float delta = DBG_CH_RVR == 0 ? sqrtf(frac) : sqrtf((float)dbg[3] / (4.f * 256.f * 512.f));
              a = a + delta; b = b + delta; if (i == 0) a[0] += DBG_CH_ABS == 0 ? 1000.f * s0 : (float)(mr & 4095u); }
#endif
            __builtin_nontemporal_store(a, (f32x4*)(args.out + i * 8)); __builtin_nontemporal_store(b, (f32x4*)(args.out + i * 8 + 4));
        }
    }
#undef MOE_CONV
#undef IN
#undef BOTH
#undef lane
#undef tid
#undef T0
#undef Win_t
#undef Wkv_t
#undef Wout_t
#undef Wq_t
#undef Wo_t
#undef Wgu_t
#undef Wd_t
#undef Pw_t
#undef XH
#undef cosT
#undef sinT
#undef gcnt
#undef rlist
#undef rwt
#undef RSTD2
#undef rsl
}
static void launch_mk(hipStream_t stream, int grid, const Args& base, int lo, int hi) {
    Args a = base; a.ph_lo = lo; a.ph_hi = hi;
    hipLaunchKernelGGL(mk, dim3(grid), dim3(NWAVES * 64), LDS_BYTES, stream, a);
}
extern "C" void kernel_launch(void* const* d_in, const int* in_sizes, int n_in, void* d_out, int out_size, void* d_ws, size_t ws_size, hipStream_t stream) {
    static int grid = 0;
    if (grid == 0) {
        if (n_in != 25 || in_sizes[0] != M * D || out_size != M * D || ws_size < WS_END) { fprintf(stderr, "kernel_launch: unexpected shapes (n_in %d, ws %zu)\n", n_in, ws_size); grid = -1; return; }
        int dev = 0, cus = 0, per_cu = 0;
        if (hipGetDevice(&dev) != hipSuccess || hipDeviceGetAttribute(&cus, hipDeviceAttributeMultiprocessorCount, dev) != hipSuccess) { grid = -1; return; }
        if (hipFuncSetAttribute((const void*)mk, hipFuncAttributeMaxDynamicSharedMemorySize, LDS_BYTES) != hipSuccess) { fprintf(stderr, "kernel_launch: hipFuncSetAttribute failed\n"); grid = -1; return; }
        if (hipOccupancyMaxActiveBlocksPerMultiprocessor(&per_cu, (const void*)mk, NWAVES * 64, LDS_BYTES) != hipSuccess || per_cu < 1) { fprintf(stderr, "kernel_launch: occupancy query says %d blocks/CU\n", per_cu); grid = -1; (void)hipGetLastError(); return; }
        grid = cus;
    }
    if (grid < 0) return;
    unsigned char* ws = (unsigned char*)d_ws; float* out = (float*)d_out;
    (void)hipMemsetAsync(ws + WS_CTL, 0, CTL_ZERO_BYTES, stream);
    Args a{};
    for (int i = 0; i < 25; ++i) a.in[i] = (const float*)d_in[i];
    a.out = out; a.ws = ws;
    for (int k = 0; k < 16; ++k) a.rep[k] = (k == PROBE_DOUBLE) ? 2 : 1;
    const float* pool_w = a.in[4]; const float* pool_scale = a.in[5]; const float* xq_norm = a.in[14]; const float* xk_norm = a.in[15]; const float* ffn_norm = a.in[17];
    const float* rgw = a.in[18]; const float* rgb = a.in[19]; const float* rew = a.in[20]; const float* reb = a.in[21];
    const float* wgate = a.in[22]; const float* wup = a.in[23]; const float* wdown = a.in[24];
    hbits* U = (hbits*)(ws + WS_U); hbits* Qa = (hbits*)(ws + WS_QA); hbits* Ka = (hbits*)(ws + WS_KA); hbits* Va = (hbits*)(ws + WS_VA);
    hbits* Qi = (hbits*)(ws + WS_QI); hbits* Ki = (hbits*)(ws + WS_KI); float* WI = (float*)(ws + WS_WI);
    unsigned long long* MASK = (unsigned long long*)(ws + WS_MASK);
    hbits* Y = (hbits*)out; hbits* MIX = (hbits*)(ws + 234 * MiB);
    float* rstd2 = (float*)(ws + WS_MISC); int* cnt = (int*)(rstd2 + M); int* offs = cnt + 32;
    int* list = (int*)(ws + WS_RLIST); float* wlist = (float*)(ws + WS_RW);
    float* X2c = (float*)(ws + WS_X1);
    float* HID = (float*)(ws + WS_XH);
#if ONE_LAUNCH
    launch_mk(stream, grid, a, 0, 13);
#else
    for (int ph = 0; ph < 13; ++ph) launch_mk(stream, grid, a, ph, ph + 1);
#endif
}
```
